# Optimizing an MI355X kernel written in HIP

```python
import jax, jax.numpy as jnp
from jax import lax
import numpy as np

D_MODEL = 1024
BATCH = 32
SEQ = 2048
DEPTH = 1

POOL_WIDTH = D_MODEL
POOL_WINDOWS = (2, 4, 8, 16)
POOL_GROUPS = len(POOL_WINDOWS)
POOL_GROUP_WIDTH = POOL_WIDTH // POOL_GROUPS
SSD_EXPAND = 2
SSD_INNER = SSD_EXPAND * D_MODEL
SSD_HEAD_DIM = 64
SSD_HEADS = SSD_INNER // SSD_HEAD_DIM
SSD_GROUPS = 8
SSD_HEADS_PER_GROUP = SSD_HEADS // SSD_GROUPS
SSD_STATE = 128
SSD_CONV = 4
SSD_CHUNK = 256
SSD_CONV_DIM = SSD_INNER + 2 * SSD_GROUPS * SSD_STATE
SSD_NORM_GROUP = SSD_INNER // SSD_GROUPS
D_FF = 4 * D_MODEL
N_BRANCHES = 2
OFF_POOL = POOL_WIDTH
OFF_Z = OFF_POOL + SSD_INNER
OFF_XBC = OFF_Z + SSD_CONV_DIM
OFF_DT = OFF_XBC + SSD_HEADS
IN_PROJ_WIDTH = OFF_DT + N_BRANCHES * D_MODEL
DEEPNORM_ALPHA = (2.0 * DEPTH) ** 0.25
DEEPNORM_BETA = (8.0 * DEPTH) ** -0.25
LN_EPS = 1e-5
RMS_EPS = 1e-5

kernel_name = "pool_ssd_gated_hybrid_deepnorm"


def layer_norm(x, g, b):
    xf = x.astype(jnp.float32)
    mu = jnp.mean(xf, axis=-1, keepdims=True)
    var = jnp.mean(jnp.square(xf - mu), axis=-1, keepdims=True)
    return ((xf - mu) * lax.rsqrt(var + LN_EPS) * g + b).astype(x.dtype)


def causal_multiscale_pool(u):
    bsz, s, _ = u.shape
    uf = u.astype(jnp.float32).reshape(bsz, s, POOL_GROUPS, POOL_GROUP_WIDTH)
    cs = jnp.cumsum(uf, axis=1)
    pos = jnp.arange(1, s + 1, dtype=jnp.float32)
    outs = []
    for gi, w in enumerate(POOL_WINDOWS):
        csg = cs[:, :, gi]
        lag = jnp.pad(csg, ((0, 0), (w, 0), (0, 0)))[:, :s]
        cnt = jnp.minimum(pos, float(w))[None, :, None]
        outs.append((csg - lag) / cnt)
    pooled = jnp.stack(outs, axis=2)
    return pooled - uf


def causal_depthwise_conv(u, w, b):
    k_width = w.shape[0]
    s = u.shape[1]
    up = jnp.pad(u, ((0, 0), (k_width - 1, 0), (0, 0)))
    y = up[:, 0:s] * w[0]
    for k in range(1, k_width):
        y = y + up[:, k:k + s] * w[k]
    return y + b


def segsum_exp(a):
    t = a.shape[-1]
    cs = jnp.cumsum(a, axis=-1)
    seg = cs[..., :, None] - cs[..., None, :]
    mask = jnp.tril(jnp.ones((t, t), dtype=bool))
    return jnp.exp(jnp.where(mask, seg, -jnp.inf))


def ssd_chunked(xdt, da, bm, cm):
    bsz, s = xdt.shape[:2]
    n_chunks = -(-s // SSD_CHUNK)
    pad = n_chunks * SSD_CHUNK - s

    def to_chunks(t):
        t = jnp.pad(t, ((0, 0), (0, pad)) + ((0, 0),) * (t.ndim - 2))
        return t.reshape((bsz, n_chunks, SSD_CHUNK) + t.shape[2:])

    xc, ac, bc, cc = to_chunks(xdt), to_chunks(da), to_chunks(bm), to_chunks(cm)
    a_cs = jnp.cumsum(ac, axis=2)
    lmat = segsum_exp(jnp.moveaxis(ac, 2, -1))
    cb = jnp.einsum('bclgn,bcsgn->bcgls', cc, bc)
    y_diag = jnp.einsum('bcgls,bcgrls,bcsgrp->bclgrp', cb, lmat, xc)
    decay_to_end = jnp.exp(a_cs[:, :, -1:] - a_cs)
    states = jnp.einsum('bclgn,bclgr,bclgrp->bcgrpn', bc, decay_to_end, xc)
    chunk_decay = jnp.exp(a_cs[:, :, -1])

    def step(h, inp):
        s_c, d_c = inp
        return d_c[..., None, None] * h + s_c, h

    h0 = jnp.zeros_like(states[:, 0])
    _, prev = lax.scan(step, h0, (jnp.moveaxis(states, 1, 0), jnp.moveaxis(chunk_decay, 1, 0)))
    prev = jnp.moveaxis(prev, 0, 1)
    y_off = jnp.einsum('bclgn,bcgrpn,bclgr->bclgrp', cc, prev, jnp.exp(a_cs))
    y = (y_diag + y_off).reshape((bsz, n_chunks * SSD_CHUNK) + xdt.shape[2:])
    return y[:, :s]


def hybrid_layer(h, w_in, b_gates, conv_w, conv_b, dt_bias, a_log, d_skip,
                 ssd_norm_w, w_ssd_proj, w_pool_group, pool_scale, w_out,
                 ln1_g, ln1_b, w_up, w_down, ln2_g, ln2_b):
    bsz, s, _ = h.shape
    proj = h @ w_in
    u_pool, z, xbc, dt_raw, gate_logits = jnp.split(
        proj, [OFF_POOL, OFF_Z, OFF_XBC, OFF_DT], axis=-1)
    gates = jax.nn.sigmoid((gate_logits + b_gates).astype(jnp.float32))
    gates = gates.reshape(bsz, s, N_BRANCHES, D_MODEL)

    pooled = causal_multiscale_pool(u_pool)
    y_pool = jnp.einsum('bsgc,gcd->bsgd', pooled, w_pool_group)
    y_pool = y_pool.reshape(bsz, s, POOL_WIDTH) * pool_scale

    xbc = jax.nn.silu(causal_depthwise_conv(xbc, conv_w, conv_b))
    xs, bm, cm = jnp.split(xbc, [SSD_INNER, SSD_INNER + SSD_GROUPS * SSD_STATE], axis=-1)
    xs = xs.astype(jnp.float32).reshape(bsz, s, SSD_GROUPS, SSD_HEADS_PER_GROUP, SSD_HEAD_DIM)
    bm = bm.astype(jnp.float32).reshape(bsz, s, SSD_GROUPS, SSD_STATE)
    cm = cm.astype(jnp.float32).reshape(bsz, s, SSD_GROUPS, SSD_STATE)
    dt = jax.nn.softplus(dt_raw.astype(jnp.float32) + dt_bias)
    dt = dt.reshape(bsz, s, SSD_GROUPS, SSD_HEADS_PER_GROUP)
    a = -jnp.exp(a_log.astype(jnp.float32)).reshape(SSD_GROUPS, SSD_HEADS_PER_GROUP)
    d = d_skip.astype(jnp.float32).reshape(SSD_GROUPS, SSD_HEADS_PER_GROUP)
    y = ssd_chunked(xs * dt[..., None], dt * a, bm, cm) + d[..., None] * xs
    y = y.reshape(bsz, s, SSD_INNER)
    yg = (y * jax.nn.silu(z.astype(jnp.float32))).reshape(bsz, s, SSD_GROUPS, SSD_NORM_GROUP)
    yg = yg * lax.rsqrt(jnp.mean(jnp.square(yg), axis=-1, keepdims=True) + RMS_EPS)
    yg = yg.reshape(bsz, s, SSD_INNER) * ssd_norm_w
    y_ssd = yg.astype(h.dtype) @ w_ssd_proj

    merged = gates[:, :, 0] * y_pool + gates[:, :, 1] * y_ssd
    mix = merged.astype(h.dtype) @ w_out
    h = layer_norm(DEEPNORM_ALPHA * h + mix, ln1_g, ln1_b)

    ff = jnp.square(jax.nn.relu(h @ w_up)) @ w_down
    h = layer_norm(DEEPNORM_ALPHA * h + ff, ln2_g, ln2_b)
    return h


def setup_inputs(seed: int = 0) -> dict:
    key = jax.random.key(seed)
    ks = jax.random.split(key, 20)
    nrm = lambda k, shape: jax.random.normal(k, shape, dtype=jnp.float32)
    x = nrm(ks[0], (BATCH, SEQ, D_MODEL))
    w_in = nrm(ks[1], (DEPTH, D_MODEL, IN_PROJ_WIDTH)) * D_MODEL ** -0.5
    b_gates = 0.1 * nrm(ks[2], (DEPTH, N_BRANCHES * D_MODEL))
    conv_w = nrm(ks[3], (DEPTH, SSD_CONV, SSD_CONV_DIM)) * SSD_CONV ** -0.5
    conv_b = 0.02 * nrm(ks[4], (DEPTH, SSD_CONV_DIM))
    dt0 = jnp.exp(jax.random.uniform(ks[5], (DEPTH, SSD_HEADS), dtype=jnp.float32,
                                     minval=np.log(1e-3), maxval=np.log(1e-1)))
    dt_bias = dt0 + jnp.log(-jnp.expm1(-dt0))
    a_log = jnp.log(jax.random.uniform(ks[6], (DEPTH, SSD_HEADS), dtype=jnp.float32,
                                       minval=1.0, maxval=16.0))
    d_skip = 1.0 + 0.1 * nrm(ks[7], (DEPTH, SSD_HEADS))
    ssd_norm_w = 1.0 + 0.02 * nrm(ks[8], (DEPTH, SSD_INNER))
    w_ssd_proj = nrm(ks[9], (DEPTH, SSD_INNER, D_MODEL)) * SSD_INNER ** -0.5
    w_pool_group = nrm(ks[10], (DEPTH, POOL_GROUPS, POOL_GROUP_WIDTH, POOL_GROUP_WIDTH)) * POOL_GROUP_WIDTH ** -0.5
    pool_scale = 1.0 + 0.02 * nrm(ks[11], (DEPTH, POOL_WIDTH))
    w_out = nrm(ks[12], (DEPTH, D_MODEL, D_MODEL)) * (D_MODEL ** -0.5 * DEEPNORM_BETA)
    ln1_g = 1.0 + 0.02 * nrm(ks[13], (DEPTH, D_MODEL))
    ln1_b = 0.02 * nrm(ks[14], (DEPTH, D_MODEL))
    w_up = nrm(ks[15], (DEPTH, D_MODEL, D_FF)) * D_MODEL ** -0.5
    w_down = nrm(ks[16], (DEPTH, D_FF, D_MODEL)) * (D_FF ** -0.5 * DEEPNORM_BETA)
    ln2_g = 1.0 + 0.02 * nrm(ks[17], (DEPTH, D_MODEL))
    ln2_b = 0.02 * nrm(ks[18], (DEPTH, D_MODEL))
    return {"x": x, "w_in": w_in, "b_gates": b_gates, "conv_w": conv_w, "conv_b": conv_b,
            "dt_bias": dt_bias, "a_log": a_log, "d_skip": d_skip, "ssd_norm_w": ssd_norm_w,
            "w_ssd_proj": w_ssd_proj, "w_pool_group": w_pool_group, "pool_scale": pool_scale,
            "w_out": w_out, "ln1_g": ln1_g, "ln1_b": ln1_b, "w_up": w_up, "w_down": w_down,
            "ln2_g": ln2_g, "ln2_b": ln2_b}


def reference(x, w_in, b_gates, conv_w, conv_b, dt_bias, a_log, d_skip, ssd_norm_w,
              w_ssd_proj, w_pool_group, pool_scale, w_out, ln1_g, ln1_b, w_up, w_down,
              ln2_g, ln2_b):
    h = x
    for layer in range(DEPTH):
        h = hybrid_layer(h, w_in[layer], b_gates[layer], conv_w[layer], conv_b[layer],
                         dt_bias[layer], a_log[layer], d_skip[layer], ssd_norm_w[layer],
                         w_ssd_proj[layer], w_pool_group[layer], pool_scale[layer],
                         w_out[layer], ln1_g[layer], ln1_b[layer], w_up[layer],
                         w_down[layer], ln2_g[layer], ln2_b[layer])
    return h
```

```cpp
#include <hip/hip_runtime.h>
#include <hip/hip_cooperative_groups.h>
#include <cstdio>
namespace cg = cooperative_groups;

#define LAS __attribute__((address_space(3)))
typedef unsigned short bf16_t;
typedef short bf16x8 __attribute__((ext_vector_type(8)));
typedef float f32x4 __attribute__((ext_vector_type(4)));
typedef float f32x2 __attribute__((ext_vector_type(2)));
typedef unsigned u32x4 __attribute__((ext_vector_type(4)));
typedef unsigned u32x2 __attribute__((ext_vector_type(2)));

constexpr int T_TOK = 65536, SEQ = 2048, DM = 1024, DFF = 4096;
constexpr int N1 = 6400;
constexpr int N2 = 3072;
constexpr float ALPHA = 1.189207115002721f;
constexpr float LN_EPS = 1e-5f, RMS_EPS = 1e-5f;
constexpr size_t MiB = 1024ull * 1024ull;
constexpr size_t WS_RA = 0;
constexpr size_t WS_RB = 512 * MiB;
constexpr size_t WS_RC = 768 * MiB;
constexpr size_t WS_DT = 896 * MiB;
constexpr size_t WS_W  = 904 * MiB;
constexpr size_t WS_WIN1 = WS_W;
constexpr size_t WS_WIN2 = WS_WIN1 + (size_t)N1 * 1024 * 2;
constexpr size_t WS_WP   = WS_WIN2 + (size_t)N2 * 1024 * 2;
constexpr size_t WS_WSSD = WS_WP + (size_t)1024 * 256 * 2;
constexpr size_t WS_WOUT = WS_WSSD + (size_t)1024 * 2048 * 2;
constexpr size_t WS_WUP  = WS_WOUT + (size_t)1024 * 1024 * 2;
constexpr size_t WS_WDN  = WS_WUP + (size_t)4096 * 1024 * 2;
constexpr size_t WS_END  = WS_WDN + (size_t)4096 * 1024 * 2;
constexpr int LDS_BYTES = 160000;
constexpr int NPHASE = 11;

struct Params { const float* in[19]; float* out; unsigned char* ws; int ph_lo, ph_hi; };

__device__ __forceinline__ unsigned cvt_pk_bf16(float lo, float hi) { unsigned r; asm volatile("v_cvt_pk_bf16_f32 %0, %1, %2" : "=v"(r) : "v"(lo), "v"(hi)); return r; }
__device__ __forceinline__ float bf_lo(unsigned u) { return __uint_as_float(u << 16); }
__device__ __forceinline__ float bf_hi(unsigned u) { return __uint_as_float(u & 0xffff0000u); }
__device__ __forceinline__ float bf2f(bf16_t b) { return __uint_as_float(((unsigned)b) << 16); }
__device__ __forceinline__ float sigmoidf_(float v) { return __builtin_amdgcn_rcpf(1.0f + __expf(-v)); }
__device__ __forceinline__ float siluf_(float v) { return v * __builtin_amdgcn_rcpf(1.0f + __expf(-v)); }
__device__ __forceinline__ float softplusf_(float v) { return fmaxf(v, 0.f) + log1pf(__expf(-fabsf(v))); }
__device__ __forceinline__ u32x4 pack8(f32x4 a, f32x4 b) { u32x4 w; w.x = cvt_pk_bf16(a[0], a[1]); w.y = cvt_pk_bf16(a[2], a[3]); w.z = cvt_pk_bf16(b[0], b[1]); w.w = cvt_pk_bf16(b[2], b[3]); return w; }
__device__ __forceinline__ void unpack8(u32x4 w, f32x4& a, f32x4& b) { a = (f32x4){bf_lo(w.x), bf_hi(w.x), bf_lo(w.y), bf_hi(w.y)}; b = (f32x4){bf_lo(w.z), bf_hi(w.z), bf_lo(w.w), bf_hi(w.w)}; }

namespace pg8 {
constexpr int BM = 256, BK = 64, HALF = 128, HTB = HALF * BK * 2, STAGE_BYTES = 8 * HTB, NXCD = 8, WGM = 8;
__device__ __forceinline__ int lds_byte(int r, int c) { const int st = (r >> 4) * 2 + (c >> 5), rr = r & 15, cc = c & 31, ob = rr * 64 + cc * 2; return st * 1024 + (ob ^ (((ob >> 9) & 1) << 5)); }
__device__ __forceinline__ void stage_rc(int b, int& R, int& C) { const int st = b / 1024, sb = b % 1024, swz = sb ^ (((sb >> 9) & 1) << 5); R = (st >> 1) * 16 + swz / 64; C = (st & 1) * 32 + (swz % 64) / 2; }
__device__ __forceinline__ int perm32(int rho) { const int n = rho >> 4, i = rho & 15; return 8 * (i >> 2) + 4 * n + (i & 3); }
struct Unit { int pm, pn; };
struct Gemm { const bf16_t* A; const bf16_t* Bt; int M, N, K, lda, ldb, a_pn_bytes; };
struct StaticOrder {
    int nM, nN, nwg, G, c;
    __device__ void init(int M, int N, int G_, int c_) { nM = M / BM; nN = N / BM; nwg = nM * nN; G = G_; c = c_; }
    __device__ bool next(int i, Unit& u) const {
        const long L = (long)i * G + c; if (L >= nwg) return false;
        int wgid = (int)L; { const int q = nwg / NXCD, r = nwg % NXCD, xcd = wgid % NXCD, off = wgid / NXCD; wgid = (xcd < r ? xcd * (q + 1) : r * (q + 1) + (xcd - r) * q) + off; }
        const int nig = WGM * nN, gid = wgid / nig, fm = gid * WGM, gsz = (nM - fm) < WGM ? (nM - fm) : WGM;
        u.pm = fm + ((wgid % nig) % gsz); u.pn = (wgid % nig) / gsz; return true;
    }
};

template <int OFF> __device__ __forceinline__ void ds_rd128(bf16x8& dst, unsigned addr) { asm volatile("ds_read_b128 %0, %1 offset:%2" : "=v"(dst) : "v"(addr), "n"(OFF)); }
template <class Epi>
__device__ __forceinline__ void gemm_phase(LAS unsigned char* lds, const Gemm g, const StaticOrder& S, const Epi& E) {
    const int tid = threadIdx.x, wid = __builtin_amdgcn_readfirstlane(tid >> 6), lane = tid & 63, wr = wid >> 2, wc = wid & 3, fr = lane & 15, fq = lane >> 4;
    const int K = g.K, nt = K / BK;
    unsigned voffA[2], voffB[2];
#pragma unroll
    for (int i = 0; i < 2; ++i) { int R, C; stage_rc(tid * 16 + i * 8192, R, C); const int Rb = Epi::PERM ? ((R & ~31) + perm32(R & 31)) : R;
        voffA[i] = (unsigned)(R * g.lda + C) * 2u; voffB[i] = (unsigned)(Rb * g.ldb + C) * 2u; }
    const size_t kstep = (size_t)(BK * 2);
    const size_t hsA = (size_t)HALF * g.lda * 2, hsB = (size_t)HALF * g.ldb * 2;
    const size_t tsA = 2 * hsA, tsB = 2 * hsB;
    const unsigned ldsw = (unsigned)wid * 1024u;
    const int aoff = lds_byte(wr * 64 + fr, fq * 8), boff = lds_byte(wc * 32 + fr, fq * 8);
    const unsigned aaddr = (unsigned)(unsigned long long)(lds + aoff), baddr = (unsigned)(unsigned long long)(lds + 4 * HTB + boff);
#define PG8_SA(b, h) (((b) * 2 + (h)) * HTB)
#define PG8_SB(b, h) ((4 + (b) * 2 + (h)) * HTB)
#define PG8_STAGE(bufoff, gbase, voff) do { _Pragma("unroll") for (int _i = 0; _i < 2; ++_i) \
        __builtin_amdgcn_global_load_lds((const unsigned*)((const char*)(gbase) + (voff)[_i]), (LAS unsigned*)(lds + (bufoff) + ldsw + _i * 8192), 16, 0, 0); } while (0)
#define PG8_LDA(dst, b, h) do { _Pragma("unroll") for (int m = 0; m < 4; ++m) _Pragma("unroll") for (int k = 0; k < 2; ++k) dst[m][k] = *(const LAS bf16x8*)(lds + PG8_SA(b, h) + aoff + m * 2048 + k * 1024); } while (0)
#define PG8_LDB(dst, b, h) do { _Pragma("unroll") for (int n = 0; n < 2; ++n) _Pragma("unroll") for (int k = 0; k < 2; ++k) dst[n][k] = *(const LAS bf16x8*)(lds + PG8_SB(b, h) + boff + n * 2048 + k * 1024); } while (0)
#define PG8_MMA(ai, bj, At, Bt) do { __builtin_amdgcn_s_setprio(1); _Pragma("unroll") for (int m = 0; m < 4; ++m) _Pragma("unroll") for (int n = 0; n < 2; ++n) _Pragma("unroll") for (int k = 0; k < 2; ++k) \
        acc[ai][bj][m][n] = __builtin_amdgcn_mfma_f32_16x16x32_bf16(Bt[n][k], At[m][k], acc[ai][bj][m][n], 0, 0, 0); __builtin_amdgcn_s_setprio(0); } while (0)
#define PG8_RDA(dst, b, h) do { ds_rd128<PG8_SA(b, h) + 0 * 2048>(dst[0][0], aaddr); ds_rd128<PG8_SA(b, h) + 1 * 2048>(dst[1][0], aaddr); ds_rd128<PG8_SA(b, h) + 2 * 2048>(dst[2][0], aaddr); ds_rd128<PG8_SA(b, h) + 3 * 2048>(dst[3][0], aaddr); \
        ds_rd128<PG8_SA(b, h) + 0 * 2048 + 1024>(dst[0][1], aaddr); ds_rd128<PG8_SA(b, h) + 1 * 2048 + 1024>(dst[1][1], aaddr); ds_rd128<PG8_SA(b, h) + 2 * 2048 + 1024>(dst[2][1], aaddr); ds_rd128<PG8_SA(b, h) + 3 * 2048 + 1024>(dst[3][1], aaddr); } while (0)
#define PG8_RDB(dst, b, h) do { ds_rd128<PG8_SA(b, h)>(dst[0][0], baddr); ds_rd128<PG8_SA(b, h) + 2048>(dst[1][0], baddr); ds_rd128<PG8_SA(b, h) + 1024>(dst[0][1], baddr); ds_rd128<PG8_SA(b, h) + 2048 + 1024>(dst[1][1], baddr); } while (0)
#define PG8_WAITA(n, F, k) asm volatile("s_waitcnt lgkmcnt(" #n ")" : "+v"(F[0][k]), "+v"(F[1][k]), "+v"(F[2][k]), "+v"(F[3][k]) :: "memory")
#define PG8_WAITB(n, F, k) asm volatile("s_waitcnt lgkmcnt(" #n ")" : "+v"(F[0][k]), "+v"(F[1][k]) :: "memory")
#define PG8_WAITAB(n, FA, FB) asm volatile("s_waitcnt lgkmcnt(" #n ")" : "+v"(FA[0][0]), "+v"(FA[1][0]), "+v"(FA[2][0]), "+v"(FA[3][0]), "+v"(FB[0][0]), "+v"(FB[1][0]), "+v"(FB[0][1]), "+v"(FB[1][1]) :: "memory")
#define PG8_MMAK(ai, bj, At, Bt, k) do { _Pragma("unroll") for (int m = 0; m < 4; ++m) _Pragma("unroll") for (int n = 0; n < 2; ++n) \
        acc[ai][bj][m][n] = __builtin_amdgcn_mfma_f32_16x16x32_bf16(Bt[n][k], At[m][k], acc[ai][bj][m][n], 0, 0, 0); } while (0)
#define PG8_PRIO(x) __builtin_amdgcn_s_setprio(x)
#define PG8_WAIT_V(n) asm volatile("s_waitcnt vmcnt(" #n ")" ::: "memory")
#define PG8_WAIT_L(n) asm volatile("s_waitcnt lgkmcnt(" #n ")" ::: "memory")
#define PG8_BAR __builtin_amdgcn_s_barrier()
#define PG8_SCHED __builtin_amdgcn_sched_barrier(0)
    Unit cur, nxt; int ui = 0;
    if (!S.next(0, cur)) return;
    f32x4 acc[2][2][4][2];
#pragma unroll
    for (int a = 0; a < 2; ++a)
#pragma unroll
        for (int b = 0; b < 2; ++b)
#pragma unroll
            for (int m = 0; m < 4; ++m)
#pragma unroll
                for (int n = 0; n < 2; ++n) acc[a][b][m][n] = (f32x4){0.f, 0.f, 0.f, 0.f};
    bf16x8 At[4][2], B0[2][2], B1[2][2];
    const char* cA = (const char*)g.A + (size_t)cur.pm * tsA + (size_t)cur.pn * g.a_pn_bytes; const char* cB = (const char*)g.Bt + (size_t)cur.pn * tsB;
    PG8_STAGE(PG8_SB(0, 0), cB, voffB); PG8_STAGE(PG8_SA(0, 0), cA, voffA); PG8_STAGE(PG8_SB(0, 1), cB + hsB, voffB); PG8_STAGE(PG8_SA(0, 1), cA + hsA, voffA);
    if (wr == 1) PG8_BAR;
    PG8_WAIT_V(4); PG8_BAR;
    PG8_STAGE(PG8_SB(1, 0), cB + kstep, voffB); PG8_STAGE(PG8_SA(1, 0), cA + kstep, voffA); PG8_STAGE(PG8_SB(1, 1), cB + hsB + kstep, voffB);
    PG8_WAIT_V(6); PG8_BAR;
    PG8_RDB(B0, 0, 0);
    for (;;) {
        const bool has_next = S.next(ui + 1, nxt);
        const char* nA = has_next ? (const char*)g.A + (size_t)nxt.pm * tsA + (size_t)nxt.pn * g.a_pn_bytes : cA; const char* nB = has_next ? (const char*)g.Bt + (size_t)nxt.pn * tsB : cB;
#pragma unroll 1
        for (int t = 0; t < nt; t += 2) {
            const bool last = (t == nt - 2);
            const char* a1 = cA + (size_t)(t + 1) * kstep;
            const char* a2 = last ? nA : cA + (size_t)(t + 2) * kstep; const char* b2 = last ? nB : cB + (size_t)(t + 2) * kstep;
            const char* a3 = a2 + kstep; const char* b3 = b2 + kstep;
            PG8_RDA(At, 0, 0); PG8_STAGE(PG8_SA(1, 1), a1 + hsA, voffA);
            PG8_WAIT_V(10); PG8_BAR; PG8_PRIO(1); PG8_WAITAB(4, At, B0); PG8_SCHED; PG8_MMAK(0, 0, At, B0, 0); PG8_SCHED; PG8_WAITA(0, At, 1); PG8_SCHED; PG8_MMAK(0, 0, At, B0, 1); PG8_PRIO(0); PG8_BAR; PG8_SCHED;
            PG8_RDB(B1, 0, 1); PG8_STAGE(PG8_SB(0, 0), b2, voffB);
            PG8_WAIT_V(10); PG8_BAR; PG8_PRIO(1); PG8_WAITB(2, B1, 0); PG8_SCHED; PG8_MMAK(0, 1, At, B1, 0); PG8_SCHED; PG8_WAITB(0, B1, 1); PG8_SCHED; PG8_MMAK(0, 1, At, B1, 1); PG8_PRIO(0); PG8_BAR; PG8_SCHED;
            PG8_RDA(At, 0, 1); PG8_STAGE(PG8_SA(0, 0), a2, voffA);
            PG8_WAIT_V(10); PG8_BAR; PG8_PRIO(1); PG8_WAITA(4, At, 0); PG8_SCHED; PG8_MMAK(1, 0, At, B0, 0); PG8_SCHED; PG8_WAITA(0, At, 1); PG8_SCHED; PG8_MMAK(1, 0, At, B0, 1); PG8_PRIO(0); PG8_BAR; PG8_SCHED;
            PG8_RDB(B0, 1, 0); PG8_STAGE(PG8_SB(0, 1), b2 + hsB, voffB);
            PG8_WAIT_V(10); PG8_BAR; PG8_MMA(1, 1, At, B1); PG8_BAR; PG8_SCHED;
            PG8_RDA(At, 1, 0); PG8_STAGE(PG8_SA(0, 1), a2 + hsA, voffA);
            PG8_WAIT_V(10); PG8_BAR; PG8_PRIO(1); PG8_WAITAB(4, At, B0); PG8_SCHED; PG8_MMAK(0, 0, At, B0, 0); PG8_SCHED; PG8_WAITA(0, At, 1); PG8_SCHED; PG8_MMAK(0, 0, At, B0, 1); PG8_PRIO(0); PG8_BAR; PG8_SCHED;
            PG8_RDB(B1, 1, 1); PG8_STAGE(PG8_SB(1, 0), b3, voffB);
            PG8_WAIT_V(10); PG8_BAR; PG8_PRIO(1); PG8_WAITB(2, B1, 0); PG8_SCHED; PG8_MMAK(0, 1, At, B1, 0); PG8_SCHED; PG8_WAITB(0, B1, 1); PG8_SCHED; PG8_MMAK(0, 1, At, B1, 1); PG8_PRIO(0); PG8_BAR; PG8_SCHED;
            PG8_RDA(At, 1, 1); PG8_STAGE(PG8_SA(1, 0), a3, voffA);
            PG8_WAIT_V(10); PG8_BAR; PG8_PRIO(1); PG8_WAITA(4, At, 0); PG8_SCHED; PG8_MMAK(1, 0, At, B0, 0); PG8_SCHED; PG8_WAITA(0, At, 1); PG8_SCHED; PG8_MMAK(1, 0, At, B0, 1); PG8_PRIO(0); PG8_BAR; PG8_SCHED;
            if (!last) PG8_RDB(B0, 0, 0);
            PG8_STAGE(PG8_SB(1, 1), b3 + hsB, voffB);
            PG8_WAIT_V(10); PG8_BAR; PG8_MMA(1, 1, At, B1); PG8_BAR; PG8_SCHED;
        }
        E(acc, cur, wr, wc, fr, fq);
        if (!has_next) break;
#pragma unroll
        for (int a = 0; a < 2; ++a)
#pragma unroll
            for (int b = 0; b < 2; ++b)
#pragma unroll
                for (int m = 0; m < 4; ++m)
#pragma unroll
                    for (int n = 0; n < 2; ++n) acc[a][b][m][n] = (f32x4){0.f, 0.f, 0.f, 0.f};
        cur = nxt; cA = nA; cB = nB; ++ui;
        PG8_RDB(B0, 0, 0);
    }
    PG8_WAIT_V(0);
    if (wr == 0) PG8_BAR;
    PG8_BAR;
#undef PG8_SA
#undef PG8_SB
#undef PG8_STAGE
#undef PG8_LDA
#undef PG8_LDB
#undef PG8_MMA
#undef PG8_MMAK
#undef PG8_RDA
#undef PG8_RDB
#undef PG8_WAITA
#undef PG8_WAITB
#undef PG8_WAITAB
#undef PG8_PRIO
#undef PG8_WAIT_V
#undef PG8_WAIT_L
#undef PG8_BAR
#undef PG8_SCHED
}

typedef const f32x4 (&AccRef)[2][2][4][2];

struct EpiG1 {
    static constexpr bool PERM = true;
    bf16_t* zs; bf16_t* xbc; float* dtb; const float* dt_bias;
    __device__ __forceinline__ void operator()(AccRef acc, const Unit& u, int wr, int wc, int fr, int fq) const {
        const int row0 = u.pm * BM + wr * 64 + fr, pn = u.pn;
        if (pn < 24) {
            const bool act = pn < 8;
            bf16_t* base = act ? zs : xbc; const int ld = act ? 2048 : 4096; const int colt = act ? pn * 256 : (pn - 8) * 256;
            const int col0 = colt + wc * 32 + 8 * fq;
#pragma unroll
            for (int ai = 0; ai < 2; ++ai)
#pragma unroll
                for (int m = 0; m < 4; ++m) { bf16_t* rowp = base + (size_t)(row0 + ai * HALF + m * 16) * ld + col0;
#pragma unroll
                    for (int bj = 0; bj < 2; ++bj) { f32x4 v0 = acc[ai][bj][m][0], v1 = acc[ai][bj][m][1];
                        if (act) {
#pragma unroll
                            for (int j = 0; j < 4; ++j) { v0[j] = siluf_(v0[j]); v1[j] = siluf_(v1[j]); } }
                        *(u32x4*)(rowp + bj * HALF) = pack8(v0, v1); } }
        } else if (wc == 0) {
            const int c0 = 8 * fq; const f32x4 b0 = *(const f32x4*)(dt_bias + c0), b1 = *(const f32x4*)(dt_bias + c0 + 4);
#pragma unroll
            for (int ai = 0; ai < 2; ++ai)
#pragma unroll
                for (int m = 0; m < 4; ++m) { float* rowp = dtb + (size_t)(row0 + ai * HALF + m * 16) * 32 + c0;
                    f32x4 v0 = acc[ai][0][m][0] + b0, v1 = acc[ai][0][m][1] + b1;
#pragma unroll
                    for (int j = 0; j < 4; ++j) { v0[j] = softplusf_(v0[j]); v1[j] = softplusf_(v1[j]); }
                    *(f32x4*)rowp = v0; *(f32x4*)(rowp + 4) = v1; }
        }
    }
};
struct EpiG2 {
    static constexpr bool PERM = true;
    bf16_t* upool; bf16_t* gates; const float* b_gates;
    __device__ __forceinline__ void operator()(AccRef acc, const Unit& u, int wr, int wc, int fr, int fq) const {
        const int row0 = u.pm * BM + wr * 64 + fr, pn = u.pn;
        const bool act = pn >= 4;
        bf16_t* base = act ? gates : upool; const int ld = act ? 2048 : 1024; const int colt = act ? (pn - 4) * 256 : pn * 256;
        const int col0 = colt + wc * 32 + 8 * fq;
        f32x4 bv[2][2];
#pragma unroll
        for (int bj = 0; bj < 2; ++bj)
#pragma unroll
            for (int n = 0; n < 2; ++n) bv[bj][n] = act ? *(const f32x4*)(b_gates + col0 + bj * HALF + 4 * n) : (f32x4){0.f, 0.f, 0.f, 0.f};
#pragma unroll
        for (int ai = 0; ai < 2; ++ai)
#pragma unroll
            for (int m = 0; m < 4; ++m) { bf16_t* rowp = base + (size_t)(row0 + ai * HALF + m * 16) * ld + col0;
#pragma unroll
                for (int bj = 0; bj < 2; ++bj) { f32x4 v0 = acc[ai][bj][m][0] + bv[bj][0], v1 = acc[ai][bj][m][1] + bv[bj][1];
                    if (act) {
#pragma unroll
                        for (int j = 0; j < 4; ++j) { v0[j] = sigmoidf_(v0[j]); v1[j] = sigmoidf_(v1[j]); } }
                    *(u32x4*)(rowp + bj * HALF) = pack8(v0, v1); } }
    }
};
struct EpiPool {
    static constexpr bool PERM = true;
    bf16_t* merged; const bf16_t* gates;
    __device__ __forceinline__ void operator()(AccRef acc, const Unit& u, int wr, int wc, int fr, int fq) const {
        const int row0 = u.pm * BM + wr * 64 + fr; const int col0 = u.pn * 256 + wc * 32 + 8 * fq;
        u32x4 gw[2][4][2];
#pragma unroll
        for (int ai = 0; ai < 2; ++ai)
#pragma unroll
            for (int m = 0; m < 4; ++m)
#pragma unroll
                for (int bj = 0; bj < 2; ++bj) gw[ai][m][bj] = *(const u32x4*)(gates + (size_t)(row0 + ai * HALF + m * 16) * 2048 + col0 + bj * HALF);
#pragma unroll
        for (int ai = 0; ai < 2; ++ai)
#pragma unroll
            for (int m = 0; m < 4; ++m) { const size_t row = (size_t)(row0 + ai * HALF + m * 16);
#pragma unroll
                for (int bj = 0; bj < 2; ++bj) { f32x4 g0, g1; unpack8(gw[ai][m][bj], g0, g1);
                    const f32x4 v0 = acc[ai][bj][m][0] * g0, v1 = acc[ai][bj][m][1] * g1;
                    *(u32x4*)(merged + row * 1024 + col0 + bj * HALF) = pack8(v0, v1); } }
    }
};
struct EpiSsd {
    static constexpr bool PERM = true;
    bf16_t* merged; const bf16_t* gates;
    __device__ __forceinline__ void operator()(AccRef acc, const Unit& u, int wr, int wc, int fr, int fq) const {
        const int row0 = u.pm * BM + wr * 64 + fr; const int col0 = u.pn * 256 + wc * 32 + 8 * fq;
#pragma unroll
        for (int ai = 0; ai < 2; ++ai) {
            u32x4 gw[4][2], pw[4][2];
#pragma unroll
            for (int m = 0; m < 4; ++m)
#pragma unroll
                for (int bj = 0; bj < 2; ++bj) { const size_t row = (size_t)(row0 + ai * HALF + m * 16);
                    gw[m][bj] = *(const u32x4*)(gates + row * 2048 + 1024 + col0 + bj * HALF); pw[m][bj] = *(const u32x4*)(merged + row * 1024 + col0 + bj * HALF); }
#pragma unroll
            for (int m = 0; m < 4; ++m) { const size_t row = (size_t)(row0 + ai * HALF + m * 16);
#pragma unroll
                for (int bj = 0; bj < 2; ++bj) { f32x4 g0, g1, p0, p1; unpack8(gw[m][bj], g0, g1); unpack8(pw[m][bj], p0, p1);
                    const f32x4 v0 = p0 + acc[ai][bj][m][0] * g0, v1 = p1 + acc[ai][bj][m][1] * g1;
                    *(u32x4*)(merged + row * 1024 + col0 + bj * HALF) = pack8(v0, v1); } }
            asm volatile("" ::: "memory");
        }
    }
};
struct EpiUp {
    static constexpr bool PERM = true;
    bf16_t* upb;
    __device__ __forceinline__ void operator()(AccRef acc, const Unit& u, int wr, int wc, int fr, int fq) const {
        const int row0 = u.pm * BM + wr * 64 + fr; const int col0 = u.pn * 256 + wc * 32 + 8 * fq;
#pragma unroll
        for (int ai = 0; ai < 2; ++ai)
#pragma unroll
            for (int m = 0; m < 4; ++m) { bf16_t* rowp = upb + (size_t)(row0 + ai * HALF + m * 16) * DFF + col0;
#pragma unroll
                for (int bj = 0; bj < 2; ++bj) { f32x4 v0 = acc[ai][bj][m][0], v1 = acc[ai][bj][m][1];
#pragma unroll
                    for (int j = 0; j < 4; ++j) { const float a = fmaxf(v0[j], 0.f), b = fmaxf(v1[j], 0.f); v0[j] = a * a; v1[j] = b * b; }
                    *(u32x4*)(rowp + bj * HALF) = pack8(v0, v1); } }
    }
};
struct EpiOut {
    static constexpr bool PERM = true;
    const float* x; bf16_t* v;
    __device__ __forceinline__ void operator()(AccRef acc, const Unit& u, int wr, int wc, int fr, int fq) const {
        const int row0 = u.pm * BM + wr * 64 + fr, col0 = u.pn * BM + wc * 32 + 8 * fq;
#pragma unroll
        for (int ai = 0; ai < 2; ++ai) {
            f32x4 xv[4][2][2];
#pragma unroll
            for (int m = 0; m < 4; ++m)
#pragma unroll
                for (int bj = 0; bj < 2; ++bj)
#pragma unroll
                    for (int n = 0; n < 2; ++n) xv[m][bj][n] = *(const f32x4*)(x + (size_t)(row0 + ai * HALF + m * 16) * DM + col0 + bj * HALF + n * 4);
#pragma unroll
            for (int m = 0; m < 4; ++m) { const size_t off = (size_t)(row0 + ai * HALF + m * 16) * DM + col0;
#pragma unroll
                for (int bj = 0; bj < 2; ++bj) *(u32x4*)(v + off + bj * HALF) = pack8(xv[m][bj][0] * ALPHA + acc[ai][bj][m][0], xv[m][bj][1] * ALPHA + acc[ai][bj][m][1]); }
            asm volatile("" ::: "memory");
        }
    }
};
struct EpiDown {
    static constexpr bool PERM = true;
    const bf16_t* h1b; bf16_t* y;
    __device__ __forceinline__ void operator()(AccRef acc, const Unit& u, int wr, int wc, int fr, int fq) const {
        const int row0 = u.pm * BM + wr * 64 + fr, col0 = u.pn * BM + wc * 32 + 8 * fq;
        u32x4 hw[2][4][2];
#pragma unroll
        for (int ai = 0; ai < 2; ++ai)
#pragma unroll
            for (int m = 0; m < 4; ++m)
#pragma unroll
                for (int bj = 0; bj < 2; ++bj) hw[ai][m][bj] = *(const u32x4*)(h1b + (size_t)(row0 + ai * HALF + m * 16) * DM + col0 + bj * HALF);
#pragma unroll
        for (int ai = 0; ai < 2; ++ai)
#pragma unroll
            for (int m = 0; m < 4; ++m) { const size_t off = (size_t)(row0 + ai * HALF + m * 16) * DM + col0;
#pragma unroll
                for (int bj = 0; bj < 2; ++bj) { f32x4 h0, h1; unpack8(hw[ai][m][bj], h0, h1);
                    *(u32x4*)(y + off + bj * HALF) = pack8(h0 * ALPHA + acc[ai][bj][m][0], h1 * ALPHA + acc[ai][bj][m][1]); } }
    }
};
}

struct TrJob { const float* src; int ld_src, col0, K, ncols, nvalid; bf16_t* dst; int ld_dst; const float* cscale; };
__device__ __forceinline__ int tr_tiles(int K, int ncols) { return (K / 64) * (ncols / 256); }
__device__ __forceinline__ bool tr_pick(const Params& p, int gt, TrJob& J, int& lt) {
    unsigned char* ws = p.ws; const float* w_in = p.in[1];
    bf16_t* win1 = (bf16_t*)(ws + WS_WIN1); bf16_t* win2 = (bf16_t*)(ws + WS_WIN2);
    int base = 0, n;
#define TRJ(SRC, LDS_, COL0, K_, NC, NV, DST, LDD, CS) do { n = tr_tiles((K_), (NC)); if (gt < base + n) { J.src = (SRC); J.ld_src = (LDS_); J.col0 = (COL0); J.K = (K_); J.ncols = (NC); J.nvalid = (NV); J.dst = (DST); J.ld_dst = (LDD); J.cscale = (CS); lt = gt - base; return true; } base += n; } while (0)
    TRJ(w_in, 9248, 3072, 1024, 4096, 4096, win1 + (size_t)2048 * 1024, 1024, nullptr);
    TRJ(p.in[15], 4096, 0, 1024, 4096, 4096, (bf16_t*)(ws + WS_WUP), 1024, nullptr);
    TRJ(p.in[16], 1024, 0, 4096, 1024, 1024, (bf16_t*)(ws + WS_WDN), 4096, nullptr);
    TRJ(w_in, 9248, 1024, 1024, 2048, 2048, win1, 1024, nullptr);
    TRJ(w_in, 9248, 7200, 1024, 2048, 2048, win2 + (size_t)1024 * 1024, 1024, nullptr);
    TRJ(p.in[9], 1024, 0, 2048, 1024, 1024, (bf16_t*)(ws + WS_WSSD), 2048, nullptr);
    TRJ(w_in, 9248, 0, 1024, 1024, 1024, win2, 1024, nullptr);
    TRJ(p.in[12], 1024, 0, 1024, 1024, 1024, (bf16_t*)(ws + WS_WOUT), 1024, nullptr);
    TRJ(w_in, 9248, 7168, 1024, 256, 32, win1 + (size_t)6144 * 1024, 1024, nullptr);
    TRJ(p.in[10], 256, 0, 256, 256, 256, (bf16_t*)(ws + WS_WP), 256, p.in[11]);
    TRJ(p.in[10] + 65536, 256, 0, 256, 256, 256, (bf16_t*)(ws + WS_WP) + 65536, 256, p.in[11] + 256);
    TRJ(p.in[10] + 2 * 65536, 256, 0, 256, 256, 256, (bf16_t*)(ws + WS_WP) + 2 * 65536, 256, p.in[11] + 512);
    TRJ(p.in[10] + 3 * 65536, 256, 0, 256, 256, 256, (bf16_t*)(ws + WS_WP) + 3 * 65536, 256, p.in[11] + 768);
#undef TRJ
    return false;
}
__device__ void phase0(const Params& p, unsigned char* smem) {
    unsigned char* ws = p.ws;
    { const float* __restrict__ x = p.in[0]; bf16_t* __restrict__ xb = (bf16_t*)(ws + WS_RC);
      const size_t nvec = (size_t)T_TOK * DM / 8, stride = (size_t)gridDim.x * blockDim.x;
      for (size_t i = (size_t)blockIdx.x * blockDim.x + threadIdx.x; i < nvec; i += 4 * stride) {
          f32x4 a[4], b[4];
#pragma unroll
          for (int k = 0; k < 4; ++k) { a[k] = *(const f32x4*)(x + (i + k * stride) * 8); b[k] = *(const f32x4*)(x + (i + k * stride) * 8 + 4); }
#pragma unroll
          for (int k = 0; k < 4; ++k) *(u32x4*)(xb + (i + k * stride) * 8) = pack8(a[k], b[k]); } }
    float* t = (float*)smem;
    const int tid = threadIdx.x;
    for (int gt = blockIdx.x; ; gt += gridDim.x) {
        TrJob J; int lt;
        if (!tr_pick(p, gt, J, lt)) break;
        const int tn = J.ncols / 256; const int k0 = (lt / tn) * 64, n0 = (lt % tn) * 256;
        __syncthreads();
        float v[4][8];
#pragma unroll
        for (int sb = 0; sb < 4; ++sb)
#pragma unroll
            for (int i = 0; i < 8; ++i) { const int k = (tid >> 6) + 8 * i, n = n0 + sb * 64 + (tid & 63); const int nc = n < J.nvalid ? n : 0;
                const float ld = J.src[(size_t)(k0 + k) * J.ld_src + J.col0 + nc]; v[sb][i] = n < J.nvalid ? ld : 0.f; }
#pragma unroll
        for (int sb = 0; sb < 4; ++sb) { const float sc = J.cscale ? J.cscale[n0 + sb * 64 + (tid & 63)] : 1.0f;
#pragma unroll
            for (int i = 0; i < 8; ++i) t[(sb * 64 + (tid >> 6) + 8 * i) * 65 + (tid & 63)] = v[sb][i] * sc; }
        __syncthreads();
        const int n = tid >> 3, kk = (tid & 7) * 8;
#pragma unroll
        for (int sb = 0; sb < 4; ++sb) { float e[8];
#pragma unroll
            for (int j = 0; j < 8; ++j) e[j] = t[(sb * 64 + kk + j) * 65 + n];
            u32x4 w; w.x = cvt_pk_bf16(e[0], e[1]); w.y = cvt_pk_bf16(e[2], e[3]); w.z = cvt_pk_bf16(e[4], e[5]); w.w = cvt_pk_bf16(e[6], e[7]);
            *(u32x4*)(J.dst + (size_t)(n0 + sb * 64 + n) * J.ld_dst + k0 + kk) = w; }
    }
}

__device__ void phase_ssd_simple(const Params& p, unsigned char* smem) {
    unsigned char* ws = p.ws;
    const bf16_t* xbc = (const bf16_t*)(ws + WS_RA); bf16_t* zy = (bf16_t*)(ws + WS_RB); const float* dtb = (const float*)(ws + WS_DT);
    const float* conv_w = p.in[3]; const float* conv_b = p.in[4]; const float* a_log = p.in[6]; const float* d_skip = p.in[7]; const float* norm_w = p.in[8];
    float* sX = (float*)smem;
    float* sY = sX + 16 * 512;
    float* sdt = sY + 16 * 256;
    const int tid = threadIdx.x;
    for (int item = blockIdx.x; item < 256; item += gridDim.x) {
        const int b = item >> 3, g = item & 7;
        const int ch = tid; int gcol;
        if (ch < 256) gcol = g * 256 + ch; else if (ch < 384) gcol = 2048 + g * 128 + (ch - 256); else gcol = 3072 + g * 128 + (ch - 384);
        const float cw0 = conv_w[gcol], cw1 = conv_w[4096 + gcol], cw2 = conv_w[8192 + gcol], cw3 = conv_w[12288 + gcol], cb = conv_b[gcol];
        float u1 = 0.f, u2 = 0.f, u3 = 0.f;
        const int r = tid >> 7, pp = (tid & 127) >> 1, nh = tid & 1;
        const float a_r = -__expf(a_log[g * 4 + r]), d_r = d_skip[g * 4 + r];
        float hst[64];
#pragma unroll
        for (int i = 0; i < 64; ++i) hst[i] = 0.f;
        for (int blk = 0; blk < SEQ / 16; ++blk) {
            const size_t t0 = (size_t)b * SEQ + (size_t)blk * 16;
#pragma unroll 4
            for (int tt = 0; tt < 16; ++tt) { const float raw = bf2f(xbc[(t0 + tt) * 4096 + gcol]);
                const float y = cb + cw0 * u1 + cw1 * u2 + cw2 * u3 + cw3 * raw; u1 = u2; u2 = u3; u3 = raw;
                sX[tt * 512 + ch] = siluf_(y); }
            if (tid < 64) sdt[tid] = dtb[(t0 + (tid >> 2)) * 32 + g * 4 + (tid & 3)];
            __syncthreads();
            for (int tt = 0; tt < 16; ++tt) {
                const float dt = sdt[tt * 4 + r], dec = __expf(dt * a_r), xv = sX[tt * 512 + r * 64 + pp], xdt = xv * dt;
                const float* Bp = sX + tt * 512 + 256 + nh * 64; const float* Cp = sX + tt * 512 + 384 + nh * 64;
                float y = 0.f;
#pragma unroll
                for (int i = 0; i < 64; ++i) { hst[i] = hst[i] * dec + xdt * Bp[i]; y += hst[i] * Cp[i]; }
                y += __shfl_xor(y, 1);
                if (nh == 0) { const float zv = bf2f(zy[(t0 + tt) * 2048 + g * 256 + r * 64 + pp]); sY[tt * 256 + r * 64 + pp] = (y + d_r * xv) * zv; }
            }
            __syncthreads();
            { const int tt = tid >> 5, c0 = (tid & 31) * 8; float e[8]; float ss = 0.f;
#pragma unroll
              for (int j = 0; j < 8; ++j) { e[j] = sY[tt * 256 + c0 + j]; ss += e[j] * e[j]; }
              ss += __shfl_xor(ss, 16); ss += __shfl_xor(ss, 8); ss += __shfl_xor(ss, 4); ss += __shfl_xor(ss, 2); ss += __shfl_xor(ss, 1);
              const float rstd = rsqrtf(ss * (1.0f / 256.0f) + RMS_EPS);
              const f32x4 w0 = *(const f32x4*)(norm_w + g * 256 + c0), w1 = *(const f32x4*)(norm_w + g * 256 + c0 + 4);
              u32x4 o; o.x = cvt_pk_bf16(e[0] * rstd * w0[0], e[1] * rstd * w0[1]); o.y = cvt_pk_bf16(e[2] * rstd * w0[2], e[3] * rstd * w0[3]);
              o.z = cvt_pk_bf16(e[4] * rstd * w1[0], e[5] * rstd * w1[1]); o.w = cvt_pk_bf16(e[6] * rstd * w1[2], e[7] * rstd * w1[3]);
              *(u32x4*)(zy + (t0 + tt) * 2048 + g * 256 + c0) = o; }
            __syncthreads();
        }
    }
}


constexpr int SX_STR = 144, SN_STR = 272, SZ_STR = 528;
constexpr int O_XT = 0;
constexpr int O_BT = O_XT + 256 * SX_STR;
constexpr int O_BN = O_BT + 128 * SX_STR;
constexpr int O_CN = O_BN + 64 * SN_STR;
constexpr int O_CB = O_CN + 64 * SN_STR;
constexpr int O_ZT = O_CB + 64 * SN_STR;
constexpr int O_ACS = O_ZT + 64 * SZ_STR;
constexpr int O_DT = O_ACS + 1024;
constexpr int O_WG = O_DT + 1024;
constexpr int O_EA = O_WG + 1024;
constexpr int O_SSQ = O_EA + 1024;
constexpr int O_RSTD = O_SSQ + 2048;
constexpr int O_CW = O_RSTD + 256;
constexpr int O_RSW = O_CW + 5 * 512 * 4;
constexpr int SSD_LDS = O_RSW + 2048;
static_assert(SSD_LDS <= LDS_BYTES, "LDS");
#define MFMA16(a, b, c) __builtin_amdgcn_mfma_f32_16x16x32_bf16((a), (b), (c), 0, 0, 0)

template <int CTRL> __device__ __forceinline__ float dpp_add(float v) { return v + __builtin_bit_cast(float, __builtin_amdgcn_update_dpp(0, __builtin_bit_cast(int, v), CTRL, 0xf, 0xf, false)); }
__device__ __forceinline__ float row16_sum(float v) { v = dpp_add<0xB1>(v); v = dpp_add<0x4E>(v); v = dpp_add<0x124>(v); v = dpp_add<0x128>(v); return v; }
__device__ __forceinline__ f32x4 unpack4(u32x2 w) { return (f32x4){bf_lo(w.x), bf_hi(w.x), bf_lo(w.y), bf_hi(w.y)}; }

__device__ void phase_ssd(const Params& p, LAS unsigned char* sm) {
    unsigned char* ws = p.ws;
    const bf16_t* xbc = (const bf16_t*)(ws + WS_RA); bf16_t* zy = (bf16_t*)(ws + WS_RB); const float* dtb = (const float*)(ws + WS_DT);
    const float* conv_w = p.in[3]; const float* conv_b = p.in[4]; const float* a_log = p.in[6]; const float* d_skip = p.in[7]; const float* norm_w = p.in[8];
    const int tid = threadIdx.x, lane = tid & 63, w = __builtin_amdgcn_readfirstlane(tid >> 6), c = lane & 15, q = lane >> 4;
    const int r = w >> 1, ph = w & 1;
    const int tq = tid >> 7, ch0 = (tid & 127) * 4;
    LAS float* ACS = (LAS float*)(sm + O_ACS); LAS float* DTV = (LAS float*)(sm + O_DT); LAS float* WG = (LAS float*)(sm + O_WG); LAS float* EA = (LAS float*)(sm + O_EA);
    LAS float* SSQ = (LAS float*)(sm + O_SSQ); LAS float* RSTD = (LAS float*)(sm + O_RSTD);
    for (int item = blockIdx.x; item < 256; item += gridDim.x) {
        const int b = item >> 3, g = item & 7;
#define SSD_GCOL(CH) ((CH) < 256 ? g * 256 + (CH) : ((CH) < 384 ? 1792 + g * 128 + (CH) : 2688 + g * 128 + (CH)))
        { const int gcol = SSD_GCOL(ch0);
        __syncthreads();
        if (tq == 0) {
#pragma unroll
            for (int k = 0; k < 4; ++k) *(LAS f32x4*)(sm + O_CW + (k * 512 + ch0) * 4) = *(const f32x4*)(conv_w + k * 4096 + gcol);
            *(LAS f32x4*)(sm + O_CW + (4 * 512 + ch0) * 4) = *(const f32x4*)(conv_b + gcol); }
        __syncthreads(); }
        const float d_r = d_skip[g * 4 + r];
        const float a_w = -__expf(a_log[g * 4 + (w & 3)]);
        const int prow0 = r * 64 + ph * 32 + c;
        const float nw0 = norm_w[g * 256 + prow0], nw1 = norm_w[g * 256 + prow0 + 16];
        f32x4 accH[8][2];
#pragma unroll
        for (int nt = 0; nt < 8; ++nt)
#pragma unroll
            for (int pt = 0; pt < 2; ++pt) accH[nt][pt] = (f32x4){0.f, 0.f, 0.f, 0.f};
        u32x2 raw[19]; u32x4 zr[4]; float dtn = 0.f;
#define SSD_ISSUE_RAW(SUBN) do { int sn_ = (SUBN); asm volatile("" : "+s"(sn_)); int tid_ = tid; asm volatile("" : "+v"(tid_)); const int ch_ = (tid_ & 127) * 4; const int gc_ = SSD_GCOL(ch_); \
            const int sl0_ = sn_ * 64 + (tid_ >> 7) * 16 - 3; const bf16_t* rp_ = xbc + ((size_t)b * SEQ + (sl0_ < 0 ? 0 : sl0_)) * 4096 + gc_; \
            _Pragma("unroll") for (int i = 0; i < 19; ++i) { const int sl = sl0_ + i; \
                const u32x2 v = *(const u32x2*)(rp_ + (sl0_ < 0 ? (i < 3 ? 0 : i - 3) : i) * 4096); raw[i].x = sl < 0 ? 0u : v.x; raw[i].y = sl < 0 ? 0u : v.y; } } while (0)
#define SSD_ISSUE_Z(SUBN) do { int sn_ = (SUBN); asm volatile("" : "+s"(sn_)); int tid_ = tid; asm volatile("" : "+v"(tid_)); \
            const bf16_t* zp_ = zy + ((size_t)b * SEQ + (size_t)sn_ * 64 + (tid_ >> 5)) * 2048 + g * 256 + (tid_ & 31) * 8; \
            _Pragma("unroll") for (int k = 0; k < 4; ++k) zr[k] = *(const u32x4*)(zp_ + (size_t)k * 16 * 2048); \
            if (w < 4) dtn = dtb[((size_t)b * SEQ + (size_t)sn_ * 64 + lane) * 32 + g * 4 + w]; } while (0)
#define SSD_ISSUE(SUBN) do { SSD_ISSUE_RAW(SUBN); SSD_ISSUE_Z(SUBN); } while (0)
        SSD_ISSUE(0);
#pragma unroll 1
        for (int sub = 0; sub < SEQ / 64; ++sub) {
            const size_t t0 = (size_t)b * SEQ + (size_t)sub * 64;
            {
                const f32x4 cw0 = *(const LAS f32x4*)(sm + O_CW + ch0 * 4), cw1 = *(const LAS f32x4*)(sm + O_CW + (512 + ch0) * 4), cw2 = *(const LAS f32x4*)(sm + O_CW + (1024 + ch0) * 4),
                            cw3 = *(const LAS f32x4*)(sm + O_CW + (1536 + ch0) * 4), cbv = *(const LAS f32x4*)(sm + O_CW + (2048 + ch0) * 4);
                f32x4 u0 = unpack4(raw[0]), u1 = unpack4(raw[1]), u2 = unpack4(raw[2]);
                unsigned tr[4][8]; f32x4 pv = {0.f, 0.f, 0.f, 0.f};
                LAS unsigned char* nb = ch0 < 384 ? sm + O_BN + (ch0 - 256) * 2 : sm + O_CN + (ch0 - 384) * 2;
#pragma unroll
                for (int i = 0; i < 16; ++i) {
                    const f32x4 u3 = unpack4(raw[i + 3]);
                    f32x4 y = cbv + cw0 * u0 + cw1 * u1 + cw2 * u2 + cw3 * u3;
#pragma unroll
                    for (int j = 0; j < 4; ++j) y[j] = siluf_(y[j]);
                    if (ch0 >= 256) *(LAS u32x2*)(nb + (tq * 16 + i) * SN_STR) = (u32x2){cvt_pk_bf16(y[0], y[1]), cvt_pk_bf16(y[2], y[3])};
                    if (i & 1) {
#pragma unroll
                        for (int j = 0; j < 4; ++j) tr[j][i >> 1] = cvt_pk_bf16(pv[j], y[j]); }
                    else pv = y;
                    u0 = u1; u1 = u2; u2 = u3;
                }
                if (ch0 < 384) {
                    LAS unsigned char* tb = ch0 < 256 ? sm + O_XT + ch0 * SX_STR : sm + O_BT + (ch0 - 256) * SX_STR;
#pragma unroll
                    for (int j = 0; j < 4; ++j) { *(LAS u32x4*)(tb + j * SX_STR + tq * 32) = (u32x4){tr[j][0], tr[j][1], tr[j][2], tr[j][3]};
                        *(LAS u32x4*)(tb + j * SX_STR + tq * 32 + 16) = (u32x4){tr[j][4], tr[j][5], tr[j][6], tr[j][7]}; }
                }
            }
            if (w < 4) {
                const float dt = dtn; float x = dt * a_w;
#pragma unroll
                for (int o = 1; o < 64; o <<= 1) { const float v = __shfl_up(x, o); if (lane >= o) x += v; }
                const float last = __shfl(x, 63);
                ACS[w * 64 + lane] = x; DTV[w * 64 + lane] = dt; WG[w * 64 + lane] = dt * __expf(last - x); EA[w * 64 + lane] = __expf(x);
            }
            __syncthreads();
            {
#pragma unroll
                for (int k = 0; k < 4; ++k) { const int v = tid + 512 * k, l = v >> 5, c8 = (v & 31) * 8; *(LAS u32x4*)(sm + O_ZT + l * SZ_STR + c8 * 2) = zr[k]; }
                const int lt = w >> 1;
#pragma unroll
                for (int sti = 0; sti < 2; ++sti) { const int st = 2 * (w & 1) + sti; f32x4 acc = {0.f, 0.f, 0.f, 0.f};
#pragma unroll
                    for (int ks = 0; ks < 4; ++ks) { const bf16x8 a = *(const LAS bf16x8*)(sm + O_CN + (16 * lt + c) * SN_STR + (32 * ks + 8 * q) * 2);
                        const bf16x8 bb = *(const LAS bf16x8*)(sm + O_BN + (16 * st + c) * SN_STR + (32 * ks + 8 * q) * 2); acc = MFMA16(a, bb, acc); }
#pragma unroll
                    for (int rg = 0; rg < 4; ++rg) *(LAS float*)(sm + O_CB + (16 * lt + 4 * q + rg) * SN_STR + (16 * st + c) * 4) = acc[rg]; }
            }
            __syncthreads();
            f32x4 accY[4][2];
#pragma unroll
            for (int lt = 0; lt < 4; ++lt)
#pragma unroll
                for (int pt = 0; pt < 2; ++pt) accY[lt][pt] = (f32x4){0.f, 0.f, 0.f, 0.f};
#pragma unroll
            for (int ks = 0; ks < 4; ++ks) {
                bf16x8 hb[2];
#pragma unroll
                for (int pt = 0; pt < 2; ++pt) hb[pt] = __builtin_bit_cast(bf16x8, pack8(accH[2 * ks][pt], accH[2 * ks + 1][pt]));
#pragma unroll
                for (int lt = 0; lt < 4; ++lt) { const LAS unsigned char* cp = sm + O_CN + (16 * lt + c) * SN_STR + (32 * ks + 4 * q) * 2;
                    const u32x2 lo = *(const LAS u32x2*)cp, hi = *(const LAS u32x2*)(cp + 32);
                    const bf16x8 a = __builtin_bit_cast(bf16x8, (u32x4){lo.x, lo.y, hi.x, hi.y});
#pragma unroll
                    for (int pt = 0; pt < 2; ++pt) accY[lt][pt] = MFMA16(a, hb[pt], accY[lt][pt]); }
            }
#pragma unroll
            for (int lt = 0; lt < 4; ++lt) { const f32x4 e = *(const LAS f32x4*)(EA + r * 64 + 16 * lt + 4 * q);
#pragma unroll
                for (int pt = 0; pt < 2; ++pt) accY[lt][pt] *= e; }
            bf16x8 xf[2][2];
#pragma unroll
            for (int ks = 0; ks < 2; ++ks)
#pragma unroll
                for (int pt = 0; pt < 2; ++pt) xf[ks][pt] = *(const LAS bf16x8*)(sm + O_XT + (prow0 + 16 * pt) * SX_STR + (32 * ks + 8 * q) * 2);
#pragma unroll
            for (int lt = 0; lt < 4; ++lt)
#pragma unroll
                for (int ks = 0; ks < 2; ++ks) {
                    if (ks == 1 && lt < 2) continue;
                    const int l = 16 * lt + c; const float acl = ACS[r * 64 + l];
                    const LAS float* cbp = (const LAS float*)(sm + O_CB + l * SN_STR) + 32 * ks + 8 * q;
                    const f32x4 cb0 = *(const LAS f32x4*)cbp, cb1 = *(const LAS f32x4*)(cbp + 4);
                    const f32x4 as0 = *(const LAS f32x4*)(ACS + r * 64 + 32 * ks + 8 * q), as1 = *(const LAS f32x4*)(ACS + r * 64 + 32 * ks + 8 * q + 4);
                    const f32x4 d0 = *(const LAS f32x4*)(DTV + r * 64 + 32 * ks + 8 * q), d1 = *(const LAS f32x4*)(DTV + r * 64 + 32 * ks + 8 * q + 4);
                    f32x4 m0, m1;
#pragma unroll
                    for (int j = 0; j < 4; ++j) { const int s0 = 32 * ks + 8 * q + j, s1 = s0 + 4;
                        m0[j] = (s0 <= l) ? cb0[j] * __expf(acl - as0[j]) * d0[j] : 0.f;
                        m1[j] = (s1 <= l) ? cb1[j] * __expf(acl - as1[j]) * d1[j] : 0.f; }
                    const bf16x8 mf = __builtin_bit_cast(bf16x8, pack8(m0, m1));
#pragma unroll
                    for (int pt = 0; pt < 2; ++pt) accY[lt][pt] = MFMA16(mf, xf[ks][pt], accY[lt][pt]);
                }
#pragma unroll
            for (int lt = 0; lt < 4; ++lt) {
#pragma unroll
                for (int pt = 0; pt < 2; ++pt) { const int prow = prow0 + 16 * pt;
                    const f32x4 xv = unpack4(*(const LAS u32x2*)(sm + O_XT + prow * SX_STR + (16 * lt + 4 * q) * 2));
#pragma unroll
                    for (int rg = 0; rg < 4; ++rg) { const int l = 16 * lt + 4 * q + rg; const float zv = bf2f(*(const LAS bf16_t*)(sm + O_ZT + l * SZ_STR + prow * 2));
                        accY[lt][pt][rg] = (accY[lt][pt][rg] + d_r * xv[rg]) * zv; } }
                f32x4 sv;
#pragma unroll
                for (int rg = 0; rg < 4; ++rg) sv[rg] = row16_sum(accY[lt][0][rg] * accY[lt][0][rg] + accY[lt][1][rg] * accY[lt][1][rg]);
                if (c == 0) *(LAS f32x4*)(SSQ + w * 64 + 16 * lt + 4 * q) = sv;
            }
            SSD_ISSUE_RAW(sub + 1 < SEQ / 64 ? sub + 1 : sub);
            {
                const float dec = __expf(ACS[r * 64 + 63]);
#pragma unroll
                for (int nt = 0; nt < 8; ++nt)
#pragma unroll
                    for (int pt = 0; pt < 2; ++pt) accH[nt][pt] *= dec;
                bf16x8 xw[2][2];
#pragma unroll
                for (int ks = 0; ks < 2; ++ks) { const f32x4 w0 = *(const LAS f32x4*)(WG + r * 64 + 32 * ks + 8 * q), w1 = *(const LAS f32x4*)(WG + r * 64 + 32 * ks + 8 * q + 4);
#pragma unroll
                    for (int pt = 0; pt < 2; ++pt) { f32x4 a, bq; unpack8(__builtin_bit_cast(u32x4, xf[ks][pt]), a, bq); xw[ks][pt] = __builtin_bit_cast(bf16x8, pack8(a * w0, bq * w1)); } }
#pragma unroll
                for (int nt = 0; nt < 8; ++nt)
#pragma unroll
                    for (int ks = 0; ks < 2; ++ks) { const bf16x8 bfr = *(const LAS bf16x8*)(sm + O_BT + (16 * nt + c) * SX_STR + (32 * ks + 8 * q) * 2);
#pragma unroll
                        for (int pt = 0; pt < 2; ++pt) accH[nt][pt] = MFMA16(bfr, xw[ks][pt], accH[nt][pt]); }
            }
            SSD_ISSUE_Z(sub + 1 < SEQ / 64 ? sub + 1 : sub);
            __syncthreads();
            { float s = 0.f;
#pragma unroll
              for (int k = 0; k < 8; ++k) s += SSQ[k * 64 + lane];
              LAS float* RSW = (LAS float*)(sm + O_RSW) + w * 64;
              RSW[lane] = rsqrtf(s * (1.0f / 256.0f) + RMS_EPS);
#pragma unroll
              for (int lt = 0; lt < 4; ++lt) { const f32x4 rs = *(const LAS f32x4*)(RSW + 16 * lt + 4 * q);
#pragma unroll
                for (int pt = 0; pt < 2; ++pt) { const float nw = pt ? nw1 : nw0;
#pragma unroll
                    for (int rg = 0; rg < 4; ++rg) { const int l = 16 * lt + 4 * q + rg;
                        *(LAS bf16_t*)(sm + O_ZT + l * SZ_STR + (prow0 + 16 * pt) * 2) = (bf16_t)(cvt_pk_bf16(accY[lt][pt][rg] * rs[rg] * nw, 0.f) & 0xffffu); } } }
#pragma unroll
              for (int k = 0; k < 4; ++k) { const int row = (lane >> 2) + 16 * k, pc = lane & 3;
                *(u32x4*)(zy + (t0 + row) * 2048 + g * 256 + r * 64 + ph * 32 + pc * 8) = *(const LAS u32x4*)(sm + O_ZT + row * SZ_STR + (r * 64 + ph * 32 + pc * 8) * 2); }
            }
        }
    }
}

template <int W>
__device__ __forceinline__ void pool_task(const bf16_t* __restrict__ colp, bf16_t* __restrict__ outp, int t0, int s0) {
    constexpr int RUN = 16, H = W - 1;
    u32x4 rw[RUN + H];
#pragma unroll
    for (int j = 0; j < RUN + H; ++j) { int tt = t0 - H + j; tt = tt < 0 ? 0 : tt; rw[j] = *(const u32x4*)(colp + (size_t)tt * 1024); }
    f32x4 S0 = {0.f, 0.f, 0.f, 0.f}, S1 = {0.f, 0.f, 0.f, 0.f};
#pragma unroll
    for (int j = 1; j <= H; ++j) { f32x4 a, b; unpack8(rw[H - j], a, b); const bool ok = (s0 - j >= 0); S0 += ok ? a : (f32x4){0.f, 0.f, 0.f, 0.f}; S1 += ok ? b : (f32x4){0.f, 0.f, 0.f, 0.f}; }
#pragma unroll
    for (int tt = 0; tt < RUN; ++tt) { const int s = s0 + tt;
        f32x4 a, b; unpack8(rw[H + tt], a, b); S0 += a; S1 += b;
        const float inv = 1.0f / (float)(s + 1 < W ? s + 1 : W);
        *(u32x4*)(outp + (size_t)(t0 + tt) * 1024) = pack8(S0 * inv - a, S1 * inv - b);
        f32x4 c, d; unpack8(rw[tt], c, d);
        if (s - W + 1 >= 0) { S0 -= c; S1 -= d; } }
}
__device__ void phase_pool(const Params& p) {
    const bf16_t* up = (const bf16_t*)(p.ws + WS_RA); bf16_t* pooled = (bf16_t*)(p.ws + WS_RA + 384 * MiB);
    const int ntask = (T_TOK / 16) * 128;
    for (int idx = blockIdx.x * blockDim.x + threadIdx.x; idx < ntask; idx += gridDim.x * blockDim.x) {
        const int widx = __builtin_amdgcn_readfirstlane(idx >> 6), gi = widx & 3;
        const int vec = gi * 32 + (idx & 31), run = (widx >> 2) * 2 + ((idx >> 5) & 1);
        const int t0 = run * 16, s0 = t0 & (SEQ - 1);
        const bf16_t* colp = up + vec * 8; bf16_t* outp = pooled + vec * 8;
        if (gi == 0) pool_task<2>(colp, outp, t0, s0); else if (gi == 1) pool_task<4>(colp, outp, t0, s0);
        else if (gi == 2) pool_task<8>(colp, outp, t0, s0); else pool_task<16>(colp, outp, t0, s0);
    }
}

template <bool OUT_BF16>
__device__ void phase_ln(const bf16_t* __restrict__ src, void* __restrict__ dst, const float* __restrict__ gam, const float* __restrict__ bet) {
    const int lane = threadIdx.x & 63, wv = threadIdx.x >> 6;
    f32x4 gv[4], bv[4];
#pragma unroll
    for (int i = 0; i < 2; ++i) { gv[2 * i] = *(const f32x4*)(gam + lane * 8 + 512 * i); gv[2 * i + 1] = *(const f32x4*)(gam + lane * 8 + 512 * i + 4);
        bv[2 * i] = *(const f32x4*)(bet + lane * 8 + 512 * i); bv[2 * i + 1] = *(const f32x4*)(bet + lane * 8 + 512 * i + 4); }
    for (int row0 = (blockIdx.x * 8 + wv) * 4; row0 < T_TOK; row0 += gridDim.x * 8 * 4) {
        u32x4 rw[4][2];
#pragma unroll
        for (int rr = 0; rr < 4; ++rr)
#pragma unroll
            for (int i = 0; i < 2; ++i) rw[rr][i] = *(const u32x4*)(src + (size_t)(row0 + rr) * DM + lane * 8 + 512 * i);
#pragma unroll
        for (int rr = 0; rr < 4; ++rr) {
            f32x4 v[4]; unpack8(rw[rr][0], v[0], v[1]); unpack8(rw[rr][1], v[2], v[3]);
            float s = 0.f;
#pragma unroll
            for (int i = 0; i < 4; ++i) s += (v[i][0] + v[i][1]) + (v[i][2] + v[i][3]);
#pragma unroll
            for (int o = 32; o >= 1; o >>= 1) s += __shfl_xor(s, o);
            const float mu = s * (1.0f / 1024.0f); float q = 0.f;
#pragma unroll
            for (int i = 0; i < 4; ++i) { v[i] -= mu; q += (v[i][0] * v[i][0] + v[i][1] * v[i][1]) + (v[i][2] * v[i][2] + v[i][3] * v[i][3]); }
#pragma unroll
            for (int o = 32; o >= 1; o >>= 1) q += __shfl_xor(q, o);
            const float rstd = rsqrtf(q * (1.0f / 1024.0f) + LN_EPS);
#pragma unroll
            for (int i = 0; i < 2; ++i) { const f32x4 o0 = v[2 * i] * rstd * gv[2 * i] + bv[2 * i], o1 = v[2 * i + 1] * rstd * gv[2 * i + 1] + bv[2 * i + 1];
                if (OUT_BF16) *(u32x4*)((bf16_t*)dst + (size_t)(row0 + rr) * DM + lane * 8 + 512 * i) = pack8(o0, o1);
                else { float* op = (float*)dst + (size_t)(row0 + rr) * DM + lane * 8 + 512 * i; *(f32x4*)op = o0; *(f32x4*)(op + 4) = o1; } }
        }
    }
}

__global__ void __launch_bounds__(512, 2) mega(Params p) {
    extern __shared__ __attribute__((aligned(16))) unsigned char lds_raw[];
    LAS unsigned char* lds = (LAS unsigned char*)lds_raw;
    cg::grid_group grid = cg::this_grid();
    unsigned char* ws = p.ws;
    const int G = gridDim.x, c = blockIdx.x;
#ifndef PHMASK
#define PHMASK 0x7ff
#endif
#define IN(k) (((PHMASK >> (k)) & 1) && p.ph_lo <= (k) && (k) < p.ph_hi)
#define SEAM(k) do { if (IN(k) && IN((k) + 1)) grid.sync(); } while (0)
    if (IN(0)) phase0(p, lds_raw);
    SEAM(0);
    if (IN(1)) {
        pg8::Gemm g{(const bf16_t*)(ws + WS_RC), (const bf16_t*)(ws + WS_WIN1), T_TOK, N1, 1024, 1024, 1024, 0};
        pg8::StaticOrder S; S.init(T_TOK, N1, G, c);
        pg8::EpiG1 E{(bf16_t*)(ws + WS_RB), (bf16_t*)(ws + WS_RA), (float*)(ws + WS_DT), p.in[5]};
        pg8::gemm_phase<pg8::EpiG1>(lds, g, S, E);
    }
    SEAM(1);
    #ifdef SSD_SIMPLE
    if (IN(2)) phase_ssd_simple(p, lds_raw);
#else
    if (IN(2)) phase_ssd(p, lds);
#endif
    SEAM(2);
    if (IN(3)) {
        pg8::Gemm g{(const bf16_t*)(ws + WS_RC), (const bf16_t*)(ws + WS_WIN2), T_TOK, N2, 1024, 1024, 1024, 0};
        pg8::StaticOrder S; S.init(T_TOK, N2, G, c);
        pg8::EpiG2 E{(bf16_t*)(ws + WS_RA), (bf16_t*)(ws + WS_RA + 128 * MiB), p.in[2]};
        pg8::gemm_phase<pg8::EpiG2>(lds, g, S, E);
    }
    SEAM(3);
    if (IN(4)) phase_pool(p);
    SEAM(4);
    if (IN(5)) {
        bf16_t* merged = (bf16_t*)(ws + WS_RC); const bf16_t* gates = (const bf16_t*)(ws + WS_RA + 128 * MiB);
        pg8::StaticOrder S; S.init(T_TOK, 1024, G, c);
#ifndef NO_P5A
        { pg8::Gemm g{(const bf16_t*)(ws + WS_RA + 384 * MiB), (const bf16_t*)(ws + WS_WP), T_TOK, 1024, 256, 1024, 256, 512};
          pg8::EpiPool E{merged, gates};
          pg8::gemm_phase<pg8::EpiPool>(lds, g, S, E); }
#endif
#ifndef NO_P5B
        { pg8::Gemm g{(const bf16_t*)(ws + WS_RB), (const bf16_t*)(ws + WS_WSSD), T_TOK, 1024, 2048, 2048, 2048, 0};
          pg8::EpiSsd E{merged, gates};
          pg8::gemm_phase<pg8::EpiSsd>(lds, g, S, E); }
#endif
    }
    SEAM(5);
    if (IN(6)) {
        pg8::Gemm g{(const bf16_t*)(ws + WS_RC), (const bf16_t*)(ws + WS_WOUT), T_TOK, 1024, 1024, 1024, 1024, 0};
        pg8::StaticOrder S; S.init(T_TOK, 1024, G, c);
        pg8::EpiOut E{p.in[0], (bf16_t*)(ws + WS_RB)};
        pg8::gemm_phase<pg8::EpiOut>(lds, g, S, E);
    }
    SEAM(6);
    if (IN(7)) phase_ln<true>((const bf16_t*)(ws + WS_RB), (void*)(ws + WS_RC), p.in[13], p.in[14]);
    SEAM(7);
    if (IN(8)) {
        pg8::Gemm g{(const bf16_t*)(ws + WS_RC), (const bf16_t*)(ws + WS_WUP), T_TOK, DFF, 1024, 1024, 1024, 0};
        pg8::StaticOrder S; S.init(T_TOK, DFF, G, c);
        pg8::EpiUp E{(bf16_t*)(ws + WS_RA)};
        pg8::gemm_phase<pg8::EpiUp>(lds, g, S, E);
    }
    SEAM(8);
    if (IN(9)) {
        pg8::Gemm g{(const bf16_t*)(ws + WS_RA), (const bf16_t*)(ws + WS_WDN), T_TOK, 1024, DFF, DFF, DFF, 0};
        pg8::StaticOrder S; S.init(T_TOK, 1024, G, c);
        pg8::EpiDown E{(const bf16_t*)(ws + WS_RC), (bf16_t*)(ws + WS_RB)};
        pg8::gemm_phase<pg8::EpiDown>(lds, g, S, E);
    }
    SEAM(9);
    if (IN(10)) phase_ln<false>((const bf16_t*)(ws + WS_RB), (void*)p.out, p.in[17], p.in[18]);
#undef IN
#undef SEAM
}

#ifndef DUPMASK
#define DUPMASK 0
#endif
#ifndef ONE_LAUNCH
#define ONE_LAUNCH 1
#endif
extern "C" void kernel_launch(void* const* d_in, const int* in_sizes, int n_in, void* d_out, int out_size, void* d_ws, size_t ws_size, hipStream_t stream) {
    static int grid = 0;
    if (grid == 0) {
        if (n_in != 19 || ws_size < WS_END) { fprintf(stderr, "kernel_launch: need 19 inputs and >= %zu bytes of workspace; got %d, %zu\n", (size_t)WS_END, n_in, ws_size); grid = -1; return; }
        int dev = 0, cus = 0, per_cu = 0;
        hipGetDevice(&dev); hipDeviceGetAttribute(&cus, hipDeviceAttributeMultiprocessorCount, dev);
        if (hipFuncSetAttribute((const void*)mega, hipFuncAttributeMaxDynamicSharedMemorySize, LDS_BYTES) != hipSuccess) { fprintf(stderr, "kernel_launch: hipFuncSetAttribute failed\n"); grid = -1; return; }
        if (hipOccupancyMaxActiveBlocksPerMultiprocessor(&per_cu, (const void*)mega, 512, LDS_BYTES) != hipSuccess || per_cu < 1) { fprintf(stderr, "kernel_launch: occupancy query says %d\n", per_cu); per_cu = 1; }
        (void)hipGetLastError();
        grid = cus;
    }
    if (grid < 0) return;
    Params p{};
    for (int i = 0; i < 19; ++i) p.in[i] = (const float*)d_in[i];
    p.out = (float*)d_out; p.ws = (unsigned char*)d_ws;
#if ONE_LAUNCH
    p.ph_lo = 0; p.ph_hi = NPHASE;
    void* args[] = {&p};
    hipError_t e = hipLaunchCooperativeKernel((const void*)mega, dim3(grid), dim3(512), args, LDS_BYTES, stream);
    if (e != hipSuccess) fprintf(stderr, "cooperative launch failed: %s (grid %d)\n", hipGetErrorString(e), grid);
#else
    for (int ph = 0; ph < NPHASE; ++ph) { p.ph_lo = ph; p.ph_hi = ph + 1;
        for (int rep = 0; rep < (((DUPMASK >> ph) & 1) ? 2 : 1); ++rep) hipLaunchKernelGGL(mega, dim3(grid), dim3(512), LDS_BYTES, stream, p); }
#endif
}
```

```cpp
#include <hip/hip_runtime.h>
#include <hip/hip_cooperative_groups.h>
#include <cstdio>
namespace cg = cooperative_groups;

#define LAS __attribute__((address_space(3)))
typedef unsigned short bf16_t;
typedef short bf16x8 __attribute__((ext_vector_type(8)));
typedef float f32x4 __attribute__((ext_vector_type(4)));
typedef float f32x2 __attribute__((ext_vector_type(2)));
typedef unsigned u32x4 __attribute__((ext_vector_type(4)));
typedef unsigned u32x2 __attribute__((ext_vector_type(2)));

constexpr int T_TOK = 65536, SEQ = 2048, DM = 1024, DFF = 4096;
constexpr int N1 = 6400;
constexpr int N2 = 3072;
constexpr float ALPHA = 1.189207115002721f;
constexpr float LN_EPS = 1e-5f, RMS_EPS = 1e-5f;
constexpr size_t MiB = 1024ull * 1024ull;
constexpr size_t WS_RA = 0;
constexpr size_t WS_RB = 512 * MiB;
constexpr size_t WS_RC = 768 * MiB;
constexpr size_t WS_DT = 896 * MiB;
constexpr size_t WS_W  = 904 * MiB;
constexpr size_t WS_WIN1 = WS_W;
constexpr size_t WS_WIN2 = WS_WIN1 + (size_t)N1 * 1024 * 2;
constexpr size_t WS_WP   = WS_WIN2 + (size_t)N2 * 1024 * 2;
constexpr size_t WS_WSSD = WS_WP + (size_t)1024 * 256 * 2;
constexpr size_t WS_WOUT = WS_WSSD + (size_t)1024 * 2048 * 2;
constexpr size_t WS_WUP  = WS_WOUT + (size_t)1024 * 1024 * 2;
constexpr size_t WS_WDN  = WS_WUP + (size_t)4096 * 1024 * 2;
constexpr size_t WS_END  = WS_WDN + (size_t)4096 * 1024 * 2;
constexpr int LDS_BYTES = 160000;
constexpr int NPHASE = 11;

struct Params { const float* in[19]; float* out; unsigned char* ws; int ph_lo, ph_hi; };

__device__ __forceinline__ unsigned cvt_pk_bf16(float lo, float hi) { unsigned r; asm volatile("v_cvt_pk_bf16_f32 %0, %1, %2" : "=v"(r) : "v"(lo), "v"(hi)); return r; }
__device__ __forceinline__ float bf_lo(unsigned u) { return __uint_as_float(u << 16); }
__device__ __forceinline__ float bf_hi(unsigned u) { return __uint_as_float(u & 0xffff0000u); }
__device__ __forceinline__ float bf2f(bf16_t b) { return __uint_as_float(((unsigned)b) << 16); }
__device__ __forceinline__ float sigmoidf_(float v) { return __builtin_amdgcn_rcpf(1.0f + __expf(-v)); }
__device__ __forceinline__ float siluf_(float v) { return v * __builtin_amdgcn_rcpf(1.0f + __expf(-v)); }
__device__ __forceinline__ float softplusf_(float v) { return fmaxf(v, 0.f) + log1pf(__expf(-fabsf(v))); }
__device__ __forceinline__ u32x4 pack8(f32x4 a, f32x4 b) { u32x4 w; w.x = cvt_pk_bf16(a[0], a[1]); w.y = cvt_pk_bf16(a[2], a[3]); w.z = cvt_pk_bf16(b[0], b[1]); w.w = cvt_pk_bf16(b[2], b[3]); return w; }
__device__ __forceinline__ void unpack8(u32x4 w, f32x4& a, f32x4& b) { a = (f32x4){bf_lo(w.x), bf_hi(w.x), bf_lo(w.y), bf_hi(w.y)}; b = (f32x4){bf_lo(w.z), bf_hi(w.z), bf_lo(w.w), bf_hi(w.w)}; }

namespace pg8 {
constexpr int BM = 256, BK = 64, HALF = 128, HTB = HALF * BK * 2, STAGE_BYTES = 8 * HTB, NXCD = 8, WGM = 8;
__device__ __forceinline__ int lds_byte(int r, int c) { const int st = (r >> 4) * 2 + (c >> 5), rr = r & 15, cc = c & 31, ob = rr * 64 + cc * 2; return st * 1024 + (ob ^ (((ob >> 9) & 1) << 5)); }
__device__ __forceinline__ void stage_rc(int b, int& R, int& C) { const int st = b / 1024, sb = b % 1024, swz = sb ^ (((sb >> 9) & 1) << 5); R = (st >> 1) * 16 + swz / 64; C = (st & 1) * 32 + (swz % 64) / 2; }
__device__ __forceinline__ int perm32(int rho) { const int n = rho >> 4, i = rho & 15; return 8 * (i >> 2) + 4 * n + (i & 3); }
struct Unit { int pm, pn; };
struct Gemm { const bf16_t* A; const bf16_t* Bt; int M, N, K, lda, ldb, a_pn_bytes; };
struct StaticOrder {
    int nM, nN, nwg, G, c;
    __device__ void init(int M, int N, int G_, int c_) { nM = M / BM; nN = N / BM; nwg = nM * nN; G = G_; c = c_; }
    __device__ bool next(int i, Unit& u) const {
        const long L = (long)i * G + c; if (L >= nwg) return false;
        int wgid = (int)L; { const int q = nwg / NXCD, r = nwg % NXCD, xcd = wgid % NXCD, off = wgid / NXCD; wgid = (xcd < r ? xcd * (q + 1) : r * (q + 1) + (xcd - r) * q) + off; }
        const int nig = WGM * nN, gid = wgid / nig, fm = gid * WGM, gsz = (nM - fm) < WGM ? (nM - fm) : WGM;
        u.pm = fm + ((wgid % nig) % gsz); u.pn = (wgid % nig) / gsz; return true;
    }
};

template <int OFF> __device__ __forceinline__ void ds_rd128(bf16x8& dst, unsigned addr) { asm volatile("ds_read_b128 %0, %1 offset:%2" : "=v"(dst) : "v"(addr), "n"(OFF)); }
template <class Epi>
__device__ __forceinline__ void gemm_phase(LAS unsigned char* lds, const Gemm g, const StaticOrder& S, const Epi& E) {
    int tid_l = threadIdx.x; asm volatile("" : "+v"(tid_l));
    const int tid = tid_l, wid = __builtin_amdgcn_readfirstlane(tid >> 6), lane = tid & 63, wr = wid >> 2, wc = wid & 3, fr = lane & 15, fq = lane >> 4;
    const int K = g.K, nt = K / BK;
    unsigned voffA[2], voffB[2];
#pragma unroll
    for (int i = 0; i < 2; ++i) { int R, C; stage_rc(tid * 16 + i * 8192, R, C); const int Rb = Epi::PERM ? ((R & ~31) + perm32(R & 31)) : R;
        voffA[i] = (unsigned)(R * g.lda + C) * 2u; voffB[i] = (unsigned)(Rb * g.ldb + C) * 2u; }
    const size_t kstep = (size_t)(BK * 2);
    const size_t hsA = (size_t)HALF * g.lda * 2, hsB = (size_t)HALF * g.ldb * 2;
    const size_t tsA = 2 * hsA, tsB = 2 * hsB;
    const unsigned ldsw = (unsigned)wid * 1024u;
    const int aoff = lds_byte(wr * 64 + fr, fq * 8), boff = lds_byte(wc * 32 + fr, fq * 8);
    const unsigned aaddr = (unsigned)(unsigned long long)(lds + aoff), baddr = (unsigned)(unsigned long long)(lds + 4 * HTB + boff);
#define PG8_SA(b, h) (((b) * 2 + (h)) * HTB)
#define PG8_SB(b, h) ((4 + (b) * 2 + (h)) * HTB)
#define PG8_STAGE(bufoff, gbase, voff) do { _Pragma("unroll") for (int _i = 0; _i < 2; ++_i) \
        __builtin_amdgcn_global_load_lds((const unsigned*)((const char*)(gbase) + (voff)[_i]), (LAS unsigned*)(lds + (bufoff) + ldsw + _i * 8192), 16, 0, 0); } while (0)
#define PG8_LDA(dst, b, h) do { _Pragma("unroll") for (int m = 0; m < 4; ++m) _Pragma("unroll") for (int k = 0; k < 2; ++k) dst[m][k] = *(const LAS bf16x8*)(lds + PG8_SA(b, h) + aoff + m * 2048 + k * 1024); } while (0)
#define PG8_LDB(dst, b, h) do { _Pragma("unroll") for (int n = 0; n < 2; ++n) _Pragma("unroll") for (int k = 0; k < 2; ++k) dst[n][k] = *(const LAS bf16x8*)(lds + PG8_SB(b, h) + boff + n * 2048 + k * 1024); } while (0)
#define PG8_MMA(ai, bj, At, Bt) do { __builtin_amdgcn_s_setprio(1); _Pragma("unroll") for (int m = 0; m < 4; ++m) _Pragma("unroll") for (int n = 0; n < 2; ++n) _Pragma("unroll") for (int k = 0; k < 2; ++k) \
        acc[ai][bj][m][n] = __builtin_amdgcn_mfma_f32_16x16x32_bf16(Bt[n][k], At[m][k], acc[ai][bj][m][n], 0, 0, 0); __builtin_amdgcn_s_setprio(0); } while (0)
#define PG8_RDA(dst, b, h) do { ds_rd128<PG8_SA(b, h) + 0 * 2048>(dst[0][0], aaddr); ds_rd128<PG8_SA(b, h) + 1 * 2048>(dst[1][0], aaddr); ds_rd128<PG8_SA(b, h) + 2 * 2048>(dst[2][0], aaddr); ds_rd128<PG8_SA(b, h) + 3 * 2048>(dst[3][0], aaddr); \
        ds_rd128<PG8_SA(b, h) + 0 * 2048 + 1024>(dst[0][1], aaddr); ds_rd128<PG8_SA(b, h) + 1 * 2048 + 1024>(dst[1][1], aaddr); ds_rd128<PG8_SA(b, h) + 2 * 2048 + 1024>(dst[2][1], aaddr); ds_rd128<PG8_SA(b, h) + 3 * 2048 + 1024>(dst[3][1], aaddr); } while (0)
#define PG8_RDB(dst, b, h) do { ds_rd128<PG8_SA(b, h)>(dst[0][0], baddr); ds_rd128<PG8_SA(b, h) + 2048>(dst[1][0], baddr); ds_rd128<PG8_SA(b, h) + 1024>(dst[0][1], baddr); ds_rd128<PG8_SA(b, h) + 2048 + 1024>(dst[1][1], baddr); } while (0)
#define PG8_WAITA(n, F, k) asm volatile("s_waitcnt lgkmcnt(" #n ")" : "+v"(F[0][k]), "+v"(F[1][k]), "+v"(F[2][k]), "+v"(F[3][k]) :: "memory")
#define PG8_WAITB(n, F, k) asm volatile("s_waitcnt lgkmcnt(" #n ")" : "+v"(F[0][k]), "+v"(F[1][k]) :: "memory")
#define PG8_WAITAB(n, FA, FB) asm volatile("s_waitcnt lgkmcnt(" #n ")" : "+v"(FA[0][0]), "+v"(FA[1][0]), "+v"(FA[2][0]), "+v"(FA[3][0]), "+v"(FB[0][0]), "+v"(FB[1][0]), "+v"(FB[0][1]), "+v"(FB[1][1]) :: "memory")
#define PG8_MMAK(ai, bj, At, Bt, k) do { _Pragma("unroll") for (int m = 0; m < 4; ++m) _Pragma("unroll") for (int n = 0; n < 2; ++n) \
        acc[ai][bj][m][n] = __builtin_amdgcn_mfma_f32_16x16x32_bf16(Bt[n][k], At[m][k], acc[ai][bj][m][n], 0, 0, 0); } while (0)
#define PG8_PRIO(x) __builtin_amdgcn_s_setprio(x)
#define PG8_WAIT_V(n) asm volatile("s_waitcnt vmcnt(" #n ")" ::: "memory")
#define PG8_WAIT_L(n) asm volatile("s_waitcnt lgkmcnt(" #n ")" ::: "memory")
#define PG8_BAR __builtin_amdgcn_s_barrier()
#define PG8_SCHED __builtin_amdgcn_sched_barrier(0)
    Unit cur, nxt; int ui = 0;
    if (!S.next(0, cur)) return;
    f32x4 acc[2][2][4][2];
#pragma unroll
    for (int a = 0; a < 2; ++a)
#pragma unroll
        for (int b = 0; b < 2; ++b)
#pragma unroll
            for (int m = 0; m < 4; ++m)
#pragma unroll
                for (int n = 0; n < 2; ++n) acc[a][b][m][n] = (f32x4){0.f, 0.f, 0.f, 0.f};
    bf16x8 At[4][2], B0[2][2], B1[2][2];
    const char* cA = (const char*)g.A + (size_t)cur.pm * tsA + (size_t)cur.pn * g.a_pn_bytes; const char* cB = (const char*)g.Bt + (size_t)cur.pn * tsB;
    PG8_STAGE(PG8_SB(0, 0), cB, voffB); PG8_STAGE(PG8_SA(0, 0), cA, voffA); PG8_STAGE(PG8_SB(0, 1), cB + hsB, voffB); PG8_STAGE(PG8_SA(0, 1), cA + hsA, voffA);
    if (wr == 1) PG8_BAR;
    PG8_WAIT_V(4); PG8_BAR;
    PG8_STAGE(PG8_SB(1, 0), cB + kstep, voffB); PG8_STAGE(PG8_SA(1, 0), cA + kstep, voffA); PG8_STAGE(PG8_SB(1, 1), cB + hsB + kstep, voffB);
    PG8_WAIT_V(6); PG8_BAR;
    PG8_RDB(B0, 0, 0);
    for (;;) {
        const bool has_next = S.next(ui + 1, nxt);
        const char* nA = has_next ? (const char*)g.A + (size_t)nxt.pm * tsA + (size_t)nxt.pn * g.a_pn_bytes : cA; const char* nB = has_next ? (const char*)g.Bt + (size_t)nxt.pn * tsB : cB;
#pragma unroll 1
        for (int t = 0; t < nt; t += 2) {
            const bool last = (t == nt - 2);
            const char* a1 = cA + (size_t)(t + 1) * kstep;
            const char* a2 = last ? nA : cA + (size_t)(t + 2) * kstep; const char* b2 = last ? nB : cB + (size_t)(t + 2) * kstep;
            const char* a3 = a2 + kstep; const char* b3 = b2 + kstep;
            PG8_RDA(At, 0, 0); PG8_STAGE(PG8_SA(1, 1), a1 + hsA, voffA);
            PG8_WAIT_V(10); PG8_BAR; PG8_PRIO(1); PG8_WAITAB(4, At, B0); PG8_SCHED; PG8_MMAK(0, 0, At, B0, 0); PG8_SCHED; PG8_WAITA(0, At, 1); PG8_SCHED; PG8_MMAK(0, 0, At, B0, 1); PG8_PRIO(0); PG8_BAR; PG8_SCHED;
            PG8_RDB(B1, 0, 1); PG8_STAGE(PG8_SB(0, 0), b2, voffB);
            PG8_WAIT_V(10); PG8_BAR; PG8_PRIO(1); PG8_WAITB(2, B1, 0); PG8_SCHED; PG8_MMAK(0, 1, At, B1, 0); PG8_SCHED; PG8_WAITB(0, B1, 1); PG8_SCHED; PG8_MMAK(0, 1, At, B1, 1); PG8_PRIO(0); PG8_BAR; PG8_SCHED;
            PG8_RDA(At, 0, 1); PG8_STAGE(PG8_SA(0, 0), a2, voffA);
            PG8_WAIT_V(10); PG8_BAR; PG8_PRIO(1); PG8_WAITA(4, At, 0); PG8_SCHED; PG8_MMAK(1, 0, At, B0, 0); PG8_SCHED; PG8_WAITA(0, At, 1); PG8_SCHED; PG8_MMAK(1, 0, At, B0, 1); PG8_PRIO(0); PG8_BAR; PG8_SCHED;
            PG8_RDB(B0, 1, 0); PG8_STAGE(PG8_SB(0, 1), b2 + hsB, voffB);
            PG8_WAIT_V(10); PG8_BAR; PG8_MMA(1, 1, At, B1); PG8_BAR; PG8_SCHED;
            PG8_RDA(At, 1, 0); PG8_STAGE(PG8_SA(0, 1), a2 + hsA, voffA);
            PG8_WAIT_V(10); PG8_BAR; PG8_PRIO(1); PG8_WAITAB(4, At, B0); PG8_SCHED; PG8_MMAK(0, 0, At, B0, 0); PG8_SCHED; PG8_WAITA(0, At, 1); PG8_SCHED; PG8_MMAK(0, 0, At, B0, 1); PG8_PRIO(0); PG8_BAR; PG8_SCHED;
            PG8_RDB(B1, 1, 1); PG8_STAGE(PG8_SB(1, 0), b3, voffB);
            PG8_WAIT_V(10); PG8_BAR; PG8_PRIO(1); PG8_WAITB(2, B1, 0); PG8_SCHED; PG8_MMAK(0, 1, At, B1, 0); PG8_SCHED; PG8_WAITB(0, B1, 1); PG8_SCHED; PG8_MMAK(0, 1, At, B1, 1); PG8_PRIO(0); PG8_BAR; PG8_SCHED;
            PG8_RDA(At, 1, 1); PG8_STAGE(PG8_SA(1, 0), a3, voffA);
            PG8_WAIT_V(10); PG8_BAR; PG8_PRIO(1); PG8_WAITA(4, At, 0); PG8_SCHED; PG8_MMAK(1, 0, At, B0, 0); PG8_SCHED; PG8_WAITA(0, At, 1); PG8_SCHED; PG8_MMAK(1, 0, At, B0, 1); PG8_PRIO(0); PG8_BAR; PG8_SCHED;
            if (!last) PG8_RDB(B0, 0, 0);
            PG8_STAGE(PG8_SB(1, 1), b3 + hsB, voffB);
            PG8_WAIT_V(10); PG8_BAR; PG8_MMA(1, 1, At, B1); PG8_BAR; PG8_SCHED;
        }
        E(acc, cur, wr, wc, fr, fq);
        if (!has_next) break;
#pragma unroll
        for (int a = 0; a < 2; ++a)
#pragma unroll
            for (int b = 0; b < 2; ++b)
#pragma unroll
                for (int m = 0; m < 4; ++m)
#pragma unroll
                    for (int n = 0; n < 2; ++n) acc[a][b][m][n] = (f32x4){0.f, 0.f, 0.f, 0.f};
        cur = nxt; cA = nA; cB = nB; ++ui;
        PG8_RDB(B0, 0, 0);
    }
    PG8_WAIT_V(0);
    if (wr == 0) PG8_BAR;
    PG8_BAR;
#undef PG8_SA
#undef PG8_SB
#undef PG8_STAGE
#undef PG8_LDA
#undef PG8_LDB
#undef PG8_MMA
#undef PG8_MMAK
#undef PG8_RDA
#undef PG8_RDB
#undef PG8_WAITA
#undef PG8_WAITB
#undef PG8_WAITAB
#undef PG8_PRIO
#undef PG8_WAIT_V
#undef PG8_WAIT_L
#undef PG8_BAR
#undef PG8_SCHED
}

typedef const f32x4 (&AccRef)[2][2][4][2];

struct EpiG1 {
    static constexpr bool PERM = true;
    bf16_t* zs; bf16_t* xbc; float* dtb; const float* dt_bias;
    __device__ __forceinline__ void operator()(AccRef acc, const Unit& u, int wr, int wc, int fr, int fq) const {
        const int row0 = u.pm * BM + wr * 64 + fr, pn = u.pn;
        if (pn < 24) {
            const bool act = pn < 8;
            bf16_t* base = act ? zs : xbc; const int ld = act ? 2048 : 4096; const int colt = act ? pn * 256 : (pn - 8) * 256;
            const int col0 = colt + wc * 32 + 8 * fq;
#pragma unroll
            for (int ai = 0; ai < 2; ++ai)
#pragma unroll
                for (int m = 0; m < 4; ++m) { bf16_t* rowp = base + (size_t)(row0 + ai * HALF + m * 16) * ld + col0;
#pragma unroll
                    for (int bj = 0; bj < 2; ++bj) { f32x4 v0 = acc[ai][bj][m][0], v1 = acc[ai][bj][m][1];
                        if (act) {
#pragma unroll
                            for (int j = 0; j < 4; ++j) { v0[j] = siluf_(v0[j]); v1[j] = siluf_(v1[j]); } }
                        *(u32x4*)(rowp + bj * HALF) = pack8(v0, v1); } }
        } else if (wc == 0) {
            const int c0 = 8 * fq; const f32x4 b0 = *(const f32x4*)(dt_bias + c0), b1 = *(const f32x4*)(dt_bias + c0 + 4);
#pragma unroll
            for (int ai = 0; ai < 2; ++ai)
#pragma unroll
                for (int m = 0; m < 4; ++m) { float* rowp = dtb + (size_t)(row0 + ai * HALF + m * 16) * 32 + c0;
                    f32x4 v0 = acc[ai][0][m][0] + b0, v1 = acc[ai][0][m][1] + b1;
#pragma unroll
                    for (int j = 0; j < 4; ++j) { v0[j] = softplusf_(v0[j]); v1[j] = softplusf_(v1[j]); }
                    *(f32x4*)rowp = v0; *(f32x4*)(rowp + 4) = v1; }
        }
    }
};
struct EpiG2 {
    static constexpr bool PERM = true;
    bf16_t* upool; bf16_t* gates; const float* b_gates;
    __device__ __forceinline__ void operator()(AccRef acc, const Unit& u, int wr, int wc, int fr, int fq) const {
        const int row0 = u.pm * BM + wr * 64 + fr, pn = u.pn;
        const bool act = pn >= 4;
        bf16_t* base = act ? gates : upool; const int ld = act ? 2048 : 1024; const int colt = act ? (pn - 4) * 256 : pn * 256;
        const int col0 = colt + wc * 32 + 8 * fq;
        f32x4 bv[2][2];
#pragma unroll
        for (int bj = 0; bj < 2; ++bj)
#pragma unroll
            for (int n = 0; n < 2; ++n) bv[bj][n] = act ? *(const f32x4*)(b_gates + col0 + bj * HALF + 4 * n) : (f32x4){0.f, 0.f, 0.f, 0.f};
#pragma unroll
        for (int ai = 0; ai < 2; ++ai)
#pragma unroll
            for (int m = 0; m < 4; ++m) { bf16_t* rowp = base + (size_t)(row0 + ai * HALF + m * 16) * ld + col0;
#pragma unroll
                for (int bj = 0; bj < 2; ++bj) { f32x4 v0 = acc[ai][bj][m][0] + bv[bj][0], v1 = acc[ai][bj][m][1] + bv[bj][1];
                    if (act) {
#pragma unroll
                        for (int j = 0; j < 4; ++j) { v0[j] = sigmoidf_(v0[j]); v1[j] = sigmoidf_(v1[j]); } }
                    *(u32x4*)(rowp + bj * HALF) = pack8(v0, v1); } }
    }
};
template <bool FIRST> struct EpiPool {
    static constexpr bool PERM = true;
    bf16_t* merged; const bf16_t* gates;
    __device__ __forceinline__ void operator()(AccRef acc, const Unit& u, int wr, int wc, int fr, int fq) const {
        const int row0 = u.pm * BM + wr * 64 + fr; const int col0 = u.pn * 256 + wc * 32 + 8 * fq;
#pragma unroll
        for (int ai = 0; ai < 2; ++ai) {
            u32x4 gw[4][2], pw[4][2];
#pragma unroll
            for (int m = 0; m < 4; ++m)
#pragma unroll
                for (int bj = 0; bj < 2; ++bj) { const size_t row = (size_t)(row0 + ai * HALF + m * 16);
                    gw[m][bj] = *(const u32x4*)(gates + row * 2048 + col0 + bj * HALF); if (!FIRST) pw[m][bj] = *(const u32x4*)(merged + row * 1024 + col0 + bj * HALF); }
#pragma unroll
            for (int m = 0; m < 4; ++m) { const size_t row = (size_t)(row0 + ai * HALF + m * 16);
#pragma unroll
                for (int bj = 0; bj < 2; ++bj) { f32x4 g0, g1, p0 = {0.f, 0.f, 0.f, 0.f}, p1 = {0.f, 0.f, 0.f, 0.f}; unpack8(gw[m][bj], g0, g1); if (!FIRST) unpack8(pw[m][bj], p0, p1);
                    const f32x4 v0 = p0 + acc[ai][bj][m][0] * g0, v1 = p1 + acc[ai][bj][m][1] * g1;
                    *(u32x4*)(merged + row * 1024 + col0 + bj * HALF) = pack8(v0, v1); } }
            asm volatile("" ::: "memory");
        }
    }
};
template <bool FIRST> struct EpiSsd {
    static constexpr bool PERM = true;
    bf16_t* merged; const bf16_t* gates;
    __device__ __forceinline__ void operator()(AccRef acc, const Unit& u, int wr, int wc, int fr, int fq) const {
        const int row0 = u.pm * BM + wr * 64 + fr; const int col0 = u.pn * 256 + wc * 32 + 8 * fq;
#pragma unroll
        for (int ai = 0; ai < 2; ++ai) {
            u32x4 gw[4][2], pw[4][2];
#pragma unroll
            for (int m = 0; m < 4; ++m)
#pragma unroll
                for (int bj = 0; bj < 2; ++bj) { const size_t row = (size_t)(row0 + ai * HALF + m * 16);
                    gw[m][bj] = *(const u32x4*)(gates + row * 2048 + 1024 + col0 + bj * HALF); if (!FIRST) pw[m][bj] = *(const u32x4*)(merged + row * 1024 + col0 + bj * HALF); }
#pragma unroll
            for (int m = 0; m < 4; ++m) { const size_t row = (size_t)(row0 + ai * HALF + m * 16);
#pragma unroll
                for (int bj = 0; bj < 2; ++bj) { f32x4 g0, g1, p0 = {0.f, 0.f, 0.f, 0.f}, p1 = {0.f, 0.f, 0.f, 0.f}; unpack8(gw[m][bj], g0, g1); if (!FIRST) unpack8(pw[m][bj], p0, p1);
                    const f32x4 v0 = p0 + acc[ai][bj][m][0] * g0, v1 = p1 + acc[ai][bj][m][1] * g1;
                    *(u32x4*)(merged + row * 1024 + col0 + bj * HALF) = pack8(v0, v1); } }
            asm volatile("" ::: "memory");
        }
    }
};
struct EpiUp {
    static constexpr bool PERM = true;
    bf16_t* upb;
    __device__ __forceinline__ void operator()(AccRef acc, const Unit& u, int wr, int wc, int fr, int fq) const {
        const int row0 = u.pm * BM + wr * 64 + fr; const int col0 = u.pn * 256 + wc * 32 + 8 * fq;
#pragma unroll
        for (int ai = 0; ai < 2; ++ai)
#pragma unroll
            for (int m = 0; m < 4; ++m) { bf16_t* rowp = upb + (size_t)(row0 + ai * HALF + m * 16) * DFF + col0;
#pragma unroll
                for (int bj = 0; bj < 2; ++bj) { f32x4 v0 = acc[ai][bj][m][0], v1 = acc[ai][bj][m][1];
#pragma unroll
                    for (int j = 0; j < 4; ++j) { const float a = fmaxf(v0[j], 0.f), b = fmaxf(v1[j], 0.f); v0[j] = a * a; v1[j] = b * b; }
                    *(u32x4*)(rowp + bj * HALF) = pack8(v0, v1); } }
    }
};
struct EpiOut {
    static constexpr bool PERM = true;
    const float* x; bf16_t* v;
    __device__ __forceinline__ void operator()(AccRef acc, const Unit& u, int wr, int wc, int fr, int fq) const {
        const int row0 = u.pm * BM + wr * 64 + fr, col0 = u.pn * BM + wc * 32 + 8 * fq;
#pragma unroll
        for (int ai = 0; ai < 2; ++ai) {
            f32x4 xv[4][2][2];
#pragma unroll
            for (int m = 0; m < 4; ++m)
#pragma unroll
                for (int bj = 0; bj < 2; ++bj)
#pragma unroll
                    for (int n = 0; n < 2; ++n) xv[m][bj][n] = *(const f32x4*)(x + (size_t)(row0 + ai * HALF + m * 16) * DM + col0 + bj * HALF + n * 4);
#pragma unroll
            for (int m = 0; m < 4; ++m) { const size_t off = (size_t)(row0 + ai * HALF + m * 16) * DM + col0;
#pragma unroll
                for (int bj = 0; bj < 2; ++bj) *(u32x4*)(v + off + bj * HALF) = pack8(xv[m][bj][0] * ALPHA + acc[ai][bj][m][0], xv[m][bj][1] * ALPHA + acc[ai][bj][m][1]); }
            asm volatile("" ::: "memory");
        }
    }
};
struct EpiDown {
    static constexpr bool PERM = true;
    const bf16_t* h1b; bf16_t* y;
    __device__ __forceinline__ void operator()(AccRef acc, const Unit& u, int wr, int wc, int fr, int fq) const {
        const int row0 = u.pm * BM + wr * 64 + fr, col0 = u.pn * BM + wc * 32 + 8 * fq;
        u32x4 hw[2][4][2];
#pragma unroll
        for (int ai = 0; ai < 2; ++ai)
#pragma unroll
            for (int m = 0; m < 4; ++m)
#pragma unroll
                for (int bj = 0; bj < 2; ++bj) hw[ai][m][bj] = *(const u32x4*)(h1b + (size_t)(row0 + ai * HALF + m * 16) * DM + col0 + bj * HALF);
#pragma unroll
        for (int ai = 0; ai < 2; ++ai)
#pragma unroll
            for (int m = 0; m < 4; ++m) { const size_t off = (size_t)(row0 + ai * HALF + m * 16) * DM + col0;
#pragma unroll
                for (int bj = 0; bj < 2; ++bj) { f32x4 h0, h1; unpack8(hw[ai][m][bj], h0, h1);
                    *(u32x4*)(y + off + bj * HALF) = pack8(h0 * ALPHA + acc[ai][bj][m][0], h1 * ALPHA + acc[ai][bj][m][1]); } }
    }
};
}

struct TrJob { const float* src; int ld_src, col0, K, ncols, nvalid; bf16_t* dst; int ld_dst; const float* cscale; };
__device__ __forceinline__ int tr_tiles(int K, int ncols) { return (K / 64) * (ncols / 256); }
__device__ __forceinline__ bool tr_pick(const Params& p, int gt, TrJob& J, int& lt) {
    unsigned char* ws = p.ws; const float* w_in = p.in[1];
    bf16_t* win1 = (bf16_t*)(ws + WS_WIN1); bf16_t* win2 = (bf16_t*)(ws + WS_WIN2);
    int base = 0, n;
#define TRJ(SRC, LDS_, COL0, K_, NC, NV, DST, LDD, CS) do { n = tr_tiles((K_), (NC)); if (gt < base + n) { J.src = (SRC); J.ld_src = (LDS_); J.col0 = (COL0); J.K = (K_); J.ncols = (NC); J.nvalid = (NV); J.dst = (DST); J.ld_dst = (LDD); J.cscale = (CS); lt = gt - base; return true; } base += n; } while (0)
    TRJ(w_in, 9248, 3072, 1024, 4096, 4096, win1 + (size_t)2048 * 1024, 1024, nullptr);
    TRJ(p.in[15], 4096, 0, 1024, 4096, 4096, (bf16_t*)(ws + WS_WUP), 1024, nullptr);
    TRJ(p.in[16], 1024, 0, 4096, 1024, 1024, (bf16_t*)(ws + WS_WDN), 4096, nullptr);
    TRJ(w_in, 9248, 1024, 1024, 2048, 2048, win1, 1024, nullptr);
    TRJ(w_in, 9248, 7200, 1024, 2048, 2048, win2 + (size_t)1024 * 1024, 1024, nullptr);
    TRJ(p.in[9], 1024, 0, 2048, 1024, 1024, (bf16_t*)(ws + WS_WSSD), 2048, nullptr);
    TRJ(w_in, 9248, 0, 1024, 1024, 1024, win2, 1024, nullptr);
    TRJ(p.in[12], 1024, 0, 1024, 1024, 1024, (bf16_t*)(ws + WS_WOUT), 1024, nullptr);
    TRJ(w_in, 9248, 7168, 1024, 256, 32, win1 + (size_t)6144 * 1024, 1024, nullptr);
    TRJ(p.in[10], 256, 0, 256, 256, 256, (bf16_t*)(ws + WS_WP), 256, p.in[11]);
    TRJ(p.in[10] + 65536, 256, 0, 256, 256, 256, (bf16_t*)(ws + WS_WP) + 65536, 256, p.in[11] + 256);
    TRJ(p.in[10] + 2 * 65536, 256, 0, 256, 256, 256, (bf16_t*)(ws + WS_WP) + 2 * 65536, 256, p.in[11] + 512);
    TRJ(p.in[10] + 3 * 65536, 256, 0, 256, 256, 256, (bf16_t*)(ws + WS_WP) + 3 * 65536, 256, p.in[11] + 768);
#undef TRJ
    return false;
}
__device__ void phase0(const Params& p, unsigned char* smem) {
    unsigned char* ws = p.ws;
    { const float* __restrict__ x = p.in[0]; bf16_t* __restrict__ xb = (bf16_t*)(ws + WS_RC);
      const size_t nvec = (size_t)T_TOK * DM / 8, stride = (size_t)gridDim.x * blockDim.x;
      for (size_t i = (size_t)blockIdx.x * blockDim.x + threadIdx.x; i < nvec; i += 4 * stride) {
          f32x4 a[4], b[4];
#pragma unroll
          for (int k = 0; k < 4; ++k) { a[k] = *(const f32x4*)(x + (i + k * stride) * 8); b[k] = *(const f32x4*)(x + (i + k * stride) * 8 + 4); }
#pragma unroll
          for (int k = 0; k < 4; ++k) *(u32x4*)(xb + (i + k * stride) * 8) = pack8(a[k], b[k]); } }
    float* t = (float*)smem;
    const int tid = threadIdx.x;
    for (int gt = blockIdx.x; ; gt += gridDim.x) {
        TrJob J; int lt;
        if (!tr_pick(p, gt, J, lt)) break;
        const int tn = J.ncols / 256; const int k0 = (lt / tn) * 64, n0 = (lt % tn) * 256;
        __syncthreads();
        float v[4][8];
#pragma unroll
        for (int sb = 0; sb < 4; ++sb)
#pragma unroll
            for (int i = 0; i < 8; ++i) { const int k = (tid >> 6) + 8 * i, n = n0 + sb * 64 + (tid & 63); const int nc = n < J.nvalid ? n : 0;
                const float ld = J.src[(size_t)(k0 + k) * J.ld_src + J.col0 + nc]; v[sb][i] = n < J.nvalid ? ld : 0.f; }
#pragma unroll
        for (int sb = 0; sb < 4; ++sb) { const float sc = J.cscale ? J.cscale[n0 + sb * 64 + (tid & 63)] : 1.0f;
#pragma unroll
            for (int i = 0; i < 8; ++i) t[(sb * 64 + (tid >> 6) + 8 * i) * 65 + (tid & 63)] = v[sb][i] * sc; }
        __syncthreads();
        const int n = tid >> 3, kk = (tid & 7) * 8;
#pragma unroll
        for (int sb = 0; sb < 4; ++sb) { float e[8];
#pragma unroll
            for (int j = 0; j < 8; ++j) e[j] = t[(sb * 64 + kk + j) * 65 + n];
            u32x4 w; w.x = cvt_pk_bf16(e[0], e[1]); w.y = cvt_pk_bf16(e[2], e[3]); w.z = cvt_pk_bf16(e[4], e[5]); w.w = cvt_pk_bf16(e[6], e[7]);
            *(u32x4*)(J.dst + (size_t)(n0 + sb * 64 + n) * J.ld_dst + k0 + kk) = w; }
    }
}

__device__ void phase_ssd_simple(const Params& p, unsigned char* smem) {
    unsigned char* ws = p.ws;
    const bf16_t* xbc = (const bf16_t*)(ws + WS_RA); bf16_t* zy = (bf16_t*)(ws + WS_RB); const float* dtb = (const float*)(ws + WS_DT);
    const float* conv_w = p.in[3]; const float* conv_b = p.in[4]; const float* a_log = p.in[6]; const float* d_skip = p.in[7]; const float* norm_w = p.in[8];
    float* sX = (float*)smem;
    float* sY = sX + 16 * 512;
    float* sdt = sY + 16 * 256;
    const int tid = threadIdx.x;
    for (int item = blockIdx.x; item < 256; item += gridDim.x) {
        const int b = item >> 3, g = item & 7;
        const int ch = tid; int gcol;
        if (ch < 256) gcol = g * 256 + ch; else if (ch < 384) gcol = 2048 + g * 128 + (ch - 256); else gcol = 3072 + g * 128 + (ch - 384);
        const float cw0 = conv_w[gcol], cw1 = conv_w[4096 + gcol], cw2 = conv_w[8192 + gcol], cw3 = conv_w[12288 + gcol], cb = conv_b[gcol];
        float u1 = 0.f, u2 = 0.f, u3 = 0.f;
        const int r = tid >> 7, pp = (tid & 127) >> 1, nh = tid & 1;
        const float a_r = -__expf(a_log[g * 4 + r]), d_r = d_skip[g * 4 + r];
        float hst[64];
#pragma unroll
        for (int i = 0; i < 64; ++i) hst[i] = 0.f;
        for (int blk = 0; blk < SEQ / 16; ++blk) {
            const size_t t0 = (size_t)b * SEQ + (size_t)blk * 16;
#pragma unroll 4
            for (int tt = 0; tt < 16; ++tt) { const float raw = bf2f(xbc[(t0 + tt) * 4096 + gcol]);
                const float y = cb + cw0 * u1 + cw1 * u2 + cw2 * u3 + cw3 * raw; u1 = u2; u2 = u3; u3 = raw;
                sX[tt * 512 + ch] = siluf_(y); }
            if (tid < 64) sdt[tid] = dtb[(t0 + (tid >> 2)) * 32 + g * 4 + (tid & 3)];
            __syncthreads();
            for (int tt = 0; tt < 16; ++tt) {
                const float dt = sdt[tt * 4 + r], dec = __expf(dt * a_r), xv = sX[tt * 512 + r * 64 + pp], xdt = xv * dt;
                const float* Bp = sX + tt * 512 + 256 + nh * 64; const float* Cp = sX + tt * 512 + 384 + nh * 64;
                float y = 0.f;
#pragma unroll
                for (int i = 0; i < 64; ++i) { hst[i] = hst[i] * dec + xdt * Bp[i]; y += hst[i] * Cp[i]; }
                y += __shfl_xor(y, 1);
                if (nh == 0) { const float zv = bf2f(zy[(t0 + tt) * 2048 + g * 256 + r * 64 + pp]); sY[tt * 256 + r * 64 + pp] = (y + d_r * xv) * zv; }
            }
            __syncthreads();
            { const int tt = tid >> 5, c0 = (tid & 31) * 8; float e[8]; float ss = 0.f;
#pragma unroll
              for (int j = 0; j < 8; ++j) { e[j] = sY[tt * 256 + c0 + j]; ss += e[j] * e[j]; }
              ss += __shfl_xor(ss, 16); ss += __shfl_xor(ss, 8); ss += __shfl_xor(ss, 4); ss += __shfl_xor(ss, 2); ss += __shfl_xor(ss, 1);
              const float rstd = rsqrtf(ss * (1.0f / 256.0f) + RMS_EPS);
              const f32x4 w0 = *(const f32x4*)(norm_w + g * 256 + c0), w1 = *(const f32x4*)(norm_w + g * 256 + c0 + 4);
              u32x4 o; o.x = cvt_pk_bf16(e[0] * rstd * w0[0], e[1] * rstd * w0[1]); o.y = cvt_pk_bf16(e[2] * rstd * w0[2], e[3] * rstd * w0[3]);
              o.z = cvt_pk_bf16(e[4] * rstd * w1[0], e[5] * rstd * w1[1]); o.w = cvt_pk_bf16(e[6] * rstd * w1[2], e[7] * rstd * w1[3]);
              *(u32x4*)(zy + (t0 + tt) * 2048 + g * 256 + c0) = o; }
            __syncthreads();
        }
    }
}


constexpr int SX_STR = 144, SN_STR = 272, SZ_STR = 528;
constexpr int O_XT = 0;
constexpr int O_BT = O_XT + 256 * SX_STR;
constexpr int O_BN = O_BT + 128 * SX_STR;
constexpr int O_CN = O_BN + 64 * SN_STR;
constexpr int O_CB = O_CN + 64 * SN_STR;
constexpr int O_ZT = O_CB + 64 * SN_STR;
constexpr int O_ACS = O_ZT + 64 * SZ_STR;
constexpr int O_DT = O_ACS + 1024;
constexpr int O_WG = O_DT + 1024;
constexpr int O_EA = O_WG + 1024;
constexpr int O_SSQ = O_EA + 1024;
constexpr int O_RSTD = O_SSQ + 2048;
constexpr int O_CW = O_RSTD + 256;
constexpr int O_RSW = O_CW + 5 * 512 * 4;
constexpr int SSD_LDS = O_RSW + 2048;
static_assert(SSD_LDS <= LDS_BYTES, "LDS");
#define MFMA16(a, b, c) __builtin_amdgcn_mfma_f32_16x16x32_bf16((a), (b), (c), 0, 0, 0)

template <int CTRL> __device__ __forceinline__ float dpp_add(float v) { return v + __builtin_bit_cast(float, __builtin_amdgcn_update_dpp(0, __builtin_bit_cast(int, v), CTRL, 0xf, 0xf, false)); }
__device__ __forceinline__ float row16_sum(float v) { v = dpp_add<0xB1>(v); v = dpp_add<0x4E>(v); v = dpp_add<0x124>(v); v = dpp_add<0x128>(v); return v; }
__device__ __forceinline__ f32x4 unpack4(u32x2 w) { return (f32x4){bf_lo(w.x), bf_hi(w.x), bf_lo(w.y), bf_hi(w.y)}; }

__device__ void phase_ssd(const Params& p, LAS unsigned char* sm) {
    unsigned char* ws = p.ws;
    const bf16_t* xbc = (const bf16_t*)(ws + WS_RA); bf16_t* zy = (bf16_t*)(ws + WS_RB); const float* dtb = (const float*)(ws + WS_DT);
    const float* conv_w = p.in[3]; const float* conv_b = p.in[4]; const float* a_log = p.in[6]; const float* d_skip = p.in[7]; const float* norm_w = p.in[8];
    const int tid = threadIdx.x, lane = tid & 63, w = __builtin_amdgcn_readfirstlane(tid >> 6), c = lane & 15, q = lane >> 4;
    const int r = w >> 1, ph = w & 1;
    const int tq = tid >> 7, ch0 = (tid & 127) * 4;
    LAS float* ACS = (LAS float*)(sm + O_ACS); LAS float* DTV = (LAS float*)(sm + O_DT); LAS float* WG = (LAS float*)(sm + O_WG); LAS float* EA = (LAS float*)(sm + O_EA);
    LAS float* SSQ = (LAS float*)(sm + O_SSQ); LAS float* RSTD = (LAS float*)(sm + O_RSTD);
    for (int item = blockIdx.x; item < 256; item += gridDim.x) {
        const int b = item >> 3, g = item & 7;
#define SSD_GCOL(CH) ((CH) < 256 ? g * 256 + (CH) : ((CH) < 384 ? 1792 + g * 128 + (CH) : 2688 + g * 128 + (CH)))
        { const int gcol = SSD_GCOL(ch0);
        __syncthreads();
        if (tq == 0) {
#pragma unroll
            for (int k = 0; k < 4; ++k) *(LAS f32x4*)(sm + O_CW + (k * 512 + ch0) * 4) = *(const f32x4*)(conv_w + k * 4096 + gcol);
            *(LAS f32x4*)(sm + O_CW + (4 * 512 + ch0) * 4) = *(const f32x4*)(conv_b + gcol); }
        __syncthreads(); }
        const float d_r = d_skip[g * 4 + r];
        const float a_w = -__expf(a_log[g * 4 + (w & 3)]);
        const int prow0 = r * 64 + ph * 32 + c;
        const float nw0 = norm_w[g * 256 + prow0], nw1 = norm_w[g * 256 + prow0 + 16];
        f32x4 accH[8][2];
#pragma unroll
        for (int nt = 0; nt < 8; ++nt)
#pragma unroll
            for (int pt = 0; pt < 2; ++pt) accH[nt][pt] = (f32x4){0.f, 0.f, 0.f, 0.f};
        u32x2 raw[19]; u32x4 zr[4]; float dtn = 0.f;
#define SSD_ISSUE(SUBN) do { int sn_ = (SUBN); asm volatile("" : "+s"(sn_)); int tid_ = tid; asm volatile("" : "+v"(tid_)); const int ch_ = (tid_ & 127) * 4; const int gc_ = SSD_GCOL(ch_); \
            const int sl0_ = sn_ * 64 + (tid_ >> 7) * 16 - 3; const bf16_t* rp_ = xbc + ((size_t)b * SEQ + (sl0_ < 0 ? 0 : sl0_)) * 4096 + gc_; \
            _Pragma("unroll") for (int i = 0; i < 19; ++i) { const int sl = sl0_ + i; \
                const u32x2 v = *(const u32x2*)(rp_ + (sl0_ < 0 ? (i < 3 ? 0 : i - 3) : i) * 4096); raw[i].x = sl < 0 ? 0u : v.x; raw[i].y = sl < 0 ? 0u : v.y; } \
            const bf16_t* zp_ = zy + ((size_t)b * SEQ + (size_t)sn_ * 64 + (tid_ >> 5)) * 2048 + g * 256 + (tid_ & 31) * 8; \
            _Pragma("unroll") for (int k = 0; k < 4; ++k) zr[k] = *(const u32x4*)(zp_ + (size_t)k * 16 * 2048); \
            if (w < 4) dtn = dtb[((size_t)b * SEQ + (size_t)sn_ * 64 + lane) * 32 + g * 4 + w]; } while (0)
        SSD_ISSUE(0);
#pragma unroll 1
        for (int sub = 0; sub < SEQ / 64; ++sub) {
            const size_t t0 = (size_t)b * SEQ + (size_t)sub * 64;
            {
                const f32x4 cw0 = *(const LAS f32x4*)(sm + O_CW + ch0 * 4), cw1 = *(const LAS f32x4*)(sm + O_CW + (512 + ch0) * 4), cw2 = *(const LAS f32x4*)(sm + O_CW + (1024 + ch0) * 4),
                            cw3 = *(const LAS f32x4*)(sm + O_CW + (1536 + ch0) * 4), cbv = *(const LAS f32x4*)(sm + O_CW + (2048 + ch0) * 4);
                f32x4 u0 = unpack4(raw[0]), u1 = unpack4(raw[1]), u2 = unpack4(raw[2]);
                unsigned tr[4][8]; f32x4 pv = {0.f, 0.f, 0.f, 0.f};
                LAS unsigned char* nb = ch0 < 384 ? sm + O_BN + (ch0 - 256) * 2 : sm + O_CN + (ch0 - 384) * 2;
#pragma unroll
                for (int i = 0; i < 16; ++i) {
                    const f32x4 u3 = unpack4(raw[i + 3]);
                    f32x4 y = cbv + cw0 * u0 + cw1 * u1 + cw2 * u2 + cw3 * u3;
#pragma unroll
                    for (int j = 0; j < 4; ++j) y[j] = siluf_(y[j]);
                    if (ch0 >= 256) *(LAS u32x2*)(nb + (tq * 16 + i) * SN_STR) = (u32x2){cvt_pk_bf16(y[0], y[1]), cvt_pk_bf16(y[2], y[3])};
                    if (i & 1) {
#pragma unroll
                        for (int j = 0; j < 4; ++j) tr[j][i >> 1] = cvt_pk_bf16(pv[j], y[j]); }
                    else pv = y;
                    u0 = u1; u1 = u2; u2 = u3;
                }
                if (ch0 < 384) {
                    LAS unsigned char* tb = ch0 < 256 ? sm + O_XT + ch0 * SX_STR : sm + O_BT + (ch0 - 256) * SX_STR;
#pragma unroll
                    for (int j = 0; j < 4; ++j) { *(LAS u32x4*)(tb + j * SX_STR + tq * 32) = (u32x4){tr[j][0], tr[j][1], tr[j][2], tr[j][3]};
                        *(LAS u32x4*)(tb + j * SX_STR + tq * 32 + 16) = (u32x4){tr[j][4], tr[j][5], tr[j][6], tr[j][7]}; }
                }
            }
            if (w < 4) {
                const float dt = dtn; float x = dt * a_w;
#pragma unroll
                for (int o = 1; o < 64; o <<= 1) { const float v = __shfl_up(x, o); if (lane >= o) x += v; }
                const float last = __shfl(x, 63);
                ACS[w * 64 + lane] = x; DTV[w * 64 + lane] = dt; WG[w * 64 + lane] = dt * __expf(last - x); EA[w * 64 + lane] = __expf(x);
            }
            __syncthreads();
            {
#pragma unroll
                for (int k = 0; k < 4; ++k) { const int v = tid + 512 * k, l = v >> 5, c8 = (v & 31) * 8; *(LAS u32x4*)(sm + O_ZT + l * SZ_STR + c8 * 2) = zr[k]; }
                const int lt = w >> 1;
#pragma unroll
                for (int sti = 0; sti < 2; ++sti) { const int st = 2 * (w & 1) + sti; f32x4 acc = {0.f, 0.f, 0.f, 0.f};
#pragma unroll
                    for (int ks = 0; ks < 4; ++ks) { const bf16x8 a = *(const LAS bf16x8*)(sm + O_CN + (16 * lt + c) * SN_STR + (32 * ks + 8 * q) * 2);
                        const bf16x8 bb = *(const LAS bf16x8*)(sm + O_BN + (16 * st + c) * SN_STR + (32 * ks + 8 * q) * 2); acc = MFMA16(a, bb, acc); }
#pragma unroll
                    for (int rg = 0; rg < 4; ++rg) *(LAS float*)(sm + O_CB + (16 * lt + 4 * q + rg) * SN_STR + (16 * st + c) * 4) = acc[rg]; }
            }
            __syncthreads();
            f32x4 accY[4][2];
#pragma unroll
            for (int lt = 0; lt < 4; ++lt)
#pragma unroll
                for (int pt = 0; pt < 2; ++pt) accY[lt][pt] = (f32x4){0.f, 0.f, 0.f, 0.f};
#pragma unroll
            for (int ks = 0; ks < 4; ++ks) {
                bf16x8 hb[2];
#pragma unroll
                for (int pt = 0; pt < 2; ++pt) hb[pt] = __builtin_bit_cast(bf16x8, pack8(accH[2 * ks][pt], accH[2 * ks + 1][pt]));
#pragma unroll
                for (int lt = 0; lt < 4; ++lt) { const LAS unsigned char* cp = sm + O_CN + (16 * lt + c) * SN_STR + (32 * ks + 4 * q) * 2;
                    const u32x2 lo = *(const LAS u32x2*)cp, hi = *(const LAS u32x2*)(cp + 32);
                    const bf16x8 a = __builtin_bit_cast(bf16x8, (u32x4){lo.x, lo.y, hi.x, hi.y});
#pragma unroll
                    for (int pt = 0; pt < 2; ++pt) accY[lt][pt] = MFMA16(a, hb[pt], accY[lt][pt]); }
            }
#pragma unroll
            for (int lt = 0; lt < 4; ++lt) { const f32x4 e = *(const LAS f32x4*)(EA + r * 64 + 16 * lt + 4 * q);
#pragma unroll
                for (int pt = 0; pt < 2; ++pt) accY[lt][pt] *= e; }
            bf16x8 xf[2][2];
#pragma unroll
            for (int ks = 0; ks < 2; ++ks)
#pragma unroll
                for (int pt = 0; pt < 2; ++pt) xf[ks][pt] = *(const LAS bf16x8*)(sm + O_XT + (prow0 + 16 * pt) * SX_STR + (32 * ks + 8 * q) * 2);
#pragma unroll
            for (int lt = 0; lt < 4; ++lt)
#pragma unroll
                for (int ks = 0; ks < 2; ++ks) {
                    if (ks == 1 && lt < 2) continue;
                    const int l = 16 * lt + c; const float acl = ACS[r * 64 + l];
                    const LAS float* cbp = (const LAS float*)(sm + O_CB + l * SN_STR) + 32 * ks + 8 * q;
                    const f32x4 cb0 = *(const LAS f32x4*)cbp, cb1 = *(const LAS f32x4*)(cbp + 4);
                    const f32x4 as0 = *(const LAS f32x4*)(ACS + r * 64 + 32 * ks + 8 * q), as1 = *(const LAS f32x4*)(ACS + r * 64 + 32 * ks + 8 * q + 4);
                    const f32x4 d0 = *(const LAS f32x4*)(DTV + r * 64 + 32 * ks + 8 * q), d1 = *(const LAS f32x4*)(DTV + r * 64 + 32 * ks + 8 * q + 4);
                    f32x4 m0, m1;
#pragma unroll
                    for (int j = 0; j < 4; ++j) { const int s0 = 32 * ks + 8 * q + j, s1 = s0 + 4;
                        m0[j] = (s0 <= l) ? cb0[j] * __expf(acl - as0[j]) * d0[j] : 0.f;
                        m1[j] = (s1 <= l) ? cb1[j] * __expf(acl - as1[j]) * d1[j] : 0.f; }
                    const bf16x8 mf = __builtin_bit_cast(bf16x8, pack8(m0, m1));
#pragma unroll
                    for (int pt = 0; pt < 2; ++pt) accY[lt][pt] = MFMA16(mf, xf[ks][pt], accY[lt][pt]);
                }
#pragma unroll
            for (int lt = 0; lt < 4; ++lt) {
#pragma unroll
                for (int pt = 0; pt < 2; ++pt) { const int prow = prow0 + 16 * pt;
                    const f32x4 xv = unpack4(*(const LAS u32x2*)(sm + O_XT + prow * SX_STR + (16 * lt + 4 * q) * 2));
#pragma unroll
                    for (int rg = 0; rg < 4; ++rg) { const int l = 16 * lt + 4 * q + rg; const float zv = bf2f(*(const LAS bf16_t*)(sm + O_ZT + l * SZ_STR + prow * 2));
                        accY[lt][pt][rg] = (accY[lt][pt][rg] + d_r * xv[rg]) * zv; } }
                f32x4 sv;
#pragma unroll
                for (int rg = 0; rg < 4; ++rg) sv[rg] = row16_sum(accY[lt][0][rg] * accY[lt][0][rg] + accY[lt][1][rg] * accY[lt][1][rg]);
                if (c == 0) *(LAS f32x4*)(SSQ + w * 64 + 16 * lt + 4 * q) = sv;
            }
            {
                const float dec = __expf(ACS[r * 64 + 63]);
#pragma unroll
                for (int nt = 0; nt < 8; ++nt)
#pragma unroll
                    for (int pt = 0; pt < 2; ++pt) accH[nt][pt] *= dec;
                bf16x8 xw[2][2];
#pragma unroll
                for (int ks = 0; ks < 2; ++ks) { const f32x4 w0 = *(const LAS f32x4*)(WG + r * 64 + 32 * ks + 8 * q), w1 = *(const LAS f32x4*)(WG + r * 64 + 32 * ks + 8 * q + 4);
#pragma unroll
                    for (int pt = 0; pt < 2; ++pt) { f32x4 a, bq; unpack8(__builtin_bit_cast(u32x4, xf[ks][pt]), a, bq); xw[ks][pt] = __builtin_bit_cast(bf16x8, pack8(a * w0, bq * w1)); } }
#pragma unroll
                for (int nt = 0; nt < 8; ++nt)
#pragma unroll
                    for (int ks = 0; ks < 2; ++ks) { const bf16x8 bfr = *(const LAS bf16x8*)(sm + O_BT + (16 * nt + c) * SX_STR + (32 * ks + 8 * q) * 2);
#pragma unroll
                        for (int pt = 0; pt < 2; ++pt) accH[nt][pt] = MFMA16(bfr, xw[ks][pt], accH[nt][pt]); }
            }
            SSD_ISSUE(sub + 1 < SEQ / 64 ? sub + 1 : sub);
            __syncthreads();
            { float s = 0.f;
#pragma unroll
              for (int k = 0; k < 8; ++k) s += SSQ[k * 64 + lane];
              LAS float* RSW = (LAS float*)(sm + O_RSW) + w * 64;
              RSW[lane] = rsqrtf(s * (1.0f / 256.0f) + RMS_EPS);
#pragma unroll
              for (int lt = 0; lt < 4; ++lt) { const f32x4 rs = *(const LAS f32x4*)(RSW + 16 * lt + 4 * q);
#pragma unroll
                for (int pt = 0; pt < 2; ++pt) { const float nw = pt ? nw1 : nw0;
#pragma unroll
                    for (int rg = 0; rg < 4; ++rg) { const int l = 16 * lt + 4 * q + rg;
                        *(LAS bf16_t*)(sm + O_ZT + l * SZ_STR + (prow0 + 16 * pt) * 2) = (bf16_t)(cvt_pk_bf16(accY[lt][pt][rg] * rs[rg] * nw, 0.f) & 0xffffu); } } }
#pragma unroll
              for (int k = 0; k < 4; ++k) { const int row = (lane >> 2) + 16 * k, pc = lane & 3;
                *(u32x4*)(zy + (t0 + row) * 2048 + g * 256 + r * 64 + ph * 32 + pc * 8) = *(const LAS u32x4*)(sm + O_ZT + row * SZ_STR + (r * 64 + ph * 32 + pc * 8) * 2); }
            }
        }
    }
}

template <int W, int RUN = 16>
__device__ __forceinline__ void pool_task(const bf16_t* __restrict__ colp, bf16_t* __restrict__ outp, int t0, int s0) {
    constexpr int H = W - 1;
    u32x4 rw[RUN + H];
#pragma unroll
    for (int j = 0; j < RUN + H; ++j) { int tt = t0 - H + j; tt = tt < 0 ? 0 : tt; rw[j] = *(const u32x4*)(colp + (size_t)tt * 1024); }
    f32x4 S0 = {0.f, 0.f, 0.f, 0.f}, S1 = {0.f, 0.f, 0.f, 0.f};
#pragma unroll
    for (int j = 1; j <= H; ++j) { f32x4 a, b; unpack8(rw[H - j], a, b); const bool ok = (s0 - j >= 0); S0 += ok ? a : (f32x4){0.f, 0.f, 0.f, 0.f}; S1 += ok ? b : (f32x4){0.f, 0.f, 0.f, 0.f}; }
#pragma unroll
    for (int tt = 0; tt < RUN; ++tt) { const int s = s0 + tt;
        f32x4 a, b; unpack8(rw[H + tt], a, b); S0 += a; S1 += b;
        const float inv = 1.0f / (float)(s + 1 < W ? s + 1 : W);
        *(u32x4*)(outp + (size_t)(t0 + tt) * 1024) = pack8(S0 * inv - a, S1 * inv - b);
        f32x4 c, d; unpack8(rw[tt], c, d);
        if (s - W + 1 >= 0) { S0 -= c; S1 -= d; } }
}
__device__ __forceinline__ void pool_tile(const Params& p, int pm, int g) {
    const bf16_t* up = (const bf16_t*)(p.ws + WS_RA); bf16_t* pooled = (bf16_t*)(p.ws + WS_RA + 384 * MiB);
    int tl = threadIdx.x; asm volatile("" : "+v"(tl));
    const int vec = g * 32 + (tl & 31), run = tl >> 5;
    const int t0 = pm * 256 + run * 16, s0 = t0 & (SEQ - 1);
    const bf16_t* colp = up + vec * 8; bf16_t* outp = pooled + vec * 8;
    if (g == 0) pool_task<2>(colp, outp, t0, s0); else if (g == 1) pool_task<4>(colp, outp, t0, s0);
    else if (g == 2) pool_task<8>(colp, outp, t0, s0); else { pool_task<16, 8>(colp, outp, t0, s0); pool_task<16, 8>(colp, outp, t0 + 8, s0 + 8); }
}

template <bool OUT_BF16>
__device__ void phase_ln(const bf16_t* __restrict__ src, void* __restrict__ dst, const float* __restrict__ gam, const float* __restrict__ bet) {
    const int lane = threadIdx.x & 63, wv = threadIdx.x >> 6;
    f32x4 gv[4], bv[4];
#pragma unroll
    for (int i = 0; i < 2; ++i) { gv[2 * i] = *(const f32x4*)(gam + lane * 8 + 512 * i); gv[2 * i + 1] = *(const f32x4*)(gam + lane * 8 + 512 * i + 4);
        bv[2 * i] = *(const f32x4*)(bet + lane * 8 + 512 * i); bv[2 * i + 1] = *(const f32x4*)(bet + lane * 8 + 512 * i + 4); }
    for (int row0 = (blockIdx.x * 8 + wv) * 4; row0 < T_TOK; row0 += gridDim.x * 8 * 4) {
        u32x4 rw[4][2];
#pragma unroll
        for (int rr = 0; rr < 4; ++rr)
#pragma unroll
            for (int i = 0; i < 2; ++i) rw[rr][i] = *(const u32x4*)(src + (size_t)(row0 + rr) * DM + lane * 8 + 512 * i);
#pragma unroll
        for (int rr = 0; rr < 4; ++rr) {
            f32x4 v[4]; unpack8(rw[rr][0], v[0], v[1]); unpack8(rw[rr][1], v[2], v[3]);
            float s = 0.f;
#pragma unroll
            for (int i = 0; i < 4; ++i) s += (v[i][0] + v[i][1]) + (v[i][2] + v[i][3]);
#pragma unroll
            for (int o = 32; o >= 1; o >>= 1) s += __shfl_xor(s, o);
            const float mu = s * (1.0f / 1024.0f); float q = 0.f;
#pragma unroll
            for (int i = 0; i < 4; ++i) { v[i] -= mu; q += (v[i][0] * v[i][0] + v[i][1] * v[i][1]) + (v[i][2] * v[i][2] + v[i][3] * v[i][3]); }
#pragma unroll
            for (int o = 32; o >= 1; o >>= 1) q += __shfl_xor(q, o);
            const float rstd = rsqrtf(q * (1.0f / 1024.0f) + LN_EPS);
#pragma unroll
            for (int i = 0; i < 2; ++i) { const f32x4 o0 = v[2 * i] * rstd * gv[2 * i] + bv[2 * i], o1 = v[2 * i + 1] * rstd * gv[2 * i + 1] + bv[2 * i + 1];
                if (OUT_BF16) *(u32x4*)((bf16_t*)dst + (size_t)(row0 + rr) * DM + lane * 8 + 512 * i) = pack8(o0, o1);
                else { float* op = (float*)dst + (size_t)(row0 + rr) * DM + lane * 8 + 512 * i; *(f32x4*)op = o0; *(f32x4*)(op + 4) = o1; } }
        }
    }
}

__global__ void __launch_bounds__(512, 2) mega(Params p) {
    extern __shared__ __attribute__((aligned(16))) unsigned char lds_raw[];
    LAS unsigned char* lds = (LAS unsigned char*)lds_raw;
    cg::grid_group grid = cg::this_grid();
    unsigned char* ws = p.ws;
    const int G = gridDim.x, c = blockIdx.x;
#ifndef PHMASK
#define PHMASK 0x7ff
#endif
#define IN(k) (((PHMASK >> (k)) & 1) && p.ph_lo <= (k) && (k) < p.ph_hi)
#define SEAM(k) do { if (IN(k) && IN((k) + 1)) grid.sync(); } while (0)
    if (IN(0)) phase0(p, lds_raw);
    SEAM(0);
    if (IN(1)) {
        pg8::Gemm g{(const bf16_t*)(ws + WS_RC), (const bf16_t*)(ws + WS_WIN1), T_TOK, N1, 1024, 1024, 1024, 0};
        pg8::StaticOrder S; S.init(T_TOK, N1, G, c);
        pg8::EpiG1 E{(bf16_t*)(ws + WS_RB), (bf16_t*)(ws + WS_RA), (float*)(ws + WS_DT), p.in[5]};
        pg8::gemm_phase<pg8::EpiG1>(lds, g, S, E);
    }
    SEAM(1);
    #ifdef SSD_SIMPLE
    if (IN(2)) phase_ssd_simple(p, lds_raw);
#else
    if (IN(2)) phase_ssd(p, lds);
#endif
    SEAM(2);
    if (IN(3)) {
        pg8::Gemm g{(const bf16_t*)(ws + WS_RC), (const bf16_t*)(ws + WS_WIN2), T_TOK, N2, 1024, 1024, 1024, 0};
        pg8::StaticOrder S; S.init(T_TOK, N2, G, c);
        pg8::EpiG2 E{(bf16_t*)(ws + WS_RA), (bf16_t*)(ws + WS_RA + 128 * MiB), p.in[2]};
        pg8::gemm_phase<pg8::EpiG2>(lds, g, S, E);
    }
    SEAM(3);
    if (IN(5)) {
        bf16_t* merged = (bf16_t*)(ws + WS_RC); const bf16_t* gates = (const bf16_t*)(ws + WS_RA + 128 * MiB);
        pg8::StaticOrder S; S.init(T_TOK, 1024, G, c);
        const pg8::Gemm gp{(const bf16_t*)(ws + WS_RA + 384 * MiB), (const bf16_t*)(ws + WS_WP), T_TOK, 1024, 256, 1024, 256, 512};
        const pg8::Gemm gs{(const bf16_t*)(ws + WS_RB), (const bf16_t*)(ws + WS_WSSD), T_TOK, 1024, 2048, 2048, 2048, 0};
        if ((c & 1) == 0) {
            { pg8::Unit u; for (int i = 0; S.next(i, u); ++i) pool_tile(p, u.pm, u.pn); }
            __syncthreads();
            { pg8::EpiPool<true> E{merged, gates}; pg8::gemm_phase<pg8::EpiPool<true>>(lds, gp, S, E); }
            { pg8::EpiSsd<false> E{merged, gates}; pg8::gemm_phase<pg8::EpiSsd<false>>(lds, gs, S, E); }
        } else {
            { pg8::EpiSsd<true> E{merged, gates}; pg8::gemm_phase<pg8::EpiSsd<true>>(lds, gs, S, E); }
            { pg8::Unit u; for (int i = 0; S.next(i, u); ++i) pool_tile(p, u.pm, u.pn); }
            __syncthreads();
            { pg8::EpiPool<false> E{merged, gates}; pg8::gemm_phase<pg8::EpiPool<false>>(lds, gp, S, E); }
        }
    }
    SEAM(5);
    if (IN(6)) {
        pg8::Gemm g{(const bf16_t*)(ws + WS_RC), (const bf16_t*)(ws + WS_WOUT), T_TOK, 1024, 1024, 1024, 1024, 0};
        pg8::StaticOrder S; S.init(T_TOK, 1024, G, c);
        pg8::EpiOut E{p.in[0], (bf16_t*)(ws + WS_RB)};
        pg8::gemm_phase<pg8::EpiOut>(lds, g, S, E);
    }
    SEAM(6);
    if (IN(7)) phase_ln<true>((const bf16_t*)(ws + WS_RB), (void*)(ws + WS_RC), p.in[13], p.in[14]);
    SEAM(7);
    if (IN(8)) {
        pg8::Gemm g{(const bf16_t*)(ws + WS_RC), (const bf16_t*)(ws + WS_WUP), T_TOK, DFF, 1024, 1024, 1024, 0};
        pg8::StaticOrder S; S.init(T_TOK, DFF, G, c);
        pg8::EpiUp E{(bf16_t*)(ws + WS_RA)};
        pg8::gemm_phase<pg8::EpiUp>(lds, g, S, E);
    }
    SEAM(8);
    if (IN(9)) {
        pg8::Gemm g{(const bf16_t*)(ws + WS_RA), (const bf16_t*)(ws + WS_WDN), T_TOK, 1024, DFF, DFF, DFF, 0};
        pg8::StaticOrder S; S.init(T_TOK, 1024, G, c);
        pg8::EpiDown E{(const bf16_t*)(ws + WS_RC), (bf16_t*)(ws + WS_RB)};
        pg8::gemm_phase<pg8::EpiDown>(lds, g, S, E);
    }
    SEAM(9);
    if (IN(10)) phase_ln<false>((const bf16_t*)(ws + WS_RB), (void*)p.out, p.in[17], p.in[18]);
#undef IN
#undef SEAM
}

#ifndef DUPMASK
#define DUPMASK 0
#endif
#ifndef ONE_LAUNCH
#define ONE_LAUNCH 1
#endif
extern "C" void kernel_launch(void* const* d_in, const int* in_sizes, int n_in, void* d_out, int out_size, void* d_ws, size_t ws_size, hipStream_t stream) {
    static int grid = 0;
    if (grid == 0) {
        if (n_in != 19 || ws_size < WS_END) { fprintf(stderr, "kernel_launch: need 19 inputs and >= %zu bytes of workspace; got %d, %zu\n", (size_t)WS_END, n_in, ws_size); grid = -1; return; }
        int dev = 0, cus = 0, per_cu = 0;
        hipGetDevice(&dev); hipDeviceGetAttribute(&cus, hipDeviceAttributeMultiprocessorCount, dev);
        if (hipFuncSetAttribute((const void*)mega, hipFuncAttributeMaxDynamicSharedMemorySize, LDS_BYTES) != hipSuccess) { fprintf(stderr, "kernel_launch: hipFuncSetAttribute failed\n"); grid = -1; return; }
        if (hipOccupancyMaxActiveBlocksPerMultiprocessor(&per_cu, (const void*)mega, 512, LDS_BYTES) != hipSuccess || per_cu < 1) { fprintf(stderr, "kernel_launch: occupancy query says %d\n", per_cu); per_cu = 1; }
        (void)hipGetLastError();
        grid = cus;
    }
    if (grid < 0) return;
    Params p{};
    for (int i = 0; i < 19; ++i) p.in[i] = (const float*)d_in[i];
    p.out = (float*)d_out; p.ws = (unsigned char*)d_ws;
#if ONE_LAUNCH
    p.ph_lo = 0; p.ph_hi = NPHASE;
    void* args[] = {&p};
    hipError_t e = hipLaunchCooperativeKernel((const void*)mega, dim3(grid), dim3(512), args, LDS_BYTES, stream);
    if (e != hipSuccess) fprintf(stderr, "cooperative launch failed: %s (grid %d)\n", hipGetErrorString(e), grid);
#else
    for (int ph = 0; ph < NPHASE; ++ph) { p.ph_lo = ph; p.ph_hi = ph + 1;
        for (int rep = 0; rep < (((DUPMASK >> ph) & 1) ? 2 : 1); ++rep) hipLaunchKernelGGL(mega, dim3(grid), dim3(512), LDS_BYTES, stream, p); }
#endif
}
```

```cpp
#include <hip/hip_runtime.h>
#include <hip/hip_cooperative_groups.h>
#include <cstdio>
namespace cg = cooperative_groups;

#define LAS __attribute__((address_space(3)))
typedef unsigned short bf16_t;
typedef short bf16x8 __attribute__((ext_vector_type(8)));
typedef float f32x4 __attribute__((ext_vector_type(4)));
typedef float f32x2 __attribute__((ext_vector_type(2)));
typedef unsigned u32x4 __attribute__((ext_vector_type(4)));
typedef unsigned u32x2 __attribute__((ext_vector_type(2)));

constexpr int T_TOK = 65536, SEQ = 2048, DM = 1024, DFF = 4096;
constexpr int N1 = 6400;
constexpr int N2 = 3072;
constexpr float ALPHA = 1.189207115002721f;
constexpr float LN_EPS = 1e-5f, RMS_EPS = 1e-5f;
constexpr size_t MiB = 1024ull * 1024ull;
constexpr size_t WS_RA = 0;
constexpr size_t WS_RB = 512 * MiB;
constexpr size_t WS_RC = 768 * MiB;
constexpr size_t WS_DT = 896 * MiB;
constexpr size_t WS_W  = 904 * MiB;
constexpr size_t WS_WIN1 = WS_W;
constexpr size_t WS_WIN2 = WS_WIN1 + (size_t)N1 * 1024 * 2;
constexpr size_t WS_WP   = WS_WIN2 + (size_t)N2 * 1024 * 2;
constexpr size_t WS_WSSD = WS_WP + (size_t)1024 * 256 * 2;
constexpr size_t WS_WOUT = WS_WSSD + (size_t)1024 * 2048 * 2;
constexpr size_t WS_WUP  = WS_WOUT + (size_t)1024 * 1024 * 2;
constexpr size_t WS_WDN  = WS_WUP + (size_t)4096 * 1024 * 2;
constexpr size_t WS_END  = WS_WDN + (size_t)4096 * 1024 * 2;
constexpr int LDS_BYTES = 160000;
constexpr int NPHASE = 11;

struct Params { const float* in[19]; float* out; unsigned char* ws; int ph_lo, ph_hi; };

__device__ __forceinline__ unsigned cvt_pk_bf16(float lo, float hi) { unsigned r; asm volatile("v_cvt_pk_bf16_f32 %0, %1, %2" : "=v"(r) : "v"(lo), "v"(hi)); return r; }
__device__ __forceinline__ float bf_lo(unsigned u) { return __uint_as_float(u << 16); }
__device__ __forceinline__ float bf_hi(unsigned u) { return __uint_as_float(u & 0xffff0000u); }
__device__ __forceinline__ float bf2f(bf16_t b) { return __uint_as_float(((unsigned)b) << 16); }
__device__ __forceinline__ float sigmoidf_(float v) { return __builtin_amdgcn_rcpf(1.0f + __expf(-v)); }
__device__ __forceinline__ float siluf_(float v) { return v * __builtin_amdgcn_rcpf(1.0f + __expf(-v)); }
__device__ __forceinline__ float softplusf_(float v) { return fmaxf(v, 0.f) + log1pf(__expf(-fabsf(v))); }
__device__ __forceinline__ u32x4 pack8(f32x4 a, f32x4 b) { u32x4 w; w.x = cvt_pk_bf16(a[0], a[1]); w.y = cvt_pk_bf16(a[2], a[3]); w.z = cvt_pk_bf16(b[0], b[1]); w.w = cvt_pk_bf16(b[2], b[3]); return w; }
__device__ __forceinline__ void unpack8(u32x4 w, f32x4& a, f32x4& b) { a = (f32x4){bf_lo(w.x), bf_hi(w.x), bf_lo(w.y), bf_hi(w.y)}; b = (f32x4){bf_lo(w.z), bf_hi(w.z), bf_lo(w.w), bf_hi(w.w)}; }

namespace pg8 {
constexpr int BM = 256, BK = 64, HALF = 128, HTB = HALF * BK * 2, STAGE_BYTES = 8 * HTB, NXCD = 8, WGM = 8;
__device__ __forceinline__ int lds_byte(int r, int c) { const int st = (r >> 4) * 2 + (c >> 5), rr = r & 15, cc = c & 31, ob = rr * 64 + cc * 2; return st * 1024 + (ob ^ (((ob >> 9) & 1) << 5)); }
__device__ __forceinline__ void stage_rc(int b, int& R, int& C) { const int st = b / 1024, sb = b % 1024, swz = sb ^ (((sb >> 9) & 1) << 5); R = (st >> 1) * 16 + swz / 64; C = (st & 1) * 32 + (swz % 64) / 2; }
__device__ __forceinline__ int perm32(int rho) { const int n = rho >> 4, i = rho & 15; return 8 * (i >> 2) + 4 * n + (i & 3); }
struct Unit { int pm, pn; };
struct Gemm { const bf16_t* A; const bf16_t* Bt; int M, N, K, lda, ldb, a_pn_bytes; };
struct StaticOrder {
    int nM, nN, nwg, G, c, owner;
    __device__ void init(int M, int N, int G_, int c_, int owner_ = 0) { nM = M / BM; nN = N / BM; nwg = nM * nN; G = G_; c = c_; owner = owner_; }
    __device__ bool next(int i, Unit& u) const {
        if (owner) { const int pm = c + (i / nN) * G; if (pm >= nM) return false; u.pm = pm; u.pn = i % nN; return true; }
        const long L = (long)i * G + c; if (L >= nwg) return false;
        int wgid = (int)L; { const int q = nwg / NXCD, r = nwg % NXCD, xcd = wgid % NXCD, off = wgid / NXCD; wgid = (xcd < r ? xcd * (q + 1) : r * (q + 1) + (xcd - r) * q) + off; }
        const int nig = WGM * nN, gid = wgid / nig, fm = gid * WGM, gsz = (nM - fm) < WGM ? (nM - fm) : WGM;
        u.pm = fm + ((wgid % nig) % gsz); u.pn = (wgid % nig) / gsz; return true;
    }
};

template <int OFF> __device__ __forceinline__ void ds_rd128(bf16x8& dst, unsigned addr) { asm volatile("ds_read_b128 %0, %1 offset:%2" : "=v"(dst) : "v"(addr), "n"(OFF)); }
template <class Epi>
__device__ __forceinline__ void gemm_phase(LAS unsigned char* lds, const Gemm g, const StaticOrder& S, const Epi& E) {
    int tid_l = threadIdx.x; asm volatile("" : "+v"(tid_l));
    const int tid = tid_l, wid = __builtin_amdgcn_readfirstlane(tid >> 6), lane = tid & 63, wr = wid >> 2, wc = wid & 3, fr = lane & 15, fq = lane >> 4;
    const int K = g.K, nt = K / BK;
    unsigned voffA[2], voffB[2];
#pragma unroll
    for (int i = 0; i < 2; ++i) { int R, C; stage_rc(tid * 16 + i * 8192, R, C); const int Rb = Epi::PERM ? ((R & ~31) + perm32(R & 31)) : R;
        voffA[i] = (unsigned)(R * g.lda + C) * 2u; voffB[i] = (unsigned)(Rb * g.ldb + C) * 2u; }
    const size_t kstep = (size_t)(BK * 2);
    const size_t hsA = (size_t)HALF * g.lda * 2, hsB = (size_t)HALF * g.ldb * 2;
    const size_t tsA = 2 * hsA, tsB = 2 * hsB;
    const unsigned ldsw = (unsigned)wid * 1024u;
    const int aoff = lds_byte(wr * 64 + fr, fq * 8), boff = lds_byte(wc * 32 + fr, fq * 8);
    const unsigned aaddr = (unsigned)(unsigned long long)(lds + aoff), baddr = (unsigned)(unsigned long long)(lds + 4 * HTB + boff);
#define PG8_SA(b, h) (((b) * 2 + (h)) * HTB)
#define PG8_SB(b, h) ((4 + (b) * 2 + (h)) * HTB)
#define PG8_STAGE(bufoff, gbase, voff) do { _Pragma("unroll") for (int _i = 0; _i < 2; ++_i) \
        __builtin_amdgcn_global_load_lds((const unsigned*)((const char*)(gbase) + (voff)[_i]), (LAS unsigned*)(lds + (bufoff) + ldsw + _i * 8192), 16, 0, 0); } while (0)
#define PG8_LDA(dst, b, h) do { _Pragma("unroll") for (int m = 0; m < 4; ++m) _Pragma("unroll") for (int k = 0; k < 2; ++k) dst[m][k] = *(const LAS bf16x8*)(lds + PG8_SA(b, h) + aoff + m * 2048 + k * 1024); } while (0)
#define PG8_LDB(dst, b, h) do { _Pragma("unroll") for (int n = 0; n < 2; ++n) _Pragma("unroll") for (int k = 0; k < 2; ++k) dst[n][k] = *(const LAS bf16x8*)(lds + PG8_SB(b, h) + boff + n * 2048 + k * 1024); } while (0)
#define PG8_MMA(ai, bj, At, Bt) do { __builtin_amdgcn_s_setprio(1); _Pragma("unroll") for (int m = 0; m < 4; ++m) _Pragma("unroll") for (int n = 0; n < 2; ++n) _Pragma("unroll") for (int k = 0; k < 2; ++k) \
        acc[ai][bj][m][n] = __builtin_amdgcn_mfma_f32_16x16x32_bf16(Bt[n][k], At[m][k], acc[ai][bj][m][n], 0, 0, 0); __builtin_amdgcn_s_setprio(0); } while (0)
#define PG8_RDA(dst, b, h) do { ds_rd128<PG8_SA(b, h) + 0 * 2048>(dst[0][0], aaddr); ds_rd128<PG8_SA(b, h) + 1 * 2048>(dst[1][0], aaddr); ds_rd128<PG8_SA(b, h) + 2 * 2048>(dst[2][0], aaddr); ds_rd128<PG8_SA(b, h) + 3 * 2048>(dst[3][0], aaddr); \
        ds_rd128<PG8_SA(b, h) + 0 * 2048 + 1024>(dst[0][1], aaddr); ds_rd128<PG8_SA(b, h) + 1 * 2048 + 1024>(dst[1][1], aaddr); ds_rd128<PG8_SA(b, h) + 2 * 2048 + 1024>(dst[2][1], aaddr); ds_rd128<PG8_SA(b, h) + 3 * 2048 + 1024>(dst[3][1], aaddr); } while (0)
#define PG8_RDB(dst, b, h) do { ds_rd128<PG8_SA(b, h)>(dst[0][0], baddr); ds_rd128<PG8_SA(b, h) + 2048>(dst[1][0], baddr); ds_rd128<PG8_SA(b, h) + 1024>(dst[0][1], baddr); ds_rd128<PG8_SA(b, h) + 2048 + 1024>(dst[1][1], baddr); } while (0)
#define PG8_WAITA(n, F, k) asm volatile("s_waitcnt lgkmcnt(" #n ")" : "+v"(F[0][k]), "+v"(F[1][k]), "+v"(F[2][k]), "+v"(F[3][k]) :: "memory")
#define PG8_WAITB(n, F, k) asm volatile("s_waitcnt lgkmcnt(" #n ")" : "+v"(F[0][k]), "+v"(F[1][k]) :: "memory")
#define PG8_WAITAB(n, FA, FB) asm volatile("s_waitcnt lgkmcnt(" #n ")" : "+v"(FA[0][0]), "+v"(FA[1][0]), "+v"(FA[2][0]), "+v"(FA[3][0]), "+v"(FB[0][0]), "+v"(FB[1][0]), "+v"(FB[0][1]), "+v"(FB[1][1]) :: "memory")
#define PG8_MMAK(ai, bj, At, Bt, k) do { _Pragma("unroll") for (int m = 0; m < 4; ++m) _Pragma("unroll") for (int n = 0; n < 2; ++n) \
        acc[ai][bj][m][n] = __builtin_amdgcn_mfma_f32_16x16x32_bf16(Bt[n][k], At[m][k], acc[ai][bj][m][n], 0, 0, 0); } while (0)
#define PG8_PRIO(x) __builtin_amdgcn_s_setprio(x)
#define PG8_WAIT_V(n) asm volatile("s_waitcnt vmcnt(" #n ")" ::: "memory")
#define PG8_WAIT_L(n) asm volatile("s_waitcnt lgkmcnt(" #n ")" ::: "memory")
#define PG8_BAR __builtin_amdgcn_s_barrier()
#define PG8_SCHED __builtin_amdgcn_sched_barrier(0)
    Unit cur, nxt; int ui = 0;
    if (!S.next(0, cur)) return;
    f32x4 acc[2][2][4][2];
#pragma unroll
    for (int a = 0; a < 2; ++a)
#pragma unroll
        for (int b = 0; b < 2; ++b)
#pragma unroll
            for (int m = 0; m < 4; ++m)
#pragma unroll
                for (int n = 0; n < 2; ++n) acc[a][b][m][n] = (f32x4){0.f, 0.f, 0.f, 0.f};
    bf16x8 At[4][2], B0[2][2], B1[2][2];
    const char* cA = (const char*)g.A + (size_t)cur.pm * tsA + (size_t)cur.pn * g.a_pn_bytes; const char* cB = (const char*)g.Bt + (size_t)cur.pn * tsB;
    PG8_STAGE(PG8_SB(0, 0), cB, voffB); PG8_STAGE(PG8_SA(0, 0), cA, voffA); PG8_STAGE(PG8_SB(0, 1), cB + hsB, voffB); PG8_STAGE(PG8_SA(0, 1), cA + hsA, voffA);
    if (wr == 1) PG8_BAR;
    PG8_WAIT_V(4); PG8_BAR;
    PG8_STAGE(PG8_SB(1, 0), cB + kstep, voffB); PG8_STAGE(PG8_SA(1, 0), cA + kstep, voffA); PG8_STAGE(PG8_SB(1, 1), cB + hsB + kstep, voffB);
    PG8_WAIT_V(6); PG8_BAR;
    PG8_RDB(B0, 0, 0);
    for (;;) {
        const bool has_next = S.next(ui + 1, nxt);
        const char* nA = has_next ? (const char*)g.A + (size_t)nxt.pm * tsA + (size_t)nxt.pn * g.a_pn_bytes : cA; const char* nB = has_next ? (const char*)g.Bt + (size_t)nxt.pn * tsB : cB;
#pragma unroll 1
        for (int t = 0; t < nt; t += 2) {
            const bool last = (t == nt - 2);
            const char* a1 = cA + (size_t)(t + 1) * kstep;
            const char* a2 = last ? nA : cA + (size_t)(t + 2) * kstep; const char* b2 = last ? nB : cB + (size_t)(t + 2) * kstep;
            const char* a3 = a2 + kstep; const char* b3 = b2 + kstep;
            PG8_RDA(At, 0, 0); PG8_STAGE(PG8_SA(1, 1), a1 + hsA, voffA);
            PG8_WAIT_V(10); PG8_BAR; PG8_PRIO(1); PG8_WAITAB(4, At, B0); PG8_SCHED; PG8_MMAK(0, 0, At, B0, 0); PG8_SCHED; PG8_WAITA(0, At, 1); PG8_SCHED; PG8_MMAK(0, 0, At, B0, 1); PG8_PRIO(0); PG8_BAR; PG8_SCHED;
            PG8_RDB(B1, 0, 1); PG8_STAGE(PG8_SB(0, 0), b2, voffB);
            PG8_WAIT_V(10); PG8_BAR; PG8_PRIO(1); PG8_WAITB(2, B1, 0); PG8_SCHED; PG8_MMAK(0, 1, At, B1, 0); PG8_SCHED; PG8_WAITB(0, B1, 1); PG8_SCHED; PG8_MMAK(0, 1, At, B1, 1); PG8_PRIO(0); PG8_BAR; PG8_SCHED;
            PG8_RDA(At, 0, 1); PG8_STAGE(PG8_SA(0, 0), a2, voffA);
            PG8_WAIT_V(10); PG8_BAR; PG8_PRIO(1); PG8_WAITA(4, At, 0); PG8_SCHED; PG8_MMAK(1, 0, At, B0, 0); PG8_SCHED; PG8_WAITA(0, At, 1); PG8_SCHED; PG8_MMAK(1, 0, At, B0, 1); PG8_PRIO(0); PG8_BAR; PG8_SCHED;
            PG8_RDB(B0, 1, 0); PG8_STAGE(PG8_SB(0, 1), b2 + hsB, voffB);
            PG8_WAIT_V(10); PG8_BAR; PG8_MMA(1, 1, At, B1); PG8_BAR; PG8_SCHED;
            PG8_RDA(At, 1, 0); PG8_STAGE(PG8_SA(0, 1), a2 + hsA, voffA);
            PG8_WAIT_V(10); PG8_BAR; PG8_PRIO(1); PG8_WAITAB(4, At, B0); PG8_SCHED; PG8_MMAK(0, 0, At, B0, 0); PG8_SCHED; PG8_WAITA(0, At, 1); PG8_SCHED; PG8_MMAK(0, 0, At, B0, 1); PG8_PRIO(0); PG8_BAR; PG8_SCHED;
            PG8_RDB(B1, 1, 1); PG8_STAGE(PG8_SB(1, 0), b3, voffB);
            PG8_WAIT_V(10); PG8_BAR; PG8_PRIO(1); PG8_WAITB(2, B1, 0); PG8_SCHED; PG8_MMAK(0, 1, At, B1, 0); PG8_SCHED; PG8_WAITB(0, B1, 1); PG8_SCHED; PG8_MMAK(0, 1, At, B1, 1); PG8_PRIO(0); PG8_BAR; PG8_SCHED;
            PG8_RDA(At, 1, 1); PG8_STAGE(PG8_SA(1, 0), a3, voffA);
            PG8_WAIT_V(10); PG8_BAR; PG8_PRIO(1); PG8_WAITA(4, At, 0); PG8_SCHED; PG8_MMAK(1, 0, At, B0, 0); PG8_SCHED; PG8_WAITA(0, At, 1); PG8_SCHED; PG8_MMAK(1, 0, At, B0, 1); PG8_PRIO(0); PG8_BAR; PG8_SCHED;
            if (!last) PG8_RDB(B0, 0, 0);
            PG8_STAGE(PG8_SB(1, 1), b3 + hsB, voffB);
            PG8_WAIT_V(10); PG8_BAR; PG8_MMA(1, 1, At, B1); PG8_BAR; PG8_SCHED;
        }
        E(acc, cur, wr, wc, fr, fq);
        if (!has_next) break;
#pragma unroll
        for (int a = 0; a < 2; ++a)
#pragma unroll
            for (int b = 0; b < 2; ++b)
#pragma unroll
                for (int m = 0; m < 4; ++m)
#pragma unroll
                    for (int n = 0; n < 2; ++n) acc[a][b][m][n] = (f32x4){0.f, 0.f, 0.f, 0.f};
        cur = nxt; cA = nA; cB = nB; ++ui;
        PG8_RDB(B0, 0, 0);
    }
    PG8_WAIT_V(0);
    if (wr == 0) PG8_BAR;
    PG8_BAR;
#undef PG8_SA
#undef PG8_SB
#undef PG8_STAGE
#undef PG8_LDA
#undef PG8_LDB
#undef PG8_MMA
#undef PG8_MMAK
#undef PG8_RDA
#undef PG8_RDB
#undef PG8_WAITA
#undef PG8_WAITB
#undef PG8_WAITAB
#undef PG8_PRIO
#undef PG8_WAIT_V
#undef PG8_WAIT_L
#undef PG8_BAR
#undef PG8_SCHED
}

typedef const f32x4 (&AccRef)[2][2][4][2];

struct EpiG1 {
    static constexpr bool PERM = true;
    bf16_t* zs; bf16_t* xbc; float* dtb; const float* dt_bias;
    __device__ __forceinline__ void operator()(AccRef acc, const Unit& u, int wr, int wc, int fr, int fq) const {
        const int row0 = u.pm * BM + wr * 64 + fr, pn = u.pn;
        if (pn < 24) {
            const bool act = pn < 8;
            bf16_t* base = act ? zs : xbc; const int ld = act ? 2048 : 4096; const int colt = act ? pn * 256 : (pn - 8) * 256;
            const int col0 = colt + wc * 32 + 8 * fq;
#pragma unroll
            for (int ai = 0; ai < 2; ++ai)
#pragma unroll
                for (int m = 0; m < 4; ++m) { bf16_t* rowp = base + (size_t)(row0 + ai * HALF + m * 16) * ld + col0;
#pragma unroll
                    for (int bj = 0; bj < 2; ++bj) { f32x4 v0 = acc[ai][bj][m][0], v1 = acc[ai][bj][m][1];
                        if (act) {
#pragma unroll
                            for (int j = 0; j < 4; ++j) { v0[j] = siluf_(v0[j]); v1[j] = siluf_(v1[j]); } }
                        *(u32x4*)(rowp + bj * HALF) = pack8(v0, v1); } }
        } else if (wc == 0) {
            const int c0 = 8 * fq; const f32x4 b0 = *(const f32x4*)(dt_bias + c0), b1 = *(const f32x4*)(dt_bias + c0 + 4);
#pragma unroll
            for (int ai = 0; ai < 2; ++ai)
#pragma unroll
                for (int m = 0; m < 4; ++m) { float* rowp = dtb + (size_t)(row0 + ai * HALF + m * 16) * 32 + c0;
                    f32x4 v0 = acc[ai][0][m][0] + b0, v1 = acc[ai][0][m][1] + b1;
#pragma unroll
                    for (int j = 0; j < 4; ++j) { v0[j] = softplusf_(v0[j]); v1[j] = softplusf_(v1[j]); }
                    *(f32x4*)rowp = v0; *(f32x4*)(rowp + 4) = v1; }
        }
    }
};
struct EpiG2 {
    static constexpr bool PERM = true;
    bf16_t* upool; bf16_t* gates; const float* b_gates;
    __device__ __forceinline__ void operator()(AccRef acc, const Unit& u, int wr, int wc, int fr, int fq) const {
        const int row0 = u.pm * BM + wr * 64 + fr, pn = u.pn;
        const bool act = pn >= 4;
        bf16_t* base = act ? gates : upool; const int ld = act ? 2048 : 1024; const int colt = act ? (pn - 4) * 256 : pn * 256;
        const int col0 = colt + wc * 32 + 8 * fq;
        f32x4 bv[2][2];
#pragma unroll
        for (int bj = 0; bj < 2; ++bj)
#pragma unroll
            for (int n = 0; n < 2; ++n) bv[bj][n] = act ? *(const f32x4*)(b_gates + col0 + bj * HALF + 4 * n) : (f32x4){0.f, 0.f, 0.f, 0.f};
#pragma unroll
        for (int ai = 0; ai < 2; ++ai)
#pragma unroll
            for (int m = 0; m < 4; ++m) { bf16_t* rowp = base + (size_t)(row0 + ai * HALF + m * 16) * ld + col0;
#pragma unroll
                for (int bj = 0; bj < 2; ++bj) { f32x4 v0 = acc[ai][bj][m][0] + bv[bj][0], v1 = acc[ai][bj][m][1] + bv[bj][1];
                    if (act) {
#pragma unroll
                        for (int j = 0; j < 4; ++j) { v0[j] = sigmoidf_(v0[j]); v1[j] = sigmoidf_(v1[j]); } }
                    *(u32x4*)(rowp + bj * HALF) = pack8(v0, v1); } }
    }
};
template <bool FIRST> struct EpiPool {
    static constexpr bool PERM = true;
    bf16_t* merged; const bf16_t* gates;
    __device__ __forceinline__ void operator()(AccRef acc, const Unit& u, int wr, int wc, int fr, int fq) const {
        const int row0 = u.pm * BM + wr * 64 + fr; const int col0 = u.pn * 256 + wc * 32 + 8 * fq;
#pragma unroll
        for (int ai = 0; ai < 2; ++ai) {
            u32x4 gw[4][2], pw[4][2];
#pragma unroll
            for (int m = 0; m < 4; ++m)
#pragma unroll
                for (int bj = 0; bj < 2; ++bj) { const size_t row = (size_t)(row0 + ai * HALF + m * 16);
                    gw[m][bj] = *(const u32x4*)(gates + row * 2048 + col0 + bj * HALF); if (!FIRST) pw[m][bj] = *(const u32x4*)(merged + row * 1024 + col0 + bj * HALF); }
#pragma unroll
            for (int m = 0; m < 4; ++m) { const size_t row = (size_t)(row0 + ai * HALF + m * 16);
#pragma unroll
                for (int bj = 0; bj < 2; ++bj) { f32x4 g0, g1, p0 = {0.f, 0.f, 0.f, 0.f}, p1 = {0.f, 0.f, 0.f, 0.f}; unpack8(gw[m][bj], g0, g1); if (!FIRST) unpack8(pw[m][bj], p0, p1);
                    const f32x4 v0 = p0 + acc[ai][bj][m][0] * g0, v1 = p1 + acc[ai][bj][m][1] * g1;
                    *(u32x4*)(merged + row * 1024 + col0 + bj * HALF) = pack8(v0, v1); } }
            asm volatile("" ::: "memory");
        }
    }
};
template <bool FIRST> struct EpiSsd {
    static constexpr bool PERM = true;
    bf16_t* merged; const bf16_t* gates;
    __device__ __forceinline__ void operator()(AccRef acc, const Unit& u, int wr, int wc, int fr, int fq) const {
        const int row0 = u.pm * BM + wr * 64 + fr; const int col0 = u.pn * 256 + wc * 32 + 8 * fq;
#pragma unroll
        for (int ai = 0; ai < 2; ++ai) {
            u32x4 gw[4][2], pw[4][2];
#pragma unroll
            for (int m = 0; m < 4; ++m)
#pragma unroll
                for (int bj = 0; bj < 2; ++bj) { const size_t row = (size_t)(row0 + ai * HALF + m * 16);
                    gw[m][bj] = *(const u32x4*)(gates + row * 2048 + 1024 + col0 + bj * HALF); if (!FIRST) pw[m][bj] = *(const u32x4*)(merged + row * 1024 + col0 + bj * HALF); }
#pragma unroll
            for (int m = 0; m < 4; ++m) { const size_t row = (size_t)(row0 + ai * HALF + m * 16);
#pragma unroll
                for (int bj = 0; bj < 2; ++bj) { f32x4 g0, g1, p0 = {0.f, 0.f, 0.f, 0.f}, p1 = {0.f, 0.f, 0.f, 0.f}; unpack8(gw[m][bj], g0, g1); if (!FIRST) unpack8(pw[m][bj], p0, p1);
                    const f32x4 v0 = p0 + acc[ai][bj][m][0] * g0, v1 = p1 + acc[ai][bj][m][1] * g1;
                    *(u32x4*)(merged + row * 1024 + col0 + bj * HALF) = pack8(v0, v1); } }
            asm volatile("" ::: "memory");
        }
    }
};
struct EpiUp {
    static constexpr bool PERM = true;
    bf16_t* upb;
    __device__ __forceinline__ void operator()(AccRef acc, const Unit& u, int wr, int wc, int fr, int fq) const {
        const int row0 = u.pm * BM + wr * 64 + fr; const int col0 = u.pn * 256 + wc * 32 + 8 * fq;
#pragma unroll
        for (int ai = 0; ai < 2; ++ai)
#pragma unroll
            for (int m = 0; m < 4; ++m) { bf16_t* rowp = upb + (size_t)(row0 + ai * HALF + m * 16) * DFF + col0;
#pragma unroll
                for (int bj = 0; bj < 2; ++bj) { f32x4 v0 = acc[ai][bj][m][0], v1 = acc[ai][bj][m][1];
#pragma unroll
                    for (int j = 0; j < 4; ++j) { const float a = fmaxf(v0[j], 0.f), b = fmaxf(v1[j], 0.f); v0[j] = a * a; v1[j] = b * b; }
                    *(u32x4*)(rowp + bj * HALF) = pack8(v0, v1); } }
    }
};
struct EpiOut {
    static constexpr bool PERM = true;
    const float* x; bf16_t* v;
    __device__ __forceinline__ void operator()(AccRef acc, const Unit& u, int wr, int wc, int fr, int fq) const {
        const int row0 = u.pm * BM + wr * 64 + fr, col0 = u.pn * BM + wc * 32 + 8 * fq;
#pragma unroll
        for (int ai = 0; ai < 2; ++ai) {
            f32x4 xv[4][2][2];
#pragma unroll
            for (int m = 0; m < 4; ++m)
#pragma unroll
                for (int bj = 0; bj < 2; ++bj)
#pragma unroll
                    for (int n = 0; n < 2; ++n) xv[m][bj][n] = *(const f32x4*)(x + (size_t)(row0 + ai * HALF + m * 16) * DM + col0 + bj * HALF + n * 4);
#pragma unroll
            for (int m = 0; m < 4; ++m) { const size_t off = (size_t)(row0 + ai * HALF + m * 16) * DM + col0;
#pragma unroll
                for (int bj = 0; bj < 2; ++bj) *(u32x4*)(v + off + bj * HALF) = pack8(xv[m][bj][0] * ALPHA + acc[ai][bj][m][0], xv[m][bj][1] * ALPHA + acc[ai][bj][m][1]); }
            asm volatile("" ::: "memory");
        }
    }
};
struct EpiDown {
    static constexpr bool PERM = true;
    const bf16_t* h1b; bf16_t* y;
    __device__ __forceinline__ void operator()(AccRef acc, const Unit& u, int wr, int wc, int fr, int fq) const {
        const int row0 = u.pm * BM + wr * 64 + fr, col0 = u.pn * BM + wc * 32 + 8 * fq;
        u32x4 hw[2][4][2];
#pragma unroll
        for (int ai = 0; ai < 2; ++ai)
#pragma unroll
            for (int m = 0; m < 4; ++m)
#pragma unroll
                for (int bj = 0; bj < 2; ++bj) hw[ai][m][bj] = *(const u32x4*)(h1b + (size_t)(row0 + ai * HALF + m * 16) * DM + col0 + bj * HALF);
#pragma unroll
        for (int ai = 0; ai < 2; ++ai)
#pragma unroll
            for (int m = 0; m < 4; ++m) { const size_t off = (size_t)(row0 + ai * HALF + m * 16) * DM + col0;
#pragma unroll
                for (int bj = 0; bj < 2; ++bj) { f32x4 h0, h1; unpack8(hw[ai][m][bj], h0, h1);
                    *(u32x4*)(y + off + bj * HALF) = pack8(h0 * ALPHA + acc[ai][bj][m][0], h1 * ALPHA + acc[ai][bj][m][1]); } }
    }
};
}

struct TrJob { const float* src; int ld_src, col0, K, ncols, nvalid; bf16_t* dst; int ld_dst; const float* cscale; };
__device__ __forceinline__ int tr_tiles(int K, int ncols) { return (K / 64) * (ncols / 256); }
__device__ __forceinline__ bool tr_pick(const Params& p, int gt, TrJob& J, int& lt) {
    unsigned char* ws = p.ws; const float* w_in = p.in[1];
    bf16_t* win1 = (bf16_t*)(ws + WS_WIN1); bf16_t* win2 = (bf16_t*)(ws + WS_WIN2);
    int base = 0, n;
#define TRJ(SRC, LDS_, COL0, K_, NC, NV, DST, LDD, CS) do { n = tr_tiles((K_), (NC)); if (gt < base + n) { J.src = (SRC); J.ld_src = (LDS_); J.col0 = (COL0); J.K = (K_); J.ncols = (NC); J.nvalid = (NV); J.dst = (DST); J.ld_dst = (LDD); J.cscale = (CS); lt = gt - base; return true; } base += n; } while (0)
    TRJ(w_in, 9248, 3072, 1024, 4096, 4096, win1 + (size_t)2048 * 1024, 1024, nullptr);
    TRJ(p.in[15], 4096, 0, 1024, 4096, 4096, (bf16_t*)(ws + WS_WUP), 1024, nullptr);
    TRJ(p.in[16], 1024, 0, 4096, 1024, 1024, (bf16_t*)(ws + WS_WDN), 4096, nullptr);
    TRJ(w_in, 9248, 1024, 1024, 2048, 2048, win1, 1024, nullptr);
    TRJ(w_in, 9248, 7200, 1024, 2048, 2048, win2 + (size_t)1024 * 1024, 1024, nullptr);
    TRJ(p.in[9], 1024, 0, 2048, 1024, 1024, (bf16_t*)(ws + WS_WSSD), 2048, nullptr);
    TRJ(w_in, 9248, 0, 1024, 1024, 1024, win2, 1024, nullptr);
    TRJ(p.in[12], 1024, 0, 1024, 1024, 1024, (bf16_t*)(ws + WS_WOUT), 1024, nullptr);
    TRJ(w_in, 9248, 7168, 1024, 256, 32, win1 + (size_t)6144 * 1024, 1024, nullptr);
    TRJ(p.in[10], 256, 0, 256, 256, 256, (bf16_t*)(ws + WS_WP), 256, p.in[11]);
    TRJ(p.in[10] + 65536, 256, 0, 256, 256, 256, (bf16_t*)(ws + WS_WP) + 65536, 256, p.in[11] + 256);
    TRJ(p.in[10] + 2 * 65536, 256, 0, 256, 256, 256, (bf16_t*)(ws + WS_WP) + 2 * 65536, 256, p.in[11] + 512);
    TRJ(p.in[10] + 3 * 65536, 256, 0, 256, 256, 256, (bf16_t*)(ws + WS_WP) + 3 * 65536, 256, p.in[11] + 768);
#undef TRJ
    return false;
}
__device__ void phase0(const Params& p, unsigned char* smem) {
    unsigned char* ws = p.ws;
    { const float* __restrict__ x = p.in[0]; bf16_t* __restrict__ xb = (bf16_t*)(ws + WS_RC);
      const size_t nvec = (size_t)T_TOK * DM / 8, stride = (size_t)gridDim.x * blockDim.x;
      for (size_t i = (size_t)blockIdx.x * blockDim.x + threadIdx.x; i < nvec; i += 4 * stride) {
          f32x4 a[4], b[4];
#pragma unroll
          for (int k = 0; k < 4; ++k) { a[k] = *(const f32x4*)(x + (i + k * stride) * 8); b[k] = *(const f32x4*)(x + (i + k * stride) * 8 + 4); }
#pragma unroll
          for (int k = 0; k < 4; ++k) *(u32x4*)(xb + (i + k * stride) * 8) = pack8(a[k], b[k]); } }
    float* t = (float*)smem;
    const int tid = threadIdx.x;
    for (int gt = blockIdx.x; ; gt += gridDim.x) {
        TrJob J; int lt;
        if (!tr_pick(p, gt, J, lt)) break;
        const int tn = J.ncols / 256; const int k0 = (lt / tn) * 64, n0 = (lt % tn) * 256;
        __syncthreads();
        float v[4][8];
#pragma unroll
        for (int sb = 0; sb < 4; ++sb)
#pragma unroll
            for (int i = 0; i < 8; ++i) { const int k = (tid >> 6) + 8 * i, n = n0 + sb * 64 + (tid & 63); const int nc = n < J.nvalid ? n : 0;
                const float ld = J.src[(size_t)(k0 + k) * J.ld_src + J.col0 + nc]; v[sb][i] = n < J.nvalid ? ld : 0.f; }
#pragma unroll
        for (int sb = 0; sb < 4; ++sb) { const float sc = J.cscale ? J.cscale[n0 + sb * 64 + (tid & 63)] : 1.0f;
#pragma unroll
            for (int i = 0; i < 8; ++i) t[(sb * 64 + (tid >> 6) + 8 * i) * 65 + (tid & 63)] = v[sb][i] * sc; }
        __syncthreads();
        const int n = tid >> 3, kk = (tid & 7) * 8;
#pragma unroll
        for (int sb = 0; sb < 4; ++sb) { float e[8];
#pragma unroll
            for (int j = 0; j < 8; ++j) e[j] = t[(sb * 64 + kk + j) * 65 + n];
            u32x4 w; w.x = cvt_pk_bf16(e[0], e[1]); w.y = cvt_pk_bf16(e[2], e[3]); w.z = cvt_pk_bf16(e[4], e[5]); w.w = cvt_pk_bf16(e[6], e[7]);
            *(u32x4*)(J.dst + (size_t)(n0 + sb * 64 + n) * J.ld_dst + k0 + kk) = w; }
    }
}

__device__ void phase_ssd_simple(const Params& p, unsigned char* smem) {
    unsigned char* ws = p.ws;
    const bf16_t* xbc = (const bf16_t*)(ws + WS_RA); bf16_t* zy = (bf16_t*)(ws + WS_RB); const float* dtb = (const float*)(ws + WS_DT);
    const float* conv_w = p.in[3]; const float* conv_b = p.in[4]; const float* a_log = p.in[6]; const float* d_skip = p.in[7]; const float* norm_w = p.in[8];
    float* sX = (float*)smem;
    float* sY = sX + 16 * 512;
    float* sdt = sY + 16 * 256;
    const int tid = threadIdx.x;
    for (int item = blockIdx.x; item < 256; item += gridDim.x) {
        const int b = item >> 3, g = item & 7;
        const int ch = tid; int gcol;
        if (ch < 256) gcol = g * 256 + ch; else if (ch < 384) gcol = 2048 + g * 128 + (ch - 256); else gcol = 3072 + g * 128 + (ch - 384);
        const float cw0 = conv_w[gcol], cw1 = conv_w[4096 + gcol], cw2 = conv_w[8192 + gcol], cw3 = conv_w[12288 + gcol], cb = conv_b[gcol];
        float u1 = 0.f, u2 = 0.f, u3 = 0.f;
        const int r = tid >> 7, pp = (tid & 127) >> 1, nh = tid & 1;
        const float a_r = -__expf(a_log[g * 4 + r]), d_r = d_skip[g * 4 + r];
        float hst[64];
#pragma unroll
        for (int i = 0; i < 64; ++i) hst[i] = 0.f;
        for (int blk = 0; blk < SEQ / 16; ++blk) {
            const size_t t0 = (size_t)b * SEQ + (size_t)blk * 16;
#pragma unroll 4
            for (int tt = 0; tt < 16; ++tt) { const float raw = bf2f(xbc[(t0 + tt) * 4096 + gcol]);
                const float y = cb + cw0 * u1 + cw1 * u2 + cw2 * u3 + cw3 * raw; u1 = u2; u2 = u3; u3 = raw;
                sX[tt * 512 + ch] = siluf_(y); }
            if (tid < 64) sdt[tid] = dtb[(t0 + (tid >> 2)) * 32 + g * 4 + (tid & 3)];
            __syncthreads();
            for (int tt = 0; tt < 16; ++tt) {
                const float dt = sdt[tt * 4 + r], dec = __expf(dt * a_r), xv = sX[tt * 512 + r * 64 + pp], xdt = xv * dt;
                const float* Bp = sX + tt * 512 + 256 + nh * 64; const float* Cp = sX + tt * 512 + 384 + nh * 64;
                float y = 0.f;
#pragma unroll
                for (int i = 0; i < 64; ++i) { hst[i] = hst[i] * dec + xdt * Bp[i]; y += hst[i] * Cp[i]; }
                y += __shfl_xor(y, 1);
                if (nh == 0) { const float zv = bf2f(zy[(t0 + tt) * 2048 + g * 256 + r * 64 + pp]); sY[tt * 256 + r * 64 + pp] = (y + d_r * xv) * zv; }
            }
            __syncthreads();
            { const int tt = tid >> 5, c0 = (tid & 31) * 8; float e[8]; float ss = 0.f;
#pragma unroll
              for (int j = 0; j < 8; ++j) { e[j] = sY[tt * 256 + c0 + j]; ss += e[j] * e[j]; }
              ss += __shfl_xor(ss, 16); ss += __shfl_xor(ss, 8); ss += __shfl_xor(ss, 4); ss += __shfl_xor(ss, 2); ss += __shfl_xor(ss, 1);
              const float rstd = rsqrtf(ss * (1.0f / 256.0f) + RMS_EPS);
              const f32x4 w0 = *(const f32x4*)(norm_w + g * 256 + c0), w1 = *(const f32x4*)(norm_w + g * 256 + c0 + 4);
              u32x4 o; o.x = cvt_pk_bf16(e[0] * rstd * w0[0], e[1] * rstd * w0[1]); o.y = cvt_pk_bf16(e[2] * rstd * w0[2], e[3] * rstd * w0[3]);
              o.z = cvt_pk_bf16(e[4] * rstd * w1[0], e[5] * rstd * w1[1]); o.w = cvt_pk_bf16(e[6] * rstd * w1[2], e[7] * rstd * w1[3]);
              *(u32x4*)(zy + (t0 + tt) * 2048 + g * 256 + c0) = o; }
            __syncthreads();
        }
    }
}


constexpr int SX_STR = 144, SN_STR = 272, SZ_STR = 528;
constexpr int O_XT = 0;
constexpr int O_BT = O_XT + 256 * SX_STR;
constexpr int O_BN = O_BT + 128 * SX_STR;
constexpr int O_CN = O_BN + 64 * SN_STR;
constexpr int O_CB = O_CN + 64 * SN_STR;
constexpr int O_ZT = O_CB + 64 * SN_STR;
constexpr int O_ACS = O_ZT + 64 * SZ_STR;
constexpr int O_DT = O_ACS + 1024;
constexpr int O_WG = O_DT + 1024;
constexpr int O_EA = O_WG + 1024;
constexpr int O_SSQ = O_EA + 1024;
constexpr int O_RSTD = O_SSQ + 2048;
constexpr int O_CW = O_RSTD + 256;
constexpr int O_RSW = O_CW + 5 * 512 * 4;
constexpr int SSD_LDS = O_RSW + 2048;
static_assert(SSD_LDS <= LDS_BYTES, "LDS");
#define MFMA16(a, b, c) __builtin_amdgcn_mfma_f32_16x16x32_bf16((a), (b), (c), 0, 0, 0)

template <int CTRL> __device__ __forceinline__ float dpp_add(float v) { return v + __builtin_bit_cast(float, __builtin_amdgcn_update_dpp(0, __builtin_bit_cast(int, v), CTRL, 0xf, 0xf, false)); }
__device__ __forceinline__ float row16_sum(float v) { v = dpp_add<0xB1>(v); v = dpp_add<0x4E>(v); v = dpp_add<0x124>(v); v = dpp_add<0x128>(v); return v; }
__device__ __forceinline__ f32x4 unpack4(u32x2 w) { return (f32x4){bf_lo(w.x), bf_hi(w.x), bf_lo(w.y), bf_hi(w.y)}; }

__device__ void phase_ssd(const Params& p, LAS unsigned char* sm) {
    unsigned char* ws = p.ws;
    const bf16_t* xbc = (const bf16_t*)(ws + WS_RA); bf16_t* zy = (bf16_t*)(ws + WS_RB); const float* dtb = (const float*)(ws + WS_DT);
    const float* conv_w = p.in[3]; const float* conv_b = p.in[4]; const float* a_log = p.in[6]; const float* d_skip = p.in[7]; const float* norm_w = p.in[8];
    const int tid = threadIdx.x, lane = tid & 63, w = __builtin_amdgcn_readfirstlane(tid >> 6), c = lane & 15, q = lane >> 4;
    const int r = w >> 1, ph = w & 1;
    const int tq = tid >> 7, ch0 = (tid & 127) * 4;
    LAS float* ACS = (LAS float*)(sm + O_ACS); LAS float* DTV = (LAS float*)(sm + O_DT); LAS float* WG = (LAS float*)(sm + O_WG); LAS float* EA = (LAS float*)(sm + O_EA);
    LAS float* SSQ = (LAS float*)(sm + O_SSQ); LAS float* RSTD = (LAS float*)(sm + O_RSTD);
    for (int item = blockIdx.x; item < 256; item += gridDim.x) {
        const int b = item >> 3, g = item & 7;
#define SSD_GCOL(CH) ((CH) < 256 ? g * 256 + (CH) : ((CH) < 384 ? 1792 + g * 128 + (CH) : 2688 + g * 128 + (CH)))
        { const int gcol = SSD_GCOL(ch0);
        __syncthreads();
        if (tq == 0) {
#pragma unroll
            for (int k = 0; k < 4; ++k) *(LAS f32x4*)(sm + O_CW + (k * 512 + ch0) * 4) = *(const f32x4*)(conv_w + k * 4096 + gcol);
            *(LAS f32x4*)(sm + O_CW + (4 * 512 + ch0) * 4) = *(const f32x4*)(conv_b + gcol); }
        __syncthreads(); }
        const float d_r = d_skip[g * 4 + r];
        const float a_w = -__expf(a_log[g * 4 + (w & 3)]);
        const int prow0 = r * 64 + ph * 32 + c;
        const float nw0 = norm_w[g * 256 + prow0], nw1 = norm_w[g * 256 + prow0 + 16];
        f32x4 accH[8][2];
#pragma unroll
        for (int nt = 0; nt < 8; ++nt)
#pragma unroll
            for (int pt = 0; pt < 2; ++pt) accH[nt][pt] = (f32x4){0.f, 0.f, 0.f, 0.f};
        u32x2 raw[19]; u32x4 zr[4]; float dtn = 0.f;
#define SSD_ISSUE(SUBN) do { int sn_ = (SUBN); asm volatile("" : "+s"(sn_)); int tid_ = tid; asm volatile("" : "+v"(tid_)); const int ch_ = (tid_ & 127) * 4; const int gc_ = SSD_GCOL(ch_); \
            const int sl0_ = sn_ * 64 + (tid_ >> 7) * 16 - 3; const bf16_t* rp_ = xbc + ((size_t)b * SEQ + (sl0_ < 0 ? 0 : sl0_)) * 4096 + gc_; \
            _Pragma("unroll") for (int i = 0; i < 19; ++i) { const int sl = sl0_ + i; \
                const u32x2 v = *(const u32x2*)(rp_ + (sl0_ < 0 ? (i < 3 ? 0 : i - 3) : i) * 4096); raw[i].x = sl < 0 ? 0u : v.x; raw[i].y = sl < 0 ? 0u : v.y; } \
            const bf16_t* zp_ = zy + ((size_t)b * SEQ + (size_t)sn_ * 64 + (tid_ >> 5)) * 2048 + g * 256 + (tid_ & 31) * 8; \
            _Pragma("unroll") for (int k = 0; k < 4; ++k) zr[k] = *(const u32x4*)(zp_ + (size_t)k * 16 * 2048); \
            if (w < 4) dtn = dtb[((size_t)b * SEQ + (size_t)sn_ * 64 + lane) * 32 + g * 4 + w]; } while (0)
        SSD_ISSUE(0);
#pragma unroll 1
        for (int sub = 0; sub < SEQ / 64; ++sub) {
            const size_t t0 = (size_t)b * SEQ + (size_t)sub * 64;
            {
                const f32x4 cw0 = *(const LAS f32x4*)(sm + O_CW + ch0 * 4), cw1 = *(const LAS f32x4*)(sm + O_CW + (512 + ch0) * 4), cw2 = *(const LAS f32x4*)(sm + O_CW + (1024 + ch0) * 4),
                            cw3 = *(const LAS f32x4*)(sm + O_CW + (1536 + ch0) * 4), cbv = *(const LAS f32x4*)(sm + O_CW + (2048 + ch0) * 4);
                f32x4 u0 = unpack4(raw[0]), u1 = unpack4(raw[1]), u2 = unpack4(raw[2]);
                unsigned tr[4][8]; f32x4 pv = {0.f, 0.f, 0.f, 0.f};
                LAS unsigned char* nb = ch0 < 384 ? sm + O_BN + (ch0 - 256) * 2 : sm + O_CN + (ch0 - 384) * 2;
#pragma unroll
                for (int i = 0; i < 16; ++i) {
                    const f32x4 u3 = unpack4(raw[i + 3]);
                    f32x4 y = cbv + cw0 * u0 + cw1 * u1 + cw2 * u2 + cw3 * u3;
#pragma unroll
                    for (int j = 0; j < 4; ++j) y[j] = siluf_(y[j]);
                    if (ch0 >= 256) *(LAS u32x2*)(nb + (tq * 16 + i) * SN_STR) = (u32x2){cvt_pk_bf16(y[0], y[1]), cvt_pk_bf16(y[2], y[3])};
                    if (i & 1) {
#pragma unroll
                        for (int j = 0; j < 4; ++j) tr[j][i >> 1] = cvt_pk_bf16(pv[j], y[j]); }
                    else pv = y;
                    u0 = u1; u1 = u2; u2 = u3;
                }
                if (ch0 < 384) {
                    LAS unsigned char* tb = ch0 < 256 ? sm + O_XT + ch0 * SX_STR : sm + O_BT + (ch0 - 256) * SX_STR;
#pragma unroll
                    for (int j = 0; j < 4; ++j) { *(LAS u32x4*)(tb + j * SX_STR + tq * 32) = (u32x4){tr[j][0], tr[j][1], tr[j][2], tr[j][3]};
                        *(LAS u32x4*)(tb + j * SX_STR + tq * 32 + 16) = (u32x4){tr[j][4], tr[j][5], tr[j][6], tr[j][7]}; }
                }
            }
            if (w < 4) {
                const float dt = dtn; float x = dt * a_w;
#pragma unroll
                for (int o = 1; o < 64; o <<= 1) { const float v = __shfl_up(x, o); if (lane >= o) x += v; }
                const float last = __shfl(x, 63);
                ACS[w * 64 + lane] = x; DTV[w * 64 + lane] = dt; WG[w * 64 + lane] = dt * __expf(last - x); EA[w * 64 + lane] = __expf(x);
            }
            __syncthreads();
            {
#pragma unroll
                for (int k = 0; k < 4; ++k) { const int v = tid + 512 * k, l = v >> 5, c8 = (v & 31) * 8; *(LAS u32x4*)(sm + O_ZT + l * SZ_STR + c8 * 2) = zr[k]; }
                const int lt = w >> 1;
#pragma unroll
                for (int sti = 0; sti < 2; ++sti) { const int st = 2 * (w & 1) + sti; f32x4 acc = {0.f, 0.f, 0.f, 0.f};
#pragma unroll
                    for (int ks = 0; ks < 4; ++ks) { const bf16x8 a = *(const LAS bf16x8*)(sm + O_CN + (16 * lt + c) * SN_STR + (32 * ks + 8 * q) * 2);
                        const bf16x8 bb = *(const LAS bf16x8*)(sm + O_BN + (16 * st + c) * SN_STR + (32 * ks + 8 * q) * 2); acc = MFMA16(a, bb, acc); }
#pragma unroll
                    for (int rg = 0; rg < 4; ++rg) *(LAS float*)(sm + O_CB + (16 * lt + 4 * q + rg) * SN_STR + (16 * st + c) * 4) = acc[rg]; }
            }
            __syncthreads();
            f32x4 accY[4][2];
#pragma unroll
            for (int lt = 0; lt < 4; ++lt)
#pragma unroll
                for (int pt = 0; pt < 2; ++pt) accY[lt][pt] = (f32x4){0.f, 0.f, 0.f, 0.f};
#pragma unroll
            for (int ks = 0; ks < 4; ++ks) {
                bf16x8 hb[2];
#pragma unroll
                for (int pt = 0; pt < 2; ++pt) hb[pt] = __builtin_bit_cast(bf16x8, pack8(accH[2 * ks][pt], accH[2 * ks + 1][pt]));
#pragma unroll
                for (int lt = 0; lt < 4; ++lt) { const LAS unsigned char* cp = sm + O_CN + (16 * lt + c) * SN_STR + (32 * ks + 4 * q) * 2;
                    const u32x2 lo = *(const LAS u32x2*)cp, hi = *(const LAS u32x2*)(cp + 32);
                    const bf16x8 a = __builtin_bit_cast(bf16x8, (u32x4){lo.x, lo.y, hi.x, hi.y});
#pragma unroll
                    for (int pt = 0; pt < 2; ++pt) accY[lt][pt] = MFMA16(a, hb[pt], accY[lt][pt]); }
            }
#pragma unroll
            for (int lt = 0; lt < 4; ++lt) { const f32x4 e = *(const LAS f32x4*)(EA + r * 64 + 16 * lt + 4 * q);
#pragma unroll
                for (int pt = 0; pt < 2; ++pt) accY[lt][pt] *= e; }
            bf16x8 xf[2][2];
#pragma unroll
            for (int ks = 0; ks < 2; ++ks)
#pragma unroll
                for (int pt = 0; pt < 2; ++pt) xf[ks][pt] = *(const LAS bf16x8*)(sm + O_XT + (prow0 + 16 * pt) * SX_STR + (32 * ks + 8 * q) * 2);
#pragma unroll
            for (int lt = 0; lt < 4; ++lt)
#pragma unroll
                for (int ks = 0; ks < 2; ++ks) {
                    if (ks == 1 && lt < 2) continue;
                    const int l = 16 * lt + c; const float acl = ACS[r * 64 + l];
                    const LAS float* cbp = (const LAS float*)(sm + O_CB + l * SN_STR) + 32 * ks + 8 * q;
                    const f32x4 cb0 = *(const LAS f32x4*)cbp, cb1 = *(const LAS f32x4*)(cbp + 4);
                    const f32x4 as0 = *(const LAS f32x4*)(ACS + r * 64 + 32 * ks + 8 * q), as1 = *(const LAS f32x4*)(ACS + r * 64 + 32 * ks + 8 * q + 4);
                    const f32x4 d0 = *(const LAS f32x4*)(DTV + r * 64 + 32 * ks + 8 * q), d1 = *(const LAS f32x4*)(DTV + r * 64 + 32 * ks + 8 * q + 4);
                    f32x4 m0, m1;
#pragma unroll
                    for (int j = 0; j < 4; ++j) { const int s0 = 32 * ks + 8 * q + j, s1 = s0 + 4;
                        m0[j] = (s0 <= l) ? cb0[j] * __expf(acl - as0[j]) * d0[j] : 0.f;
                        m1[j] = (s1 <= l) ? cb1[j] * __expf(acl - as1[j]) * d1[j] : 0.f; }
                    const bf16x8 mf = __builtin_bit_cast(bf16x8, pack8(m0, m1));
#pragma unroll
                    for (int pt = 0; pt < 2; ++pt) accY[lt][pt] = MFMA16(mf, xf[ks][pt], accY[lt][pt]);
                }
#pragma unroll
            for (int lt = 0; lt < 4; ++lt) {
#pragma unroll
                for (int pt = 0; pt < 2; ++pt) { const int prow = prow0 + 16 * pt;
                    const f32x4 xv = unpack4(*(const LAS u32x2*)(sm + O_XT + prow * SX_STR + (16 * lt + 4 * q) * 2));
#pragma unroll
                    for (int rg = 0; rg < 4; ++rg) { const int l = 16 * lt + 4 * q + rg; const float zv = bf2f(*(const LAS bf16_t*)(sm + O_ZT + l * SZ_STR + prow * 2));
                        accY[lt][pt][rg] = (accY[lt][pt][rg] + d_r * xv[rg]) * zv; } }
                f32x4 sv;
#pragma unroll
                for (int rg = 0; rg < 4; ++rg) sv[rg] = row16_sum(accY[lt][0][rg] * accY[lt][0][rg] + accY[lt][1][rg] * accY[lt][1][rg]);
                if (c == 0) *(LAS f32x4*)(SSQ + w * 64 + 16 * lt + 4 * q) = sv;
            }
            {
                const float dec = __expf(ACS[r * 64 + 63]);
#pragma unroll
                for (int nt = 0; nt < 8; ++nt)
#pragma unroll
                    for (int pt = 0; pt < 2; ++pt) accH[nt][pt] *= dec;
                bf16x8 xw[2][2];
#pragma unroll
                for (int ks = 0; ks < 2; ++ks) { const f32x4 w0 = *(const LAS f32x4*)(WG + r * 64 + 32 * ks + 8 * q), w1 = *(const LAS f32x4*)(WG + r * 64 + 32 * ks + 8 * q + 4);
#pragma unroll
                    for (int pt = 0; pt < 2; ++pt) { f32x4 a, bq; unpack8(__builtin_bit_cast(u32x4, xf[ks][pt]), a, bq); xw[ks][pt] = __builtin_bit_cast(bf16x8, pack8(a * w0, bq * w1)); } }
#pragma unroll
                for (int nt = 0; nt < 8; ++nt)
#pragma unroll
                    for (int ks = 0; ks < 2; ++ks) { const bf16x8 bfr = *(const LAS bf16x8*)(sm + O_BT + (16 * nt + c) * SX_STR + (32 * ks + 8 * q) * 2);
#pragma unroll
                        for (int pt = 0; pt < 2; ++pt) accH[nt][pt] = MFMA16(bfr, xw[ks][pt], accH[nt][pt]); }
            }
            SSD_ISSUE(sub + 1 < SEQ / 64 ? sub + 1 : sub);
            __syncthreads();
            { float s = 0.f;
#pragma unroll
              for (int k = 0; k < 8; ++k) s += SSQ[k * 64 + lane];
              LAS float* RSW = (LAS float*)(sm + O_RSW) + w * 64;
              RSW[lane] = rsqrtf(s * (1.0f / 256.0f) + RMS_EPS);
#pragma unroll
              for (int lt = 0; lt < 4; ++lt) { const f32x4 rs = *(const LAS f32x4*)(RSW + 16 * lt + 4 * q);
#pragma unroll
                for (int pt = 0; pt < 2; ++pt) { const float nw = pt ? nw1 : nw0;
#pragma unroll
                    for (int rg = 0; rg < 4; ++rg) { const int l = 16 * lt + 4 * q + rg;
                        *(LAS bf16_t*)(sm + O_ZT + l * SZ_STR + (prow0 + 16 * pt) * 2) = (bf16_t)(cvt_pk_bf16(accY[lt][pt][rg] * rs[rg] * nw, 0.f) & 0xffffu); } } }
#pragma unroll
              for (int k = 0; k < 4; ++k) { const int row = (lane >> 2) + 16 * k, pc = lane & 3;
                *(u32x4*)(zy + (t0 + row) * 2048 + g * 256 + r * 64 + ph * 32 + pc * 8) = *(const LAS u32x4*)(sm + O_ZT + row * SZ_STR + (r * 64 + ph * 32 + pc * 8) * 2); }
            }
        }
    }
}

template <int W, int RUN = 16>
__device__ __forceinline__ void pool_task(const bf16_t* __restrict__ colp, bf16_t* __restrict__ outp, int t0, int s0) {
    constexpr int H = W - 1;
    u32x4 rw[RUN + H];
#pragma unroll
    for (int j = 0; j < RUN + H; ++j) { int tt = t0 - H + j; tt = tt < 0 ? 0 : tt; rw[j] = *(const u32x4*)(colp + (size_t)tt * 1024); }
    f32x4 S0 = {0.f, 0.f, 0.f, 0.f}, S1 = {0.f, 0.f, 0.f, 0.f};
#pragma unroll
    for (int j = 1; j <= H; ++j) { f32x4 a, b; unpack8(rw[H - j], a, b); const bool ok = (s0 - j >= 0); S0 += ok ? a : (f32x4){0.f, 0.f, 0.f, 0.f}; S1 += ok ? b : (f32x4){0.f, 0.f, 0.f, 0.f}; }
#pragma unroll
    for (int tt = 0; tt < RUN; ++tt) { const int s = s0 + tt;
        f32x4 a, b; unpack8(rw[H + tt], a, b); S0 += a; S1 += b;
        const float inv = 1.0f / (float)(s + 1 < W ? s + 1 : W);
        *(u32x4*)(outp + (size_t)(t0 + tt) * 1024) = pack8(S0 * inv - a, S1 * inv - b);
        f32x4 c, d; unpack8(rw[tt], c, d);
        if (s - W + 1 >= 0) { S0 -= c; S1 -= d; } }
}
__device__ __forceinline__ void pool_tile(const Params& p, int pm, int g) {
    const bf16_t* up = (const bf16_t*)(p.ws + WS_RA); bf16_t* pooled = (bf16_t*)(p.ws + WS_RA + 384 * MiB);
    int tl = threadIdx.x; asm volatile("" : "+v"(tl));
    const int vec = g * 32 + (tl & 31), run = tl >> 5;
    const int t0 = pm * 256 + run * 16, s0 = t0 & (SEQ - 1);
    const bf16_t* colp = up + vec * 8; bf16_t* outp = pooled + vec * 8;
    if (g == 0) pool_task<2>(colp, outp, t0, s0); else if (g == 1) pool_task<4>(colp, outp, t0, s0);
    else if (g == 2) pool_task<8>(colp, outp, t0, s0); else { pool_task<16, 8>(colp, outp, t0, s0); pool_task<16, 8>(colp, outp, t0 + 8, s0 + 8); }
}

template <bool OUT_BF16>
__device__ void phase_ln(const bf16_t* __restrict__ src, void* __restrict__ dst, const float* __restrict__ gam, const float* __restrict__ bet) {
    const int lane = threadIdx.x & 63, wv = threadIdx.x >> 6;
    f32x4 gv[4], bv[4];
#pragma unroll
    for (int i = 0; i < 2; ++i) { gv[2 * i] = *(const f32x4*)(gam + lane * 8 + 512 * i); gv[2 * i + 1] = *(const f32x4*)(gam + lane * 8 + 512 * i + 4);
        bv[2 * i] = *(const f32x4*)(bet + lane * 8 + 512 * i); bv[2 * i + 1] = *(const f32x4*)(bet + lane * 8 + 512 * i + 4); }
    for (int row0 = (blockIdx.x * 8 + wv) * 4; row0 < T_TOK; row0 += gridDim.x * 8 * 4) {
        u32x4 rw[4][2];
#pragma unroll
        for (int rr = 0; rr < 4; ++rr)
#pragma unroll
            for (int i = 0; i < 2; ++i) rw[rr][i] = *(const u32x4*)(src + (size_t)(row0 + rr) * DM + lane * 8 + 512 * i);
#pragma unroll
        for (int rr = 0; rr < 4; ++rr) {
            f32x4 v[4]; unpack8(rw[rr][0], v[0], v[1]); unpack8(rw[rr][1], v[2], v[3]);
            float s = 0.f;
#pragma unroll
            for (int i = 0; i < 4; ++i) s += (v[i][0] + v[i][1]) + (v[i][2] + v[i][3]);
#pragma unroll
            for (int o = 32; o >= 1; o >>= 1) s += __shfl_xor(s, o);
            const float mu = s * (1.0f / 1024.0f); float q = 0.f;
#pragma unroll
            for (int i = 0; i < 4; ++i) { v[i] -= mu; q += (v[i][0] * v[i][0] + v[i][1] * v[i][1]) + (v[i][2] * v[i][2] + v[i][3] * v[i][3]); }
#pragma unroll
            for (int o = 32; o >= 1; o >>= 1) q += __shfl_xor(q, o);
            const float rstd = rsqrtf(q * (1.0f / 1024.0f) + LN_EPS);
#pragma unroll
            for (int i = 0; i < 2; ++i) { const f32x4 o0 = v[2 * i] * rstd * gv[2 * i] + bv[2 * i], o1 = v[2 * i + 1] * rstd * gv[2 * i + 1] + bv[2 * i + 1];
                if (OUT_BF16) *(u32x4*)((bf16_t*)dst + (size_t)(row0 + rr) * DM + lane * 8 + 512 * i) = pack8(o0, o1);
                else { float* op = (float*)dst + (size_t)(row0 + rr) * DM + lane * 8 + 512 * i; *(f32x4*)op = o0; *(f32x4*)(op + 4) = o1; } }
        }
    }
}

__device__ __forceinline__ void ln_panel_bf16(const bf16_t* __restrict__ src, bf16_t* __restrict__ dst, const float* __restrict__ gam, const float* __restrict__ bet, int r0) {
    int tl = threadIdx.x; asm volatile("" : "+v"(tl));
    const int lane = tl & 63, wv = tl >> 6;
    f32x4 gv[4], bv[4];
#pragma unroll
    for (int i = 0; i < 2; ++i) { gv[2 * i] = *(const f32x4*)(gam + lane * 8 + 512 * i); gv[2 * i + 1] = *(const f32x4*)(gam + lane * 8 + 512 * i + 4);
        bv[2 * i] = *(const f32x4*)(bet + lane * 8 + 512 * i); bv[2 * i + 1] = *(const f32x4*)(bet + lane * 8 + 512 * i + 4); }
#pragma unroll 1
    for (int k = 0; k < 8; ++k) { const int row0 = r0 + wv * 32 + k * 4;
        u32x4 rw[4][2];
#pragma unroll
        for (int rr = 0; rr < 4; ++rr)
#pragma unroll
            for (int i = 0; i < 2; ++i) rw[rr][i] = *(const u32x4*)(src + (size_t)(row0 + rr) * DM + lane * 8 + 512 * i);
#pragma unroll
        for (int rr = 0; rr < 4; ++rr) {
            f32x4 v[4]; unpack8(rw[rr][0], v[0], v[1]); unpack8(rw[rr][1], v[2], v[3]);
            float sm = 0.f;
#pragma unroll
            for (int i = 0; i < 4; ++i) sm += (v[i][0] + v[i][1]) + (v[i][2] + v[i][3]);
#pragma unroll
            for (int o = 32; o >= 1; o >>= 1) sm += __shfl_xor(sm, o);
            const float mu = sm * (1.0f / 1024.0f); float q = 0.f;
#pragma unroll
            for (int i = 0; i < 4; ++i) { v[i] -= mu; q += (v[i][0] * v[i][0] + v[i][1] * v[i][1]) + (v[i][2] * v[i][2] + v[i][3] * v[i][3]); }
#pragma unroll
            for (int o = 32; o >= 1; o >>= 1) q += __shfl_xor(q, o);
            const float rstd = rsqrtf(q * (1.0f / 1024.0f) + LN_EPS);
#pragma unroll
            for (int i = 0; i < 2; ++i) *(u32x4*)(dst + (size_t)(row0 + rr) * DM + lane * 8 + 512 * i) = pack8(v[2 * i] * rstd * gv[2 * i] + bv[2 * i], v[2 * i + 1] * rstd * gv[2 * i + 1] + bv[2 * i + 1]);
        }
    }
}

__global__ void __launch_bounds__(512, 2) mega(Params p) {
    extern __shared__ __attribute__((aligned(16))) unsigned char lds_raw[];
    LAS unsigned char* lds = (LAS unsigned char*)lds_raw;
    cg::grid_group grid = cg::this_grid();
    unsigned char* ws = p.ws;
    const int G = gridDim.x, c = blockIdx.x;
#ifndef PHMASK
#define PHMASK 0x7ff
#endif
#define IN(k) (((PHMASK >> (k)) & 1) && p.ph_lo <= (k) && (k) < p.ph_hi)
#define SEAM(k) do { if (IN(k) && IN((k) + 1)) grid.sync(); } while (0)
    if (IN(0)) phase0(p, lds_raw);
    SEAM(0);
    if (IN(1)) {
        pg8::Gemm g{(const bf16_t*)(ws + WS_RC), (const bf16_t*)(ws + WS_WIN1), T_TOK, N1, 1024, 1024, 1024, 0};
        pg8::StaticOrder S; S.init(T_TOK, N1, G, c);
        pg8::EpiG1 E{(bf16_t*)(ws + WS_RB), (bf16_t*)(ws + WS_RA), (float*)(ws + WS_DT), p.in[5]};
        pg8::gemm_phase<pg8::EpiG1>(lds, g, S, E);
    }
    SEAM(1);
    #ifdef SSD_SIMPLE
    if (IN(2)) phase_ssd_simple(p, lds_raw);
#else
    if (IN(2)) phase_ssd(p, lds);
#endif
    SEAM(2);
    if (IN(3)) {
        pg8::Gemm g{(const bf16_t*)(ws + WS_RC), (const bf16_t*)(ws + WS_WIN2), T_TOK, N2, 1024, 1024, 1024, 0};
        pg8::StaticOrder S; S.init(T_TOK, N2, G, c);
        pg8::EpiG2 E{(bf16_t*)(ws + WS_RA), (bf16_t*)(ws + WS_RA + 128 * MiB), p.in[2]};
        pg8::gemm_phase<pg8::EpiG2>(lds, g, S, E);
    }
    SEAM(3);
    if (IN(5)) {
        bf16_t* merged = (bf16_t*)(ws + WS_RC); const bf16_t* gates = (const bf16_t*)(ws + WS_RA + 128 * MiB);
        pg8::StaticOrder S; S.init(T_TOK, 1024, G, c);
        const pg8::Gemm gp{(const bf16_t*)(ws + WS_RA + 384 * MiB), (const bf16_t*)(ws + WS_WP), T_TOK, 1024, 256, 1024, 256, 512};
        const pg8::Gemm gs{(const bf16_t*)(ws + WS_RB), (const bf16_t*)(ws + WS_WSSD), T_TOK, 1024, 2048, 2048, 2048, 0};
        if ((c & 1) == 0) {
            { pg8::Unit u; for (int i = 0; S.next(i, u); ++i) pool_tile(p, u.pm, u.pn); }
            __syncthreads();
            { pg8::EpiPool<true> E{merged, gates}; pg8::gemm_phase<pg8::EpiPool<true>>(lds, gp, S, E); }
            { pg8::EpiSsd<false> E{merged, gates}; pg8::gemm_phase<pg8::EpiSsd<false>>(lds, gs, S, E); }
        } else {
            { pg8::EpiSsd<true> E{merged, gates}; pg8::gemm_phase<pg8::EpiSsd<true>>(lds, gs, S, E); }
            { pg8::Unit u; for (int i = 0; S.next(i, u); ++i) pool_tile(p, u.pm, u.pn); }
            __syncthreads();
            { pg8::EpiPool<false> E{merged, gates}; pg8::gemm_phase<pg8::EpiPool<false>>(lds, gp, S, E); }
        }
    }
    SEAM(5);
    if (IN(6)) {
        pg8::Gemm g{(const bf16_t*)(ws + WS_RC), (const bf16_t*)(ws + WS_WOUT), T_TOK, 1024, 1024, 1024, 1024, 0};
        pg8::StaticOrder S; S.init(T_TOK, 1024, G, c, 1);
        pg8::EpiOut E{p.in[0], (bf16_t*)(ws + WS_RB)};
        pg8::gemm_phase<pg8::EpiOut>(lds, g, S, E);
        __syncthreads();
        for (int pm = c; pm < T_TOK / 256; pm += G) ln_panel_bf16((const bf16_t*)(ws + WS_RB), (bf16_t*)(ws + WS_RC), p.in[13], p.in[14], pm * 256);
    }
    SEAM(6);
    if (IN(8)) {
        pg8::Gemm g{(const bf16_t*)(ws + WS_RC), (const bf16_t*)(ws + WS_WUP), T_TOK, DFF, 1024, 1024, 1024, 0};
        pg8::StaticOrder S; S.init(T_TOK, DFF, G, c);
        pg8::EpiUp E{(bf16_t*)(ws + WS_RA)};
        pg8::gemm_phase<pg8::EpiUp>(lds, g, S, E);
    }
    SEAM(8);
    if (IN(9)) {
        pg8::Gemm g{(const bf16_t*)(ws + WS_RA), (const bf16_t*)(ws + WS_WDN), T_TOK, 1024, DFF, DFF, DFF, 0};
        pg8::StaticOrder S; S.init(T_TOK, 1024, G, c);
        pg8::EpiDown E{(const bf16_t*)(ws + WS_RC), (bf16_t*)(ws + WS_RB)};
        pg8::gemm_phase<pg8::EpiDown>(lds, g, S, E);
    }
    SEAM(9);
    if (IN(10)) phase_ln<false>((const bf16_t*)(ws + WS_RB), (void*)p.out, p.in[17], p.in[18]);
#undef IN
#undef SEAM
}

#ifndef DUPMASK
#define DUPMASK 0
#endif
#ifndef ONE_LAUNCH
#define ONE_LAUNCH 1
#endif
extern "C" void kernel_launch(void* const* d_in, const int* in_sizes, int n_in, void* d_out, int out_size, void* d_ws, size_t ws_size, hipStream_t stream) {
    static int grid = 0;
    if (grid == 0) {
        if (n_in != 19 || ws_size < WS_END) { fprintf(stderr, "kernel_launch: need 19 inputs and >= %zu bytes of workspace; got %d, %zu\n", (size_t)WS_END, n_in, ws_size); grid = -1; return; }
        int dev = 0, cus = 0, per_cu = 0;
        hipGetDevice(&dev); hipDeviceGetAttribute(&cus, hipDeviceAttributeMultiprocessorCount, dev);
        if (hipFuncSetAttribute((const void*)mega, hipFuncAttributeMaxDynamicSharedMemorySize, LDS_BYTES) != hipSuccess) { fprintf(stderr, "kernel_launch: hipFuncSetAttribute failed\n"); grid = -1; return; }
        if (hipOccupancyMaxActiveBlocksPerMultiprocessor(&per_cu, (const void*)mega, 512, LDS_BYTES) != hipSuccess || per_cu < 1) { fprintf(stderr, "kernel_launch: occupancy query says %d\n", per_cu); per_cu = 1; }
        (void)hipGetLastError();
        grid = cus;
    }
    if (grid < 0) return;
    Params p{};
    for (int i = 0; i < 19; ++i) p.in[i] = (const float*)d_in[i];
    p.out = (float*)d_out; p.ws = (unsigned char*)d_ws;
#if ONE_LAUNCH
    p.ph_lo = 0; p.ph_hi = NPHASE;
    void* args[] = {&p};
    hipError_t e = hipLaunchCooperativeKernel((const void*)mega, dim3(grid), dim3(512), args, LDS_BYTES, stream);
    if (e != hipSuccess) fprintf(stderr, "cooperative launch failed: %s (grid %d)\n", hipGetErrorString(e), grid);
#else
    for (int ph = 0; ph < NPHASE; ++ph) { p.ph_lo = ph; p.ph_hi = ph + 1;
        for (int rep = 0; rep < (((DUPMASK >> ph) & 1) ? 2 : 1); ++rep) hipLaunchKernelGGL(mega, dim3(grid), dim3(512), LDS_BYTES, stream, p); }
#endif
}
```

```cpp
#include <hip/hip_runtime.h>
#include <hip/hip_cooperative_groups.h>
#include <cstdio>
namespace cg = cooperative_groups;

#define LAS __attribute__((address_space(3)))
typedef unsigned short bf16_t;
typedef short bf16x8 __attribute__((ext_vector_type(8)));
typedef float f32x4 __attribute__((ext_vector_type(4)));
typedef float f32x2 __attribute__((ext_vector_type(2)));
typedef unsigned u32x4 __attribute__((ext_vector_type(4)));
typedef unsigned u32x2 __attribute__((ext_vector_type(2)));

constexpr int T_TOK = 65536, SEQ = 2048, DM = 1024, DFF = 4096;
constexpr int N1 = 6400;
constexpr int N2 = 3072;
constexpr float ALPHA = 1.189207115002721f;
constexpr float LN_EPS = 1e-5f, RMS_EPS = 1e-5f;
constexpr size_t MiB = 1024ull * 1024ull;
constexpr size_t WS_RA = 0;
constexpr size_t WS_RB = 512 * MiB;
constexpr size_t WS_RC = 768 * MiB;
constexpr size_t WS_DT = 896 * MiB;
constexpr size_t WS_W  = 904 * MiB;
constexpr size_t WS_WIN1 = WS_W;
constexpr size_t WS_WIN2 = WS_WIN1 + (size_t)N1 * 1024 * 2;
constexpr size_t WS_WP   = WS_WIN2 + (size_t)N2 * 1024 * 2;
constexpr size_t WS_WSSD = WS_WP + (size_t)1024 * 256 * 2;
constexpr size_t WS_WOUT = WS_WSSD + (size_t)1024 * 2048 * 2;
constexpr size_t WS_WUP  = WS_WOUT + (size_t)1024 * 1024 * 2;
constexpr size_t WS_WDN  = WS_WUP + (size_t)4096 * 1024 * 2;
constexpr size_t WS_END  = WS_WDN + (size_t)4096 * 1024 * 2;
constexpr int LDS_BYTES = 160000;
constexpr int NPHASE = 11;

struct Params { const float* in[19]; float* out; unsigned char* ws; int ph_lo, ph_hi; };

__device__ __forceinline__ unsigned cvt_pk_bf16(float lo, float hi) { unsigned r; asm volatile("v_cvt_pk_bf16_f32 %0, %1, %2" : "=v"(r) : "v"(lo), "v"(hi)); return r; }
__device__ __forceinline__ float bf_lo(unsigned u) { return __uint_as_float(u << 16); }
__device__ __forceinline__ float bf_hi(unsigned u) { return __uint_as_float(u & 0xffff0000u); }
__device__ __forceinline__ float bf2f(bf16_t b) { return __uint_as_float(((unsigned)b) << 16); }
__device__ __forceinline__ float sigmoidf_(float v) { return __builtin_amdgcn_rcpf(1.0f + __expf(-v)); }
__device__ __forceinline__ float siluf_(float v) { return v * __builtin_amdgcn_rcpf(1.0f + __expf(-v)); }
__device__ __forceinline__ float softplusf_(float v) { return fmaxf(v, 0.f) + log1pf(__expf(-fabsf(v))); }
__device__ __forceinline__ u32x4 pack8(f32x4 a, f32x4 b) { u32x4 w; w.x = cvt_pk_bf16(a[0], a[1]); w.y = cvt_pk_bf16(a[2], a[3]); w.z = cvt_pk_bf16(b[0], b[1]); w.w = cvt_pk_bf16(b[2], b[3]); return w; }
__device__ __forceinline__ void unpack8(u32x4 w, f32x4& a, f32x4& b) { a = (f32x4){bf_lo(w.x), bf_hi(w.x), bf_lo(w.y), bf_hi(w.y)}; b = (f32x4){bf_lo(w.z), bf_hi(w.z), bf_lo(w.w), bf_hi(w.w)}; }

namespace pg8 {
constexpr int BM = 256, BK = 64, HALF = 128, HTB = HALF * BK * 2, STAGE_BYTES = 8 * HTB, NXCD = 8, WGM = 8;
__device__ __forceinline__ int lds_byte(int r, int c) { const int st = (r >> 4) * 2 + (c >> 5), rr = r & 15, cc = c & 31, ob = rr * 64 + cc * 2; return st * 1024 + (ob ^ (((ob >> 9) & 1) << 5)); }
__device__ __forceinline__ void stage_rc(int b, int& R, int& C) { const int st = b / 1024, sb = b % 1024, swz = sb ^ (((sb >> 9) & 1) << 5); R = (st >> 1) * 16 + swz / 64; C = (st & 1) * 32 + (swz % 64) / 2; }
__device__ __forceinline__ int perm32(int rho) { const int n = rho >> 4, i = rho & 15; return 8 * (i >> 2) + 4 * n + (i & 3); }
struct Unit { int pm, pn; };
struct Gemm { const bf16_t* A; const bf16_t* Bt; int M, N, K, lda, ldb, a_pn_bytes; };
struct StaticOrder {
    int nM, nN, nwg, G, c, owner;
    __device__ void init(int M, int N, int G_, int c_, int owner_ = 0) { nM = M / BM; nN = N / BM; nwg = nM * nN; G = G_; c = c_; owner = owner_; }
    __device__ bool next(int i, Unit& u) const {
        if (owner) { const int pm = c + (i / nN) * G; if (pm >= nM) return false; u.pm = pm; u.pn = i % nN; return true; }
        const long L = (long)i * G + c; if (L >= nwg) return false;
        int wgid = (int)L; { const int q = nwg / NXCD, r = nwg % NXCD, xcd = wgid % NXCD, off = wgid / NXCD; wgid = (xcd < r ? xcd * (q + 1) : r * (q + 1) + (xcd - r) * q) + off; }
        const int nig = WGM * nN, gid = wgid / nig, fm = gid * WGM, gsz = (nM - fm) < WGM ? (nM - fm) : WGM;
        u.pm = fm + ((wgid % nig) % gsz); u.pn = (wgid % nig) / gsz; return true;
    }
};

template <int OFF> __device__ __forceinline__ void ds_rd128(bf16x8& dst, unsigned addr) { asm volatile("ds_read_b128 %0, %1 offset:%2" : "=v"(dst) : "v"(addr), "n"(OFF)); }
template <class Epi>
__device__ __forceinline__ void gemm_phase(LAS unsigned char* lds, const Gemm g, const StaticOrder& S, const Epi& E) {
    int tid_l = threadIdx.x; asm volatile("" : "+v"(tid_l));
    const int tid = tid_l, wid = __builtin_amdgcn_readfirstlane(tid >> 6), lane = tid & 63, wr = wid >> 2, wc = wid & 3, fr = lane & 15, fq = lane >> 4;
    const int K = g.K, nt = K / BK;
    unsigned voffA[2], voffB[2];
#pragma unroll
    for (int i = 0; i < 2; ++i) { int R, C; stage_rc(tid * 16 + i * 8192, R, C); const int Rb = Epi::PERM ? ((R & ~31) + perm32(R & 31)) : R;
        voffA[i] = (unsigned)(R * g.lda + C) * 2u; voffB[i] = (unsigned)(Rb * g.ldb + C) * 2u; }
    const size_t kstep = (size_t)(BK * 2);
    const size_t hsA = (size_t)HALF * g.lda * 2, hsB = (size_t)HALF * g.ldb * 2;
    const size_t tsA = 2 * hsA, tsB = 2 * hsB;
    const unsigned ldsw = (unsigned)wid * 1024u;
    const int aoff = lds_byte(wr * 64 + fr, fq * 8), boff = lds_byte(wc * 32 + fr, fq * 8);
    const unsigned aaddr = (unsigned)(unsigned long long)(lds + aoff), baddr = (unsigned)(unsigned long long)(lds + 4 * HTB + boff);
#define PG8_SA(b, h) (((b) * 2 + (h)) * HTB)
#define PG8_SB(b, h) ((4 + (b) * 2 + (h)) * HTB)
#define PG8_STAGE(bufoff, gbase, voff) do { _Pragma("unroll") for (int _i = 0; _i < 2; ++_i) \
        __builtin_amdgcn_global_load_lds((const unsigned*)((const char*)(gbase) + (voff)[_i]), (LAS unsigned*)(lds + (bufoff) + ldsw + _i * 8192), 16, 0, 0); } while (0)
#define PG8_LDA(dst, b, h) do { _Pragma("unroll") for (int m = 0; m < 4; ++m) _Pragma("unroll") for (int k = 0; k < 2; ++k) dst[m][k] = *(const LAS bf16x8*)(lds + PG8_SA(b, h) + aoff + m * 2048 + k * 1024); } while (0)
#define PG8_LDB(dst, b, h) do { _Pragma("unroll") for (int n = 0; n < 2; ++n) _Pragma("unroll") for (int k = 0; k < 2; ++k) dst[n][k] = *(const LAS bf16x8*)(lds + PG8_SB(b, h) + boff + n * 2048 + k * 1024); } while (0)
#define PG8_MMA(ai, bj, At, Bt) do { __builtin_amdgcn_s_setprio(1); _Pragma("unroll") for (int m = 0; m < 4; ++m) _Pragma("unroll") for (int n = 0; n < 2; ++n) _Pragma("unroll") for (int k = 0; k < 2; ++k) \
        acc[ai][bj][m][n] = __builtin_amdgcn_mfma_f32_16x16x32_bf16(Bt[n][k], At[m][k], acc[ai][bj][m][n], 0, 0, 0); __builtin_amdgcn_s_setprio(0); } while (0)
#define PG8_RDA(dst, b, h) do { ds_rd128<PG8_SA(b, h) + 0 * 2048>(dst[0][0], aaddr); ds_rd128<PG8_SA(b, h) + 1 * 2048>(dst[1][0], aaddr); ds_rd128<PG8_SA(b, h) + 2 * 2048>(dst[2][0], aaddr); ds_rd128<PG8_SA(b, h) + 3 * 2048>(dst[3][0], aaddr); \
        ds_rd128<PG8_SA(b, h) + 0 * 2048 + 1024>(dst[0][1], aaddr); ds_rd128<PG8_SA(b, h) + 1 * 2048 + 1024>(dst[1][1], aaddr); ds_rd128<PG8_SA(b, h) + 2 * 2048 + 1024>(dst[2][1], aaddr); ds_rd128<PG8_SA(b, h) + 3 * 2048 + 1024>(dst[3][1], aaddr); } while (0)
#define PG8_RDB(dst, b, h) do { ds_rd128<PG8_SA(b, h)>(dst[0][0], baddr); ds_rd128<PG8_SA(b, h) + 2048>(dst[1][0], baddr); ds_rd128<PG8_SA(b, h) + 1024>(dst[0][1], baddr); ds_rd128<PG8_SA(b, h) + 2048 + 1024>(dst[1][1], baddr); } while (0)
#define PG8_WAITA(n, F, k) asm volatile("s_waitcnt lgkmcnt(" #n ")" : "+v"(F[0][k]), "+v"(F[1][k]), "+v"(F[2][k]), "+v"(F[3][k]) :: "memory")
#define PG8_WAITB(n, F, k) asm volatile("s_waitcnt lgkmcnt(" #n ")" : "+v"(F[0][k]), "+v"(F[1][k]) :: "memory")
#define PG8_WAITAB(n, FA, FB) asm volatile("s_waitcnt lgkmcnt(" #n ")" : "+v"(FA[0][0]), "+v"(FA[1][0]), "+v"(FA[2][0]), "+v"(FA[3][0]), "+v"(FB[0][0]), "+v"(FB[1][0]), "+v"(FB[0][1]), "+v"(FB[1][1]) :: "memory")
#define PG8_MMAK(ai, bj, At, Bt, k) do { _Pragma("unroll") for (int m = 0; m < 4; ++m) _Pragma("unroll") for (int n = 0; n < 2; ++n) \
        acc[ai][bj][m][n] = __builtin_amdgcn_mfma_f32_16x16x32_bf16(Bt[n][k], At[m][k], acc[ai][bj][m][n], 0, 0, 0); } while (0)
#define PG8_PRIO(x) __builtin_amdgcn_s_setprio(x)
#define PG8_WAIT_V(n) asm volatile("s_waitcnt vmcnt(" #n ")" ::: "memory")
#define PG8_WAIT_L(n) asm volatile("s_waitcnt lgkmcnt(" #n ")" ::: "memory")
#define PG8_BAR __builtin_amdgcn_s_barrier()
#define PG8_SCHED __builtin_amdgcn_sched_barrier(0)
    Unit cur, nxt; int ui = 0;
    if (!S.next(0, cur)) return;
    f32x4 acc[2][2][4][2];
#pragma unroll
    for (int a = 0; a < 2; ++a)
#pragma unroll
        for (int b = 0; b < 2; ++b)
#pragma unroll
            for (int m = 0; m < 4; ++m)
#pragma unroll
                for (int n = 0; n < 2; ++n) acc[a][b][m][n] = (f32x4){0.f, 0.f, 0.f, 0.f};
    bf16x8 At[4][2], B0[2][2], B1[2][2];
    const char* cA = (const char*)g.A + (size_t)cur.pm * tsA + (size_t)cur.pn * g.a_pn_bytes; const char* cB = (const char*)g.Bt + (size_t)cur.pn * tsB;
    PG8_STAGE(PG8_SB(0, 0), cB, voffB); PG8_STAGE(PG8_SA(0, 0), cA, voffA); PG8_STAGE(PG8_SB(0, 1), cB + hsB, voffB); PG8_STAGE(PG8_SA(0, 1), cA + hsA, voffA);
    if (wr == 1) PG8_BAR;
    PG8_WAIT_V(4); PG8_BAR;
    PG8_STAGE(PG8_SB(1, 0), cB + kstep, voffB); PG8_STAGE(PG8_SA(1, 0), cA + kstep, voffA); PG8_STAGE(PG8_SB(1, 1), cB + hsB + kstep, voffB);
    PG8_WAIT_V(6); PG8_BAR;
    PG8_RDB(B0, 0, 0);
    for (;;) {
        const bool has_next = S.next(ui + 1, nxt);
        const char* nA = has_next ? (const char*)g.A + (size_t)nxt.pm * tsA + (size_t)nxt.pn * g.a_pn_bytes : cA; const char* nB = has_next ? (const char*)g.Bt + (size_t)nxt.pn * tsB : cB;
#pragma unroll 1
        for (int t = 0; t < nt; t += 2) {
            const bool last = (t == nt - 2);
            const char* a1 = cA + (size_t)(t + 1) * kstep;
            const char* a2 = last ? nA : cA + (size_t)(t + 2) * kstep; const char* b2 = last ? nB : cB + (size_t)(t + 2) * kstep;
            const char* a3 = a2 + kstep; const char* b3 = b2 + kstep;
            PG8_RDA(At, 0, 0); PG8_STAGE(PG8_SA(1, 1), a1 + hsA, voffA);
            PG8_WAIT_V(10); PG8_BAR; PG8_PRIO(1); PG8_WAITAB(4, At, B0); PG8_SCHED; PG8_MMAK(0, 0, At, B0, 0); PG8_SCHED; PG8_WAITA(0, At, 1); PG8_SCHED; PG8_MMAK(0, 0, At, B0, 1); PG8_PRIO(0); PG8_BAR; PG8_SCHED;
            PG8_RDB(B1, 0, 1); PG8_STAGE(PG8_SB(0, 0), b2, voffB);
            PG8_WAIT_V(10); PG8_BAR; PG8_PRIO(1); PG8_WAITB(2, B1, 0); PG8_SCHED; PG8_MMAK(0, 1, At, B1, 0); PG8_SCHED; PG8_WAITB(0, B1, 1); PG8_SCHED; PG8_MMAK(0, 1, At, B1, 1); PG8_PRIO(0); PG8_BAR; PG8_SCHED;
            PG8_RDA(At, 0, 1); PG8_STAGE(PG8_SA(0, 0), a2, voffA);
            PG8_WAIT_V(10); PG8_BAR; PG8_PRIO(1); PG8_WAITA(4, At, 0); PG8_SCHED; PG8_MMAK(1, 0, At, B0, 0); PG8_SCHED; PG8_WAITA(0, At, 1); PG8_SCHED; PG8_MMAK(1, 0, At, B0, 1); PG8_PRIO(0); PG8_BAR; PG8_SCHED;
            PG8_RDB(B0, 1, 0); PG8_STAGE(PG8_SB(0, 1), b2 + hsB, voffB);
            PG8_WAIT_V(10); PG8_BAR; PG8_MMA(1, 1, At, B1); PG8_BAR; PG8_SCHED;
            PG8_RDA(At, 1, 0); PG8_STAGE(PG8_SA(0, 1), a2 + hsA, voffA);
            PG8_WAIT_V(10); PG8_BAR; PG8_PRIO(1); PG8_WAITAB(4, At, B0); PG8_SCHED; PG8_MMAK(0, 0, At, B0, 0); PG8_SCHED; PG8_WAITA(0, At, 1); PG8_SCHED; PG8_MMAK(0, 0, At, B0, 1); PG8_PRIO(0); PG8_BAR; PG8_SCHED;
            PG8_RDB(B1, 1, 1); PG8_STAGE(PG8_SB(1, 0), b3, voffB);
            PG8_WAIT_V(10); PG8_BAR; PG8_PRIO(1); PG8_WAITB(2, B1, 0); PG8_SCHED; PG8_MMAK(0, 1, At, B1, 0); PG8_SCHED; PG8_WAITB(0, B1, 1); PG8_SCHED; PG8_MMAK(0, 1, At, B1, 1); PG8_PRIO(0); PG8_BAR; PG8_SCHED;
            PG8_RDA(At, 1, 1); PG8_STAGE(PG8_SA(1, 0), a3, voffA);
            PG8_WAIT_V(10); PG8_BAR; PG8_PRIO(1); PG8_WAITA(4, At, 0); PG8_SCHED; PG8_MMAK(1, 0, At, B0, 0); PG8_SCHED; PG8_WAITA(0, At, 1); PG8_SCHED; PG8_MMAK(1, 0, At, B0, 1); PG8_PRIO(0); PG8_BAR; PG8_SCHED;
            if (!last) PG8_RDB(B0, 0, 0);
            PG8_STAGE(PG8_SB(1, 1), b3 + hsB, voffB);
            PG8_WAIT_V(10); PG8_BAR; PG8_MMA(1, 1, At, B1); PG8_BAR; PG8_SCHED;
        }
        E(acc, cur, wr, wc, fr, fq);
        if (!has_next) break;
#pragma unroll
        for (int a = 0; a < 2; ++a)
#pragma unroll
            for (int b = 0; b < 2; ++b)
#pragma unroll
                for (int m = 0; m < 4; ++m)
#pragma unroll
                    for (int n = 0; n < 2; ++n) acc[a][b][m][n] = (f32x4){0.f, 0.f, 0.f, 0.f};
        cur = nxt; cA = nA; cB = nB; ++ui;
        PG8_RDB(B0, 0, 0);
    }
    PG8_WAIT_V(0);
    if (wr == 0) PG8_BAR;
    PG8_BAR;
#undef PG8_SA
#undef PG8_SB
#undef PG8_STAGE
#undef PG8_LDA
#undef PG8_LDB
#undef PG8_MMA
#undef PG8_MMAK
#undef PG8_RDA
#undef PG8_RDB
#undef PG8_WAITA
#undef PG8_WAITB
#undef PG8_WAITAB
#undef PG8_PRIO
#undef PG8_WAIT_V
#undef PG8_WAIT_L
#undef PG8_BAR
#undef PG8_SCHED
}

typedef const f32x4 (&AccRef)[2][2][4][2];

struct EpiG1 {
    static constexpr bool PERM = true;
    bf16_t* zs; bf16_t* xbc; float* dtb; const float* dt_bias; int pn_off;
    __device__ __forceinline__ void operator()(AccRef acc, const Unit& u, int wr, int wc, int fr, int fq) const {
        const int row0 = u.pm * BM + wr * 64 + fr, pn = u.pn + pn_off;
        if (pn < 24) {
            const bool act = pn < 8;
            bf16_t* base = act ? zs : xbc; const int ld = act ? 2048 : 4096; const int colt = act ? pn * 256 : (pn - 8) * 256;
            const int col0 = colt + wc * 32 + 8 * fq;
#pragma unroll
            for (int ai = 0; ai < 2; ++ai)
#pragma unroll
                for (int m = 0; m < 4; ++m) { bf16_t* rowp = base + (size_t)(row0 + ai * HALF + m * 16) * ld + col0;
#pragma unroll
                    for (int bj = 0; bj < 2; ++bj) { f32x4 v0 = acc[ai][bj][m][0], v1 = acc[ai][bj][m][1];
                        if (act) {
#pragma unroll
                            for (int j = 0; j < 4; ++j) { v0[j] = siluf_(v0[j]); v1[j] = siluf_(v1[j]); } }
                        *(u32x4*)(rowp + bj * HALF) = pack8(v0, v1); } }
        } else if (wc == 0) {
            const int c0 = 8 * fq; const f32x4 b0 = *(const f32x4*)(dt_bias + c0), b1 = *(const f32x4*)(dt_bias + c0 + 4);
#pragma unroll
            for (int ai = 0; ai < 2; ++ai)
#pragma unroll
                for (int m = 0; m < 4; ++m) { float* rowp = dtb + (size_t)(row0 + ai * HALF + m * 16) * 32 + c0;
                    f32x4 v0 = acc[ai][0][m][0] + b0, v1 = acc[ai][0][m][1] + b1;
#pragma unroll
                    for (int j = 0; j < 4; ++j) { v0[j] = softplusf_(v0[j]); v1[j] = softplusf_(v1[j]); }
                    *(f32x4*)rowp = v0; *(f32x4*)(rowp + 4) = v1; }
        }
    }
};
struct EpiG2 {
    static constexpr bool PERM = true;
    bf16_t* upool; bf16_t* gates; const float* b_gates;
    __device__ __forceinline__ void operator()(AccRef acc, const Unit& u, int wr, int wc, int fr, int fq) const {
        const int row0 = u.pm * BM + wr * 64 + fr, pn = u.pn;
        const bool act = pn >= 4;
        bf16_t* base = act ? gates : upool; const int ld = act ? 2048 : 1024; const int colt = act ? (pn - 4) * 256 : pn * 256;
        const int col0 = colt + wc * 32 + 8 * fq;
        f32x4 bv[2][2];
#pragma unroll
        for (int bj = 0; bj < 2; ++bj)
#pragma unroll
            for (int n = 0; n < 2; ++n) bv[bj][n] = act ? *(const f32x4*)(b_gates + col0 + bj * HALF + 4 * n) : (f32x4){0.f, 0.f, 0.f, 0.f};
#pragma unroll
        for (int ai = 0; ai < 2; ++ai)
#pragma unroll
            for (int m = 0; m < 4; ++m) { bf16_t* rowp = base + (size_t)(row0 + ai * HALF + m * 16) * ld + col0;
#pragma unroll
                for (int bj = 0; bj < 2; ++bj) { f32x4 v0 = acc[ai][bj][m][0] + bv[bj][0], v1 = acc[ai][bj][m][1] + bv[bj][1];
                    if (act) {
#pragma unroll
                        for (int j = 0; j < 4; ++j) { v0[j] = sigmoidf_(v0[j]); v1[j] = sigmoidf_(v1[j]); } }
                    *(u32x4*)(rowp + bj * HALF) = pack8(v0, v1); } }
    }
};
template <bool FIRST> struct EpiPool {
    static constexpr bool PERM = true;
    bf16_t* merged; const bf16_t* gates;
    __device__ __forceinline__ void operator()(AccRef acc, const Unit& u, int wr, int wc, int fr, int fq) const {
        const int row0 = u.pm * BM + wr * 64 + fr; const int col0 = u.pn * 256 + wc * 32 + 8 * fq;
#pragma unroll
        for (int ai = 0; ai < 2; ++ai) {
            u32x4 gw[4][2], pw[4][2];
#pragma unroll
            for (int m = 0; m < 4; ++m)
#pragma unroll
                for (int bj = 0; bj < 2; ++bj) { const size_t row = (size_t)(row0 + ai * HALF + m * 16);
                    gw[m][bj] = *(const u32x4*)(gates + row * 2048 + col0 + bj * HALF); if (!FIRST) pw[m][bj] = *(const u32x4*)(merged + row * 1024 + col0 + bj * HALF); }
#pragma unroll
            for (int m = 0; m < 4; ++m) { const size_t row = (size_t)(row0 + ai * HALF + m * 16);
#pragma unroll
                for (int bj = 0; bj < 2; ++bj) { f32x4 g0, g1, p0 = {0.f, 0.f, 0.f, 0.f}, p1 = {0.f, 0.f, 0.f, 0.f}; unpack8(gw[m][bj], g0, g1); if (!FIRST) unpack8(pw[m][bj], p0, p1);
                    const f32x4 v0 = p0 + acc[ai][bj][m][0] * g0, v1 = p1 + acc[ai][bj][m][1] * g1;
                    *(u32x4*)(merged + row * 1024 + col0 + bj * HALF) = pack8(v0, v1); } }
            asm volatile("" ::: "memory");
        }
    }
};
template <bool FIRST> struct EpiSsd {
    static constexpr bool PERM = true;
    bf16_t* merged; const bf16_t* gates;
    __device__ __forceinline__ void operator()(AccRef acc, const Unit& u, int wr, int wc, int fr, int fq) const {
        const int row0 = u.pm * BM + wr * 64 + fr; const int col0 = u.pn * 256 + wc * 32 + 8 * fq;
#pragma unroll
        for (int ai = 0; ai < 2; ++ai) {
            u32x4 gw[4][2], pw[4][2];
#pragma unroll
            for (int m = 0; m < 4; ++m)
#pragma unroll
                for (int bj = 0; bj < 2; ++bj) { const size_t row = (size_t)(row0 + ai * HALF + m * 16);
                    gw[m][bj] = *(const u32x4*)(gates + row * 2048 + 1024 + col0 + bj * HALF); if (!FIRST) pw[m][bj] = *(const u32x4*)(merged + row * 1024 + col0 + bj * HALF); }
#pragma unroll
            for (int m = 0; m < 4; ++m) { const size_t row = (size_t)(row0 + ai * HALF + m * 16);
#pragma unroll
                for (int bj = 0; bj < 2; ++bj) { f32x4 g0, g1, p0 = {0.f, 0.f, 0.f, 0.f}, p1 = {0.f, 0.f, 0.f, 0.f}; unpack8(gw[m][bj], g0, g1); if (!FIRST) unpack8(pw[m][bj], p0, p1);
                    const f32x4 v0 = p0 + acc[ai][bj][m][0] * g0, v1 = p1 + acc[ai][bj][m][1] * g1;
                    *(u32x4*)(merged + row * 1024 + col0 + bj * HALF) = pack8(v0, v1); } }
            asm volatile("" ::: "memory");
        }
    }
};
struct EpiUp {
    static constexpr bool PERM = true;
    bf16_t* upb;
    __device__ __forceinline__ void operator()(AccRef acc, const Unit& u, int wr, int wc, int fr, int fq) const {
        const int row0 = u.pm * BM + wr * 64 + fr; const int col0 = u.pn * 256 + wc * 32 + 8 * fq;
#pragma unroll
        for (int ai = 0; ai < 2; ++ai)
#pragma unroll
            for (int m = 0; m < 4; ++m) { bf16_t* rowp = upb + (size_t)(row0 + ai * HALF + m * 16) * DFF + col0;
#pragma unroll
                for (int bj = 0; bj < 2; ++bj) { f32x4 v0 = acc[ai][bj][m][0], v1 = acc[ai][bj][m][1];
#pragma unroll
                    for (int j = 0; j < 4; ++j) { const float a = fmaxf(v0[j], 0.f), b = fmaxf(v1[j], 0.f); v0[j] = a * a; v1[j] = b * b; }
                    *(u32x4*)(rowp + bj * HALF) = pack8(v0, v1); } }
    }
};
struct EpiOut {
    static constexpr bool PERM = true;
    const float* x; bf16_t* v;
    __device__ __forceinline__ void operator()(AccRef acc, const Unit& u, int wr, int wc, int fr, int fq) const {
        const int row0 = u.pm * BM + wr * 64 + fr, col0 = u.pn * BM + wc * 32 + 8 * fq;
#pragma unroll
        for (int ai = 0; ai < 2; ++ai) {
            f32x4 xv[4][2][2];
#pragma unroll
            for (int m = 0; m < 4; ++m)
#pragma unroll
                for (int bj = 0; bj < 2; ++bj)
#pragma unroll
                    for (int n = 0; n < 2; ++n) xv[m][bj][n] = *(const f32x4*)(x + (size_t)(row0 + ai * HALF + m * 16) * DM + col0 + bj * HALF + n * 4);
#pragma unroll
            for (int m = 0; m < 4; ++m) { const size_t off = (size_t)(row0 + ai * HALF + m * 16) * DM + col0;
#pragma unroll
                for (int bj = 0; bj < 2; ++bj) *(u32x4*)(v + off + bj * HALF) = pack8(xv[m][bj][0] * ALPHA + acc[ai][bj][m][0], xv[m][bj][1] * ALPHA + acc[ai][bj][m][1]); }
            asm volatile("" ::: "memory");
        }
    }
};
struct EpiDown {
    static constexpr bool PERM = true;
    const bf16_t* h1b; bf16_t* y;
    __device__ __forceinline__ void operator()(AccRef acc, const Unit& u, int wr, int wc, int fr, int fq) const {
        const int row0 = u.pm * BM + wr * 64 + fr, col0 = u.pn * BM + wc * 32 + 8 * fq;
        u32x4 hw[2][4][2];
#pragma unroll
        for (int ai = 0; ai < 2; ++ai)
#pragma unroll
            for (int m = 0; m < 4; ++m)
#pragma unroll
                for (int bj = 0; bj < 2; ++bj) hw[ai][m][bj] = *(const u32x4*)(h1b + (size_t)(row0 + ai * HALF + m * 16) * DM + col0 + bj * HALF);
#pragma unroll
        for (int ai = 0; ai < 2; ++ai)
#pragma unroll
            for (int m = 0; m < 4; ++m) { const size_t off = (size_t)(row0 + ai * HALF + m * 16) * DM + col0;
#pragma unroll
                for (int bj = 0; bj < 2; ++bj) { f32x4 h0, h1; unpack8(hw[ai][m][bj], h0, h1);
                    *(u32x4*)(y + off + bj * HALF) = pack8(h0 * ALPHA + acc[ai][bj][m][0], h1 * ALPHA + acc[ai][bj][m][1]); } }
    }
};
}

struct TrJob { const float* src; int ld_src, col0, K, ncols, nvalid; bf16_t* dst; int ld_dst; const float* cscale; };
__device__ __forceinline__ int tr_tiles(int K, int ncols) { return (K / 64) * (ncols / 256); }
__device__ __forceinline__ bool tr_pick(const Params& p, int gt, TrJob& J, int& lt) {
    unsigned char* ws = p.ws; const float* w_in = p.in[1];
    bf16_t* win1 = (bf16_t*)(ws + WS_WIN1); bf16_t* win2 = (bf16_t*)(ws + WS_WIN2);
    int base = 0, n;
#define TRJ(SRC, LDS_, COL0, K_, NC, NV, DST, LDD, CS) do { n = tr_tiles((K_), (NC)); if (gt < base + n) { J.src = (SRC); J.ld_src = (LDS_); J.col0 = (COL0); J.K = (K_); J.ncols = (NC); J.nvalid = (NV); J.dst = (DST); J.ld_dst = (LDD); J.cscale = (CS); lt = gt - base; return true; } base += n; } while (0)
    TRJ(w_in, 9248, 3072, 1024, 4096, 4096, win1 + (size_t)2048 * 1024, 1024, nullptr);
    TRJ(p.in[15], 4096, 0, 1024, 4096, 4096, (bf16_t*)(ws + WS_WUP), 1024, nullptr);
    TRJ(p.in[16], 1024, 0, 4096, 1024, 1024, (bf16_t*)(ws + WS_WDN), 4096, nullptr);
    TRJ(w_in, 9248, 1024, 1024, 2048, 2048, win1, 1024, nullptr);
    TRJ(w_in, 9248, 7200, 1024, 2048, 2048, win2 + (size_t)1024 * 1024, 1024, nullptr);
    TRJ(p.in[9], 1024, 0, 2048, 1024, 1024, (bf16_t*)(ws + WS_WSSD), 2048, nullptr);
    TRJ(w_in, 9248, 0, 1024, 1024, 1024, win2, 1024, nullptr);
    TRJ(p.in[12], 1024, 0, 1024, 1024, 1024, (bf16_t*)(ws + WS_WOUT), 1024, nullptr);
    TRJ(w_in, 9248, 7168, 1024, 256, 32, win1 + (size_t)6144 * 1024, 1024, nullptr);
    TRJ(p.in[10], 256, 0, 256, 256, 256, (bf16_t*)(ws + WS_WP), 256, p.in[11]);
    TRJ(p.in[10] + 65536, 256, 0, 256, 256, 256, (bf16_t*)(ws + WS_WP) + 65536, 256, p.in[11] + 256);
    TRJ(p.in[10] + 2 * 65536, 256, 0, 256, 256, 256, (bf16_t*)(ws + WS_WP) + 2 * 65536, 256, p.in[11] + 512);
    TRJ(p.in[10] + 3 * 65536, 256, 0, 256, 256, 256, (bf16_t*)(ws + WS_WP) + 3 * 65536, 256, p.in[11] + 768);
#undef TRJ
    return false;
}
__device__ void phase0(const Params& p, unsigned char* smem) {
    unsigned char* ws = p.ws;
    { const float* __restrict__ x = p.in[0]; bf16_t* __restrict__ xb = (bf16_t*)(ws + WS_RC);
      const size_t nvec = (size_t)T_TOK * DM / 8, stride = (size_t)gridDim.x * blockDim.x;
      for (size_t i = (size_t)blockIdx.x * blockDim.x + threadIdx.x; i < nvec; i += 4 * stride) {
          f32x4 a[4], b[4];
#pragma unroll
          for (int k = 0; k < 4; ++k) { a[k] = *(const f32x4*)(x + (i + k * stride) * 8); b[k] = *(const f32x4*)(x + (i + k * stride) * 8 + 4); }
#pragma unroll
          for (int k = 0; k < 4; ++k) *(u32x4*)(xb + (i + k * stride) * 8) = pack8(a[k], b[k]); } }
    float* t = (float*)smem;
    const int tid = threadIdx.x;
    for (int gt = blockIdx.x; ; gt += gridDim.x) {
        TrJob J; int lt;
        if (!tr_pick(p, gt, J, lt)) break;
        const int tn = J.ncols / 256; const int k0 = (lt / tn) * 64, n0 = (lt % tn) * 256;
        __syncthreads();
        float v[4][8];
#pragma unroll
        for (int sb = 0; sb < 4; ++sb)
#pragma unroll
            for (int i = 0; i < 8; ++i) { const int k = (tid >> 6) + 8 * i, n = n0 + sb * 64 + (tid & 63); const int nc = n < J.nvalid ? n : 0;
                const float ld = J.src[(size_t)(k0 + k) * J.ld_src + J.col0 + nc]; v[sb][i] = n < J.nvalid ? ld : 0.f; }
#pragma unroll
        for (int sb = 0; sb < 4; ++sb) { const float sc = J.cscale ? J.cscale[n0 + sb * 64 + (tid & 63)] : 1.0f;
#pragma unroll
            for (int i = 0; i < 8; ++i) t[(sb * 64 + (tid >> 6) + 8 * i) * 65 + (tid & 63)] = v[sb][i] * sc; }
        __syncthreads();
        const int n = tid >> 3, kk = (tid & 7) * 8;
#pragma unroll
        for (int sb = 0; sb < 4; ++sb) { float e[8];
#pragma unroll
            for (int j = 0; j < 8; ++j) e[j] = t[(sb * 64 + kk + j) * 65 + n];
            u32x4 w; w.x = cvt_pk_bf16(e[0], e[1]); w.y = cvt_pk_bf16(e[2], e[3]); w.z = cvt_pk_bf16(e[4], e[5]); w.w = cvt_pk_bf16(e[6], e[7]);
            *(u32x4*)(J.dst + (size_t)(n0 + sb * 64 + n) * J.ld_dst + k0 + kk) = w; }
    }
}

__device__ void phase_ssd_simple(const Params& p, unsigned char* smem) {
    unsigned char* ws = p.ws;
    const bf16_t* xbc = (const bf16_t*)(ws + WS_RA); bf16_t* zy = (bf16_t*)(ws + WS_RB); const float* dtb = (const float*)(ws + WS_DT);
    const float* conv_w = p.in[3]; const float* conv_b = p.in[4]; const float* a_log = p.in[6]; const float* d_skip = p.in[7]; const float* norm_w = p.in[8];
    float* sX = (float*)smem;
    float* sY = sX + 16 * 512;
    float* sdt = sY + 16 * 256;
    const int tid = threadIdx.x;
    for (int item = blockIdx.x; item < 256; item += gridDim.x) {
        const int b = item >> 3, g = item & 7;
        const int ch = tid; int gcol;
        if (ch < 256) gcol = g * 256 + ch; else if (ch < 384) gcol = 2048 + g * 128 + (ch - 256); else gcol = 3072 + g * 128 + (ch - 384);
        const float cw0 = conv_w[gcol], cw1 = conv_w[4096 + gcol], cw2 = conv_w[8192 + gcol], cw3 = conv_w[12288 + gcol], cb = conv_b[gcol];
        float u1 = 0.f, u2 = 0.f, u3 = 0.f;
        const int r = tid >> 7, pp = (tid & 127) >> 1, nh = tid & 1;
        const float a_r = -__expf(a_log[g * 4 + r]), d_r = d_skip[g * 4 + r];
        float hst[64];
#pragma unroll
        for (int i = 0; i < 64; ++i) hst[i] = 0.f;
        for (int blk = 0; blk < SEQ / 16; ++blk) {
            const size_t t0 = (size_t)b * SEQ + (size_t)blk * 16;
#pragma unroll 4
            for (int tt = 0; tt < 16; ++tt) { const float raw = bf2f(xbc[(t0 + tt) * 4096 + gcol]);
                const float y = cb + cw0 * u1 + cw1 * u2 + cw2 * u3 + cw3 * raw; u1 = u2; u2 = u3; u3 = raw;
                sX[tt * 512 + ch] = siluf_(y); }
            if (tid < 64) sdt[tid] = dtb[(t0 + (tid >> 2)) * 32 + g * 4 + (tid & 3)];
            __syncthreads();
            for (int tt = 0; tt < 16; ++tt) {
                const float dt = sdt[tt * 4 + r], dec = __expf(dt * a_r), xv = sX[tt * 512 + r * 64 + pp], xdt = xv * dt;
                const float* Bp = sX + tt * 512 + 256 + nh * 64; const float* Cp = sX + tt * 512 + 384 + nh * 64;
                float y = 0.f;
#pragma unroll
                for (int i = 0; i < 64; ++i) { hst[i] = hst[i] * dec + xdt * Bp[i]; y += hst[i] * Cp[i]; }
                y += __shfl_xor(y, 1);
                if (nh == 0) { const float zv = bf2f(zy[(t0 + tt) * 2048 + g * 256 + r * 64 + pp]); sY[tt * 256 + r * 64 + pp] = (y + d_r * xv) * zv; }
            }
            __syncthreads();
            { const int tt = tid >> 5, c0 = (tid & 31) * 8; float e[8]; float ss = 0.f;
#pragma unroll
              for (int j = 0; j < 8; ++j) { e[j] = sY[tt * 256 + c0 + j]; ss += e[j] * e[j]; }
              ss += __shfl_xor(ss, 16); ss += __shfl_xor(ss, 8); ss += __shfl_xor(ss, 4); ss += __shfl_xor(ss, 2); ss += __shfl_xor(ss, 1);
              const float rstd = rsqrtf(ss * (1.0f / 256.0f) + RMS_EPS);
              const f32x4 w0 = *(const f32x4*)(norm_w + g * 256 + c0), w1 = *(const f32x4*)(norm_w + g * 256 + c0 + 4);
              u32x4 o; o.x = cvt_pk_bf16(e[0] * rstd * w0[0], e[1] * rstd * w0[1]); o.y = cvt_pk_bf16(e[2] * rstd * w0[2], e[3] * rstd * w0[3]);
              o.z = cvt_pk_bf16(e[4] * rstd * w1[0], e[5] * rstd * w1[1]); o.w = cvt_pk_bf16(e[6] * rstd * w1[2], e[7] * rstd * w1[3]);
              *(u32x4*)(zy + (t0 + tt) * 2048 + g * 256 + c0) = o; }
            __syncthreads();
        }
    }
}


constexpr int SX_STR = 144, SN_STR = 272, SZ_STR = 528;
constexpr int O_XT = 0;
constexpr int O_BT = O_XT + 256 * SX_STR;
constexpr int O_BN = O_BT + 128 * SX_STR;
constexpr int O_CN = O_BN + 64 * SN_STR;
constexpr int O_CB = O_CN + 64 * SN_STR;
constexpr int O_ZT = O_CB + 64 * SN_STR;
constexpr int O_ACS = O_ZT + 64 * SZ_STR;
constexpr int O_DT = O_ACS + 1024;
constexpr int O_WG = O_DT + 1024;
constexpr int O_EA = O_WG + 1024;
constexpr int O_SSQ = O_EA + 1024;
constexpr int O_RSTD = O_SSQ + 2048;
constexpr int O_CW = O_RSTD + 256;
constexpr int O_RSW = O_CW + 5 * 512 * 4;
constexpr int SSD_LDS = O_RSW + 2048;
static_assert(SSD_LDS <= LDS_BYTES, "LDS");
#define MFMA16(a, b, c) __builtin_amdgcn_mfma_f32_16x16x32_bf16((a), (b), (c), 0, 0, 0)

template <int CTRL> __device__ __forceinline__ float dpp_add(float v) { return v + __builtin_bit_cast(float, __builtin_amdgcn_update_dpp(0, __builtin_bit_cast(int, v), CTRL, 0xf, 0xf, false)); }
__device__ __forceinline__ float row16_sum(float v) { v = dpp_add<0xB1>(v); v = dpp_add<0x4E>(v); v = dpp_add<0x124>(v); v = dpp_add<0x128>(v); return v; }
__device__ __forceinline__ f32x4 unpack4(u32x2 w) { return (f32x4){bf_lo(w.x), bf_hi(w.x), bf_lo(w.y), bf_hi(w.y)}; }

__device__ void phase_ssd(const Params& p, LAS unsigned char* sm) {
    unsigned char* ws = p.ws;
    const bf16_t* xbc = (const bf16_t*)(ws + WS_RA); bf16_t* zy = (bf16_t*)(ws + WS_RB); const float* dtb = (const float*)(ws + WS_DT);
    const float* conv_w = p.in[3]; const float* conv_b = p.in[4]; const float* a_log = p.in[6]; const float* d_skip = p.in[7]; const float* norm_w = p.in[8];
    const int tid = threadIdx.x, lane = tid & 63, w = __builtin_amdgcn_readfirstlane(tid >> 6), c = lane & 15, q = lane >> 4;
    const int r = w >> 1, ph = w & 1;
    const int tq = tid >> 7, ch0 = (tid & 127) * 4;
    LAS float* ACS = (LAS float*)(sm + O_ACS); LAS float* DTV = (LAS float*)(sm + O_DT); LAS float* WG = (LAS float*)(sm + O_WG); LAS float* EA = (LAS float*)(sm + O_EA);
    LAS float* SSQ = (LAS float*)(sm + O_SSQ); LAS float* RSTD = (LAS float*)(sm + O_RSTD);
    for (int item = blockIdx.x; item < 256; item += gridDim.x) {
        const int b = item >> 3, g = item & 7;
#define SSD_GCOL(CH) ((CH) < 256 ? g * 256 + (CH) : ((CH) < 384 ? 1792 + g * 128 + (CH) : 2688 + g * 128 + (CH)))
        { const int gcol = SSD_GCOL(ch0);
        __syncthreads();
        if (tq == 0) {
#pragma unroll
            for (int k = 0; k < 4; ++k) *(LAS f32x4*)(sm + O_CW + (k * 512 + ch0) * 4) = *(const f32x4*)(conv_w + k * 4096 + gcol);
            *(LAS f32x4*)(sm + O_CW + (4 * 512 + ch0) * 4) = *(const f32x4*)(conv_b + gcol); }
        __syncthreads(); }
        const float d_r = d_skip[g * 4 + r];
        const float a_w = -__expf(a_log[g * 4 + (w & 3)]);
        const int prow0 = r * 64 + ph * 32 + c;
        const float nw0 = norm_w[g * 256 + prow0], nw1 = norm_w[g * 256 + prow0 + 16];
        f32x4 accH[8][2];
#pragma unroll
        for (int nt = 0; nt < 8; ++nt)
#pragma unroll
            for (int pt = 0; pt < 2; ++pt) accH[nt][pt] = (f32x4){0.f, 0.f, 0.f, 0.f};
        u32x2 raw[19]; u32x4 zr[4]; float dtn = 0.f;
#define SSD_ISSUE(SUBN) do { int sn_ = (SUBN); asm volatile("" : "+s"(sn_)); int tid_ = tid; asm volatile("" : "+v"(tid_)); const int ch_ = (tid_ & 127) * 4; const int gc_ = SSD_GCOL(ch_); \
            const int sl0_ = sn_ * 64 + (tid_ >> 7) * 16 - 3; const bf16_t* rp_ = xbc + ((size_t)b * SEQ + (sl0_ < 0 ? 0 : sl0_)) * 4096 + gc_; \
            _Pragma("unroll") for (int i = 0; i < 19; ++i) { const int sl = sl0_ + i; \
                const u32x2 v = *(const u32x2*)(rp_ + (sl0_ < 0 ? (i < 3 ? 0 : i - 3) : i) * 4096); raw[i].x = sl < 0 ? 0u : v.x; raw[i].y = sl < 0 ? 0u : v.y; } \
            const bf16_t* zp_ = zy + ((size_t)b * SEQ + (size_t)sn_ * 64 + (tid_ >> 5)) * 2048 + g * 256 + (tid_ & 31) * 8; \
            _Pragma("unroll") for (int k = 0; k < 4; ++k) zr[k] = *(const u32x4*)(zp_ + (size_t)k * 16 * 2048); \
            if (w < 4) dtn = dtb[((size_t)b * SEQ + (size_t)sn_ * 64 + lane) * 32 + g * 4 + w]; } while (0)
        SSD_ISSUE(0);
#pragma unroll 1
        for (int sub = 0; sub < SEQ / 64; ++sub) {
            const size_t t0 = (size_t)b * SEQ + (size_t)sub * 64;
            {
                const f32x4 cw0 = *(const LAS f32x4*)(sm + O_CW + ch0 * 4), cw1 = *(const LAS f32x4*)(sm + O_CW + (512 + ch0) * 4), cw2 = *(const LAS f32x4*)(sm + O_CW + (1024 + ch0) * 4),
                            cw3 = *(const LAS f32x4*)(sm + O_CW + (1536 + ch0) * 4), cbv = *(const LAS f32x4*)(sm + O_CW + (2048 + ch0) * 4);
                f32x4 u0 = unpack4(raw[0]), u1 = unpack4(raw[1]), u2 = unpack4(raw[2]);
                unsigned tr[4][8]; f32x4 pv = {0.f, 0.f, 0.f, 0.f};
                LAS unsigned char* nb = ch0 < 384 ? sm + O_BN + (ch0 - 256) * 2 : sm + O_CN + (ch0 - 384) * 2;
#pragma unroll
                for (int i = 0; i < 16; ++i) {
                    const f32x4 u3 = unpack4(raw[i + 3]);
                    f32x4 y = cbv + cw0 * u0 + cw1 * u1 + cw2 * u2 + cw3 * u3;
#pragma unroll
                    for (int j = 0; j < 4; ++j) y[j] = siluf_(y[j]);
                    if (ch0 >= 256) *(LAS u32x2*)(nb + (tq * 16 + i) * SN_STR) = (u32x2){cvt_pk_bf16(y[0], y[1]), cvt_pk_bf16(y[2], y[3])};
                    if (i & 1) {
#pragma unroll
                        for (int j = 0; j < 4; ++j) tr[j][i >> 1] = cvt_pk_bf16(pv[j], y[j]); }
                    else pv = y;
                    u0 = u1; u1 = u2; u2 = u3;
                }
                if (ch0 < 384) {
                    LAS unsigned char* tb = ch0 < 256 ? sm + O_XT + ch0 * SX_STR : sm + O_BT + (ch0 - 256) * SX_STR;
#pragma unroll
                    for (int j = 0; j < 4; ++j) { *(LAS u32x4*)(tb + j * SX_STR + tq * 32) = (u32x4){tr[j][0], tr[j][1], tr[j][2], tr[j][3]};
                        *(LAS u32x4*)(tb + j * SX_STR + tq * 32 + 16) = (u32x4){tr[j][4], tr[j][5], tr[j][6], tr[j][7]}; }
                }
            }
            if (w < 4) {
                const float dt = dtn; float x = dt * a_w;
#pragma unroll
                for (int o = 1; o < 64; o <<= 1) { const float v = __shfl_up(x, o); if (lane >= o) x += v; }
                const float last = __shfl(x, 63);
                ACS[w * 64 + lane] = x; DTV[w * 64 + lane] = dt; WG[w * 64 + lane] = dt * __expf(last - x); EA[w * 64 + lane] = __expf(x);
            }
            __syncthreads();
            {
#pragma unroll
                for (int k = 0; k < 4; ++k) { const int v = tid + 512 * k, l = v >> 5, c8 = (v & 31) * 8; *(LAS u32x4*)(sm + O_ZT + l * SZ_STR + c8 * 2) = zr[k]; }
                const int lt = w >> 1;
#pragma unroll
                for (int sti = 0; sti < 2; ++sti) { const int st = 2 * (w & 1) + sti; f32x4 acc = {0.f, 0.f, 0.f, 0.f};
#pragma unroll
                    for (int ks = 0; ks < 4; ++ks) { const bf16x8 a = *(const LAS bf16x8*)(sm + O_CN + (16 * lt + c) * SN_STR + (32 * ks + 8 * q) * 2);
                        const bf16x8 bb = *(const LAS bf16x8*)(sm + O_BN + (16 * st + c) * SN_STR + (32 * ks + 8 * q) * 2); acc = MFMA16(a, bb, acc); }
#pragma unroll
                    for (int rg = 0; rg < 4; ++rg) *(LAS float*)(sm + O_CB + (16 * lt + 4 * q + rg) * SN_STR + (16 * st + c) * 4) = acc[rg]; }
            }
            __syncthreads();
            f32x4 accY[4][2];
#pragma unroll
            for (int lt = 0; lt < 4; ++lt)
#pragma unroll
                for (int pt = 0; pt < 2; ++pt) accY[lt][pt] = (f32x4){0.f, 0.f, 0.f, 0.f};
#pragma unroll
            for (int ks = 0; ks < 4; ++ks) {
                bf16x8 hb[2];
#pragma unroll
                for (int pt = 0; pt < 2; ++pt) hb[pt] = __builtin_bit_cast(bf16x8, pack8(accH[2 * ks][pt], accH[2 * ks + 1][pt]));
#pragma unroll
                for (int lt = 0; lt < 4; ++lt) { const LAS unsigned char* cp = sm + O_CN + (16 * lt + c) * SN_STR + (32 * ks + 4 * q) * 2;
                    const u32x2 lo = *(const LAS u32x2*)cp, hi = *(const LAS u32x2*)(cp + 32);
                    const bf16x8 a = __builtin_bit_cast(bf16x8, (u32x4){lo.x, lo.y, hi.x, hi.y});
#pragma unroll
                    for (int pt = 0; pt < 2; ++pt) accY[lt][pt] = MFMA16(a, hb[pt], accY[lt][pt]); }
            }
#pragma unroll
            for (int lt = 0; lt < 4; ++lt) { const f32x4 e = *(const LAS f32x4*)(EA + r * 64 + 16 * lt + 4 * q);
#pragma unroll
                for (int pt = 0; pt < 2; ++pt) accY[lt][pt] *= e; }
            bf16x8 xf[2][2];
#pragma unroll
            for (int ks = 0; ks < 2; ++ks)
#pragma unroll
                for (int pt = 0; pt < 2; ++pt) xf[ks][pt] = *(const LAS bf16x8*)(sm + O_XT + (prow0 + 16 * pt) * SX_STR + (32 * ks + 8 * q) * 2);
#pragma unroll
            for (int lt = 0; lt < 4; ++lt)
#pragma unroll
                for (int ks = 0; ks < 2; ++ks) {
                    if (ks == 1 && lt < 2) continue;
                    const int l = 16 * lt + c; const float acl = ACS[r * 64 + l];
                    const LAS float* cbp = (const LAS float*)(sm + O_CB + l * SN_STR) + 32 * ks + 8 * q;
                    const f32x4 cb0 = *(const LAS f32x4*)cbp, cb1 = *(const LAS f32x4*)(cbp + 4);
                    const f32x4 as0 = *(const LAS f32x4*)(ACS + r * 64 + 32 * ks + 8 * q), as1 = *(const LAS f32x4*)(ACS + r * 64 + 32 * ks + 8 * q + 4);
                    const f32x4 d0 = *(const LAS f32x4*)(DTV + r * 64 + 32 * ks + 8 * q), d1 = *(const LAS f32x4*)(DTV + r * 64 + 32 * ks + 8 * q + 4);
                    f32x4 m0, m1;
#pragma unroll
                    for (int j = 0; j < 4; ++j) { const int s0 = 32 * ks + 8 * q + j, s1 = s0 + 4;
                        m0[j] = (s0 <= l) ? cb0[j] * __expf(acl - as0[j]) * d0[j] : 0.f;
                        m1[j] = (s1 <= l) ? cb1[j] * __expf(acl - as1[j]) * d1[j] : 0.f; }
                    const bf16x8 mf = __builtin_bit_cast(bf16x8, pack8(m0, m1));
#pragma unroll
                    for (int pt = 0; pt < 2; ++pt) accY[lt][pt] = MFMA16(mf, xf[ks][pt], accY[lt][pt]);
                }
#pragma unroll
            for (int lt = 0; lt < 4; ++lt) {
#pragma unroll
                for (int pt = 0; pt < 2; ++pt) { const int prow = prow0 + 16 * pt;
                    const f32x4 xv = unpack4(*(const LAS u32x2*)(sm + O_XT + prow * SX_STR + (16 * lt + 4 * q) * 2));
#pragma unroll
                    for (int rg = 0; rg < 4; ++rg) { const int l = 16 * lt + 4 * q + rg; const float zv = bf2f(*(const LAS bf16_t*)(sm + O_ZT + l * SZ_STR + prow * 2));
                        accY[lt][pt][rg] = (accY[lt][pt][rg] + d_r * xv[rg]) * zv; } }
                f32x4 sv;
#pragma unroll
                for (int rg = 0; rg < 4; ++rg) sv[rg] = row16_sum(accY[lt][0][rg] * accY[lt][0][rg] + accY[lt][1][rg] * accY[lt][1][rg]);
                if (c == 0) *(LAS f32x4*)(SSQ + w * 64 + 16 * lt + 4 * q) = sv;
            }
            {
                const float dec = __expf(ACS[r * 64 + 63]);
#pragma unroll
                for (int nt = 0; nt < 8; ++nt)
#pragma unroll
                    for (int pt = 0; pt < 2; ++pt) accH[nt][pt] *= dec;
                bf16x8 xw[2][2];
#pragma unroll
                for (int ks = 0; ks < 2; ++ks) { const f32x4 w0 = *(const LAS f32x4*)(WG + r * 64 + 32 * ks + 8 * q), w1 = *(const LAS f32x4*)(WG + r * 64 + 32 * ks + 8 * q + 4);
#pragma unroll
                    for (int pt = 0; pt < 2; ++pt) { f32x4 a, bq; unpack8(__builtin_bit_cast(u32x4, xf[ks][pt]), a, bq); xw[ks][pt] = __builtin_bit_cast(bf16x8, pack8(a * w0, bq * w1)); } }
#pragma unroll
                for (int nt = 0; nt < 8; ++nt)
#pragma unroll
                    for (int ks = 0; ks < 2; ++ks) { const bf16x8 bfr = *(const LAS bf16x8*)(sm + O_BT + (16 * nt + c) * SX_STR + (32 * ks + 8 * q) * 2);
#pragma unroll
                        for (int pt = 0; pt < 2; ++pt) accH[nt][pt] = MFMA16(bfr, xw[ks][pt], accH[nt][pt]); }
            }
            SSD_ISSUE(sub + 1 < SEQ / 64 ? sub + 1 : sub);
            __syncthreads();
            { float s = 0.f;
#pragma unroll
              for (int k = 0; k < 8; ++k) s += SSQ[k * 64 + lane];
              LAS float* RSW = (LAS float*)(sm + O_RSW) + w * 64;
              RSW[lane] = rsqrtf(s * (1.0f / 256.0f) + RMS_EPS);
#pragma unroll
              for (int lt = 0; lt < 4; ++lt) { const f32x4 rs = *(const LAS f32x4*)(RSW + 16 * lt + 4 * q);
#pragma unroll
                for (int pt = 0; pt < 2; ++pt) { const float nw = pt ? nw1 : nw0;
#pragma unroll
                    for (int rg = 0; rg < 4; ++rg) { const int l = 16 * lt + 4 * q + rg;
                        *(LAS bf16_t*)(sm + O_ZT + l * SZ_STR + (prow0 + 16 * pt) * 2) = (bf16_t)(cvt_pk_bf16(accY[lt][pt][rg] * rs[rg] * nw, 0.f) & 0xffffu); } } }
#pragma unroll
              for (int k = 0; k < 4; ++k) { const int row = (lane >> 2) + 16 * k, pc = lane & 3;
                *(u32x4*)(zy + (t0 + row) * 2048 + g * 256 + r * 64 + ph * 32 + pc * 8) = *(const LAS u32x4*)(sm + O_ZT + row * SZ_STR + (r * 64 + ph * 32 + pc * 8) * 2); }
            }
        }
    }
}

template <int W, int RUN = 16>
__device__ __forceinline__ void pool_task(const bf16_t* __restrict__ colp, bf16_t* __restrict__ outp, int t0, int s0) {
    constexpr int H = W - 1;
    u32x4 rw[RUN + H];
#pragma unroll
    for (int j = 0; j < RUN + H; ++j) { int tt = t0 - H + j; tt = tt < 0 ? 0 : tt; rw[j] = *(const u32x4*)(colp + (size_t)tt * 1024); }
    f32x4 S0 = {0.f, 0.f, 0.f, 0.f}, S1 = {0.f, 0.f, 0.f, 0.f};
#pragma unroll
    for (int j = 1; j <= H; ++j) { f32x4 a, b; unpack8(rw[H - j], a, b); const bool ok = (s0 - j >= 0); S0 += ok ? a : (f32x4){0.f, 0.f, 0.f, 0.f}; S1 += ok ? b : (f32x4){0.f, 0.f, 0.f, 0.f}; }
#pragma unroll
    for (int tt = 0; tt < RUN; ++tt) { const int s = s0 + tt;
        f32x4 a, b; unpack8(rw[H + tt], a, b); S0 += a; S1 += b;
        const float inv = 1.0f / (float)(s + 1 < W ? s + 1 : W);
        *(u32x4*)(outp + (size_t)(t0 + tt) * 1024) = pack8(S0 * inv - a, S1 * inv - b);
        f32x4 c, d; unpack8(rw[tt], c, d);
        if (s - W + 1 >= 0) { S0 -= c; S1 -= d; } }
}
__device__ __forceinline__ void pool_tile(const Params& p, int pm, int g) {
    const bf16_t* up = (const bf16_t*)(p.ws + WS_RA); bf16_t* pooled = (bf16_t*)(p.ws + WS_RA + 384 * MiB);
    int tl = threadIdx.x; asm volatile("" : "+v"(tl));
    const int vec = g * 32 + (tl & 31), run = tl >> 5;
    const int t0 = pm * 256 + run * 16, s0 = t0 & (SEQ - 1);
    const bf16_t* colp = up + vec * 8; bf16_t* outp = pooled + vec * 8;
    if (g == 0) pool_task<2>(colp, outp, t0, s0); else if (g == 1) pool_task<4>(colp, outp, t0, s0);
    else if (g == 2) pool_task<8>(colp, outp, t0, s0); else { pool_task<16, 8>(colp, outp, t0, s0); pool_task<16, 8>(colp, outp, t0 + 8, s0 + 8); }
}

template <bool OUT_BF16>
__device__ void phase_ln(const bf16_t* __restrict__ src, void* __restrict__ dst, const float* __restrict__ gam, const float* __restrict__ bet) {
    const int lane = threadIdx.x & 63, wv = threadIdx.x >> 6;
    f32x4 gv[4], bv[4];
#pragma unroll
    for (int i = 0; i < 2; ++i) { gv[2 * i] = *(const f32x4*)(gam + lane * 8 + 512 * i); gv[2 * i + 1] = *(const f32x4*)(gam + lane * 8 + 512 * i + 4);
        bv[2 * i] = *(const f32x4*)(bet + lane * 8 + 512 * i); bv[2 * i + 1] = *(const f32x4*)(bet + lane * 8 + 512 * i + 4); }
    for (int row0 = (blockIdx.x * 8 + wv) * 4; row0 < T_TOK; row0 += gridDim.x * 8 * 4) {
        u32x4 rw[4][2];
#pragma unroll
        for (int rr = 0; rr < 4; ++rr)
#pragma unroll
            for (int i = 0; i < 2; ++i) rw[rr][i] = *(const u32x4*)(src + (size_t)(row0 + rr) * DM + lane * 8 + 512 * i);
#pragma unroll
        for (int rr = 0; rr < 4; ++rr) {
            f32x4 v[4]; unpack8(rw[rr][0], v[0], v[1]); unpack8(rw[rr][1], v[2], v[3]);
            float s = 0.f;
#pragma unroll
            for (int i = 0; i < 4; ++i) s += (v[i][0] + v[i][1]) + (v[i][2] + v[i][3]);
#pragma unroll
            for (int o = 32; o >= 1; o >>= 1) s += __shfl_xor(s, o);
            const float mu = s * (1.0f / 1024.0f); float q = 0.f;
#pragma unroll
            for (int i = 0; i < 4; ++i) { v[i] -= mu; q += (v[i][0] * v[i][0] + v[i][1] * v[i][1]) + (v[i][2] * v[i][2] + v[i][3] * v[i][3]); }
#pragma unroll
            for (int o = 32; o >= 1; o >>= 1) q += __shfl_xor(q, o);
            const float rstd = rsqrtf(q * (1.0f / 1024.0f) + LN_EPS);
#pragma unroll
            for (int i = 0; i < 2; ++i) { const f32x4 o0 = v[2 * i] * rstd * gv[2 * i] + bv[2 * i], o1 = v[2 * i + 1] * rstd * gv[2 * i + 1] + bv[2 * i + 1];
                if (OUT_BF16) *(u32x4*)((bf16_t*)dst + (size_t)(row0 + rr) * DM + lane * 8 + 512 * i) = pack8(o0, o1);
                else { float* op = (float*)dst + (size_t)(row0 + rr) * DM + lane * 8 + 512 * i; *(f32x4*)op = o0; *(f32x4*)(op + 4) = o1; } }
        }
    }
}

__device__ __forceinline__ void ln_panel_bf16(const bf16_t* __restrict__ src, bf16_t* __restrict__ dst, const float* __restrict__ gam, const float* __restrict__ bet, int r0) {
    int tl = threadIdx.x; asm volatile("" : "+v"(tl));
    const int lane = tl & 63, wv = tl >> 6;
    f32x4 gv[4], bv[4];
#pragma unroll
    for (int i = 0; i < 2; ++i) { gv[2 * i] = *(const f32x4*)(gam + lane * 8 + 512 * i); gv[2 * i + 1] = *(const f32x4*)(gam + lane * 8 + 512 * i + 4);
        bv[2 * i] = *(const f32x4*)(bet + lane * 8 + 512 * i); bv[2 * i + 1] = *(const f32x4*)(bet + lane * 8 + 512 * i + 4); }
#pragma unroll 1
    for (int k = 0; k < 8; ++k) { const int row0 = r0 + wv * 32 + k * 4;
        u32x4 rw[4][2];
#pragma unroll
        for (int rr = 0; rr < 4; ++rr)
#pragma unroll
            for (int i = 0; i < 2; ++i) rw[rr][i] = *(const u32x4*)(src + (size_t)(row0 + rr) * DM + lane * 8 + 512 * i);
#pragma unroll
        for (int rr = 0; rr < 4; ++rr) {
            f32x4 v[4]; unpack8(rw[rr][0], v[0], v[1]); unpack8(rw[rr][1], v[2], v[3]);
            float sm = 0.f;
#pragma unroll
            for (int i = 0; i < 4; ++i) sm += (v[i][0] + v[i][1]) + (v[i][2] + v[i][3]);
#pragma unroll
            for (int o = 32; o >= 1; o >>= 1) sm += __shfl_xor(sm, o);
            const float mu = sm * (1.0f / 1024.0f); float q = 0.f;
#pragma unroll
            for (int i = 0; i < 4; ++i) { v[i] -= mu; q += (v[i][0] * v[i][0] + v[i][1] * v[i][1]) + (v[i][2] * v[i][2] + v[i][3] * v[i][3]); }
#pragma unroll
            for (int o = 32; o >= 1; o >>= 1) q += __shfl_xor(q, o);
            const float rstd = rsqrtf(q * (1.0f / 1024.0f) + LN_EPS);
#pragma unroll
            for (int i = 0; i < 2; ++i) *(u32x4*)(dst + (size_t)(row0 + rr) * DM + lane * 8 + 512 * i) = pack8(v[2 * i] * rstd * gv[2 * i] + bv[2 * i], v[2 * i + 1] * rstd * gv[2 * i + 1] + bv[2 * i + 1]);
        }
    }
}

__global__ void __launch_bounds__(512, 2) mega(Params p) {
    extern __shared__ __attribute__((aligned(16))) unsigned char lds_raw[];
    LAS unsigned char* lds = (LAS unsigned char*)lds_raw;
    cg::grid_group grid = cg::this_grid();
    unsigned char* ws = p.ws;
    const int G = gridDim.x, c = blockIdx.x;
#ifndef PHMASK
#define PHMASK 0x7ff
#endif
#define IN(k) (((PHMASK >> (k)) & 1) && p.ph_lo <= (k) && (k) < p.ph_hi)
#define SEAM(k) do { if (IN(k) && IN((k) + 1)) grid.sync(); } while (0)
    if (IN(0)) phase0(p, lds_raw);
    SEAM(0);
    if (IN(1)) {
        { pg8::Gemm g{(const bf16_t*)(ws + WS_RC), (const bf16_t*)(ws + WS_WIN1), T_TOK, N1 - 256, 1024, 1024, 1024, 0};
          pg8::StaticOrder S; S.init(T_TOK, N1 - 256, G, c);
          pg8::EpiG1 E{(bf16_t*)(ws + WS_RB), (bf16_t*)(ws + WS_RA), (float*)(ws + WS_DT), p.in[5], 0};
          pg8::gemm_phase<pg8::EpiG1>(lds, g, S, E); }
        { pg8::Gemm g{(const bf16_t*)(ws + WS_RC), (const bf16_t*)(ws + WS_WIN1) + (size_t)(N1 - 256) * 1024, T_TOK, 256, 1024, 1024, 1024, 0};
          pg8::StaticOrder S; S.init(T_TOK, 256, G, c);
          pg8::EpiG1 E{(bf16_t*)(ws + WS_RB), (bf16_t*)(ws + WS_RA), (float*)(ws + WS_DT), p.in[5], 24};
          pg8::gemm_phase<pg8::EpiG1>(lds, g, S, E); }
    }
    SEAM(1);
    #ifdef SSD_SIMPLE
    if (IN(2)) phase_ssd_simple(p, lds_raw);
#else
    if (IN(2)) phase_ssd(p, lds);
#endif
    SEAM(2);
    if (IN(3)) {
        pg8::Gemm g{(const bf16_t*)(ws + WS_RC), (const bf16_t*)(ws + WS_WIN2), T_TOK, N2, 1024, 1024, 1024, 0};
        pg8::StaticOrder S; S.init(T_TOK, N2, G, c);
        pg8::EpiG2 E{(bf16_t*)(ws + WS_RA), (bf16_t*)(ws + WS_RA + 128 * MiB), p.in[2]};
        pg8::gemm_phase<pg8::EpiG2>(lds, g, S, E);
    }
    SEAM(3);
    if (IN(5)) {
        bf16_t* merged = (bf16_t*)(ws + WS_RC); const bf16_t* gates = (const bf16_t*)(ws + WS_RA + 128 * MiB);
        pg8::StaticOrder S; S.init(T_TOK, 1024, G, c);
        const pg8::Gemm gp{(const bf16_t*)(ws + WS_RA + 384 * MiB), (const bf16_t*)(ws + WS_WP), T_TOK, 1024, 256, 1024, 256, 512};
        const pg8::Gemm gs{(const bf16_t*)(ws + WS_RB), (const bf16_t*)(ws + WS_WSSD), T_TOK, 1024, 2048, 2048, 2048, 0};
        if ((c & 1) == 0) {
            { pg8::Unit u; for (int i = 0; S.next(i, u); ++i) pool_tile(p, u.pm, u.pn); }
            __syncthreads();
            { pg8::EpiPool<true> E{merged, gates}; pg8::gemm_phase<pg8::EpiPool<true>>(lds, gp, S, E); }
            { pg8::EpiSsd<false> E{merged, gates}; pg8::gemm_phase<pg8::EpiSsd<false>>(lds, gs, S, E); }
        } else {
            { pg8::EpiSsd<true> E{merged, gates}; pg8::gemm_phase<pg8::EpiSsd<true>>(lds, gs, S, E); }
            { pg8::Unit u; for (int i = 0; S.next(i, u); ++i) pool_tile(p, u.pm, u.pn); }
            __syncthreads();
            { pg8::EpiPool<false> E{merged, gates}; pg8::gemm_phase<pg8::EpiPool<false>>(lds, gp, S, E); }
        }
    }
    SEAM(5);
    if (IN(6)) {
        pg8::Gemm g{(const bf16_t*)(ws + WS_RC), (const bf16_t*)(ws + WS_WOUT), T_TOK, 1024, 1024, 1024, 1024, 0};
        pg8::StaticOrder S; S.init(T_TOK, 1024, G, c, 1);
        pg8::EpiOut E{p.in[0], (bf16_t*)(ws + WS_RB)};
        pg8::gemm_phase<pg8::EpiOut>(lds, g, S, E);
        __syncthreads();
        for (int pm = c; pm < T_TOK / 256; pm += G) ln_panel_bf16((const bf16_t*)(ws + WS_RB), (bf16_t*)(ws + WS_RC), p.in[13], p.in[14], pm * 256);
    }
    SEAM(6);
    if (IN(8)) {
        pg8::Gemm g{(const bf16_t*)(ws + WS_RC), (const bf16_t*)(ws + WS_WUP), T_TOK, DFF, 1024, 1024, 1024, 0};
        pg8::StaticOrder S; S.init(T_TOK, DFF, G, c);
        pg8::EpiUp E{(bf16_t*)(ws + WS_RA)};
        pg8::gemm_phase<pg8::EpiUp>(lds, g, S, E);
    }
    SEAM(8);
    if (IN(9)) {
        pg8::Gemm g{(const bf16_t*)(ws + WS_RA), (const bf16_t*)(ws + WS_WDN), T_TOK, 1024, DFF, DFF, DFF, 0};
        pg8::StaticOrder S; S.init(T_TOK, 1024, G, c);
        pg8::EpiDown E{(const bf16_t*)(ws + WS_RC), (bf16_t*)(ws + WS_RB)};
        pg8::gemm_phase<pg8::EpiDown>(lds, g, S, E);
    }
    SEAM(9);
    if (IN(10)) phase_ln<false>((const bf16_t*)(ws + WS_RB), (void*)p.out, p.in[17], p.in[18]);
#undef IN
#undef SEAM
}

#ifndef DUPMASK
#define DUPMASK 0
#endif
#ifndef ONE_LAUNCH
#define ONE_LAUNCH 1
#endif
extern "C" void kernel_launch(void* const* d_in, const int* in_sizes, int n_in, void* d_out, int out_size, void* d_ws, size_t ws_size, hipStream_t stream) {
    static int grid = 0;
    if (grid == 0) {
        if (n_in != 19 || ws_size < WS_END) { fprintf(stderr, "kernel_launch: need 19 inputs and >= %zu bytes of workspace; got %d, %zu\n", (size_t)WS_END, n_in, ws_size); grid = -1; return; }
        int dev = 0, cus = 0, per_cu = 0;
        hipGetDevice(&dev); hipDeviceGetAttribute(&cus, hipDeviceAttributeMultiprocessorCount, dev);
        if (hipFuncSetAttribute((const void*)mega, hipFuncAttributeMaxDynamicSharedMemorySize, LDS_BYTES) != hipSuccess) { fprintf(stderr, "kernel_launch: hipFuncSetAttribute failed\n"); grid = -1; return; }
        if (hipOccupancyMaxActiveBlocksPerMultiprocessor(&per_cu, (const void*)mega, 512, LDS_BYTES) != hipSuccess || per_cu < 1) { fprintf(stderr, "kernel_launch: occupancy query says %d\n", per_cu); per_cu = 1; }
        (void)hipGetLastError();
        grid = cus;
    }
    if (grid < 0) return;
    Params p{};
    for (int i = 0; i < 19; ++i) p.in[i] = (const float*)d_in[i];
    p.out = (float*)d_out; p.ws = (unsigned char*)d_ws;
#if ONE_LAUNCH
    p.ph_lo = 0; p.ph_hi = NPHASE;
    void* args[] = {&p};
    hipError_t e = hipLaunchCooperativeKernel((const void*)mega, dim3(grid), dim3(512), args, LDS_BYTES, stream);
    if (e != hipSuccess) fprintf(stderr, "cooperative launch failed: %s (grid %d)\n", hipGetErrorString(e), grid);
#else
    for (int ph = 0; ph < NPHASE; ++ph) { p.ph_lo = ph; p.ph_hi = ph + 1;
        for (int rep = 0; rep < (((DUPMASK >> ph) & 1) ? 2 : 1); ++rep) hipLaunchKernelGGL(mega, dim3(grid), dim3(512), LDS_BYTES, stream, p); }
#endif
}
```

```cpp
#include <hip/hip_runtime.h>
#include <hip/hip_cooperative_groups.h>
#include <cstdio>
namespace cg = cooperative_groups;

#define LAS __attribute__((address_space(3)))
typedef unsigned short bf16_t;
typedef short bf16x8 __attribute__((ext_vector_type(8)));
typedef float f32x4 __attribute__((ext_vector_type(4)));
typedef float f32x2 __attribute__((ext_vector_type(2)));
typedef unsigned u32x4 __attribute__((ext_vector_type(4)));
typedef unsigned u32x2 __attribute__((ext_vector_type(2)));

constexpr int T_TOK = 65536, SEQ = 2048, DM = 1024, DFF = 4096;
constexpr int N1 = 6400;
constexpr int N2 = 3072;
constexpr float ALPHA = 1.189207115002721f;
constexpr float LN_EPS = 1e-5f, RMS_EPS = 1e-5f;
constexpr size_t MiB = 1024ull * 1024ull;
constexpr size_t WS_RA = 0;
constexpr size_t WS_RB = 512 * MiB;
constexpr size_t WS_RC = 768 * MiB;
constexpr size_t WS_DT = 896 * MiB;
constexpr size_t WS_W  = 904 * MiB;
constexpr size_t WS_WIN1 = WS_W;
constexpr size_t WS_WIN2 = WS_WIN1 + (size_t)N1 * 1024 * 2;
constexpr size_t WS_WP   = WS_WIN2 + (size_t)N2 * 1024 * 2;
constexpr size_t WS_WSSD = WS_WP + (size_t)1024 * 256 * 2;
constexpr size_t WS_WOUT = WS_WSSD + (size_t)1024 * 2048 * 2;
constexpr size_t WS_WUP  = WS_WOUT + (size_t)1024 * 1024 * 2;
constexpr size_t WS_WDN  = WS_WUP + (size_t)4096 * 1024 * 2;
constexpr size_t WS_END  = WS_WDN + (size_t)4096 * 1024 * 2;
constexpr int LDS_BYTES = 160000;
constexpr int NPHASE = 11;

struct Params { const float* in[19]; float* out; unsigned char* ws; int ph_lo, ph_hi; };

__device__ __forceinline__ unsigned cvt_pk_bf16(float lo, float hi) { unsigned r; asm volatile("v_cvt_pk_bf16_f32 %0, %1, %2" : "=v"(r) : "v"(lo), "v"(hi)); return r; }
__device__ __forceinline__ float bf_lo(unsigned u) { return __uint_as_float(u << 16); }
__device__ __forceinline__ float bf_hi(unsigned u) { return __uint_as_float(u & 0xffff0000u); }
__device__ __forceinline__ float bf2f(bf16_t b) { return __uint_as_float(((unsigned)b) << 16); }
__device__ __forceinline__ float sigmoidf_(float v) { return __builtin_amdgcn_rcpf(1.0f + __expf(-v)); }
__device__ __forceinline__ float siluf_(float v) { return v * __builtin_amdgcn_rcpf(1.0f + __expf(-v)); }
__device__ __forceinline__ float softplusf_(float v) { return fmaxf(v, 0.f) + log1pf(__expf(-fabsf(v))); }
__device__ __forceinline__ u32x4 pack8(f32x4 a, f32x4 b) { u32x4 w; w.x = cvt_pk_bf16(a[0], a[1]); w.y = cvt_pk_bf16(a[2], a[3]); w.z = cvt_pk_bf16(b[0], b[1]); w.w = cvt_pk_bf16(b[2], b[3]); return w; }
__device__ __forceinline__ void unpack8(u32x4 w, f32x4& a, f32x4& b) { a = (f32x4){bf_lo(w.x), bf_hi(w.x), bf_lo(w.y), bf_hi(w.y)}; b = (f32x4){bf_lo(w.z), bf_hi(w.z), bf_lo(w.w), bf_hi(w.w)}; }

namespace pg8 {
constexpr int BM = 256, BK = 64, HALF = 128, HTB = HALF * BK * 2, STAGE_BYTES = 8 * HTB, NXCD = 8, WGM = 8;
__device__ __forceinline__ int lds_byte(int r, int c) { const int st = (r >> 4) * 2 + (c >> 5), rr = r & 15, cc = c & 31, ob = rr * 64 + cc * 2; return st * 1024 + (ob ^ (((ob >> 9) & 1) << 5)); }
__device__ __forceinline__ void stage_rc(int b, int& R, int& C) { const int st = b / 1024, sb = b % 1024, swz = sb ^ (((sb >> 9) & 1) << 5); R = (st >> 1) * 16 + swz / 64; C = (st & 1) * 32 + (swz % 64) / 2; }
__device__ __forceinline__ int perm32(int rho) { const int n = rho >> 4, i = rho & 15; return 8 * (i >> 2) + 4 * n + (i & 3); }
struct Unit { int pm, pn; };
struct Gemm { const bf16_t* A; const bf16_t* Bt; int M, N, K, lda, ldb, a_pn_bytes; };
struct StaticOrder {
    int nM, nN, nwg, G, c, owner;
    __device__ void init(int M, int N, int G_, int c_, int owner_ = 0) { nM = M / BM; nN = N / BM; nwg = nM * nN; G = G_; c = c_; owner = owner_; }
    __device__ bool next(int i, Unit& u) const {
        if (owner) { const int pm = c + (i / nN) * G; if (pm >= nM) return false; u.pm = pm; u.pn = i % nN; return true; }
        const long L = (long)i * G + c; if (L >= nwg) return false;
        int wgid = (int)L; { const int q = nwg / NXCD, r = nwg % NXCD, xcd = wgid % NXCD, off = wgid / NXCD; wgid = (xcd < r ? xcd * (q + 1) : r * (q + 1) + (xcd - r) * q) + off; }
        const int nig = WGM * nN, gid = wgid / nig, fm = gid * WGM, gsz = (nM - fm) < WGM ? (nM - fm) : WGM;
        u.pm = fm + ((wgid % nig) % gsz); u.pn = (wgid % nig) / gsz; return true;
    }
};

template <int OFF> __device__ __forceinline__ void ds_rd128(bf16x8& dst, unsigned addr) { asm volatile("ds_read_b128 %0, %1 offset:%2" : "=v"(dst) : "v"(addr), "n"(OFF)); }
template <class Epi, bool NARROW = false>
__device__ __forceinline__ void gemm_phase(LAS unsigned char* lds, const Gemm g, const StaticOrder& S, const Epi& E) {
    int tid_l = threadIdx.x; asm volatile("" : "+v"(tid_l));
    const int tid = tid_l, wid = __builtin_amdgcn_readfirstlane(tid >> 6), lane = tid & 63, wr = wid >> 2, wc = wid & 3, fr = lane & 15, fq = lane >> 4;
    const int K = g.K, nt = K / BK;
    unsigned voffA[2], voffB[2];
#pragma unroll
    for (int i = 0; i < 2; ++i) { int R, C; stage_rc(tid * 16 + i * 8192, R, C); const int Rb = Epi::PERM ? ((R & ~31) + perm32(R & 31)) : R;
        voffA[i] = (unsigned)(R * g.lda + C) * 2u; voffB[i] = (unsigned)(Rb * g.ldb + C) * 2u; }
    const size_t kstep = (size_t)(BK * 2);
    const size_t hsA = (size_t)HALF * g.lda * 2, hsB = (size_t)HALF * g.ldb * 2;
    const size_t tsA = 2 * hsA, tsB = 2 * hsB;
    const unsigned ldsw = (unsigned)wid * 1024u;
    const int aoff = lds_byte(wr * 64 + fr, fq * 8), boff = lds_byte(wc * 32 + fr, fq * 8);
    const unsigned aaddr = (unsigned)(unsigned long long)(lds + aoff), baddr = (unsigned)(unsigned long long)(lds + 4 * HTB + boff);
#define PG8_SA(b, h) (((b) * 2 + (h)) * HTB)
#define PG8_SB(b, h) ((4 + (b) * 2 + (h)) * HTB)
#define PG8_STAGE(bufoff, gbase, voff) do { _Pragma("unroll") for (int _i = 0; _i < 2; ++_i) \
        __builtin_amdgcn_global_load_lds((const unsigned*)((const char*)(gbase) + (voff)[_i]), (LAS unsigned*)(lds + (bufoff) + ldsw + _i * 8192), 16, 0, 0); } while (0)
#define PG8_LDA(dst, b, h) do { _Pragma("unroll") for (int m = 0; m < 4; ++m) _Pragma("unroll") for (int k = 0; k < 2; ++k) dst[m][k] = *(const LAS bf16x8*)(lds + PG8_SA(b, h) + aoff + m * 2048 + k * 1024); } while (0)
#define PG8_LDB(dst, b, h) do { _Pragma("unroll") for (int n = 0; n < 2; ++n) _Pragma("unroll") for (int k = 0; k < 2; ++k) dst[n][k] = *(const LAS bf16x8*)(lds + PG8_SB(b, h) + boff + n * 2048 + k * 1024); } while (0)
#define PG8_MMA(ai, bj, At, Bt) do { __builtin_amdgcn_s_setprio(1); _Pragma("unroll") for (int m = 0; m < 4; ++m) _Pragma("unroll") for (int n = 0; n < 2; ++n) _Pragma("unroll") for (int k = 0; k < 2; ++k) \
        acc[ai][bj][m][n] = __builtin_amdgcn_mfma_f32_16x16x32_bf16(Bt[n][k], At[m][k], acc[ai][bj][m][n], 0, 0, 0); __builtin_amdgcn_s_setprio(0); } while (0)
#define PG8_RDA(dst, b, h) do { ds_rd128<PG8_SA(b, h) + 0 * 2048>(dst[0][0], aaddr); ds_rd128<PG8_SA(b, h) + 1 * 2048>(dst[1][0], aaddr); ds_rd128<PG8_SA(b, h) + 2 * 2048>(dst[2][0], aaddr); ds_rd128<PG8_SA(b, h) + 3 * 2048>(dst[3][0], aaddr); \
        ds_rd128<PG8_SA(b, h) + 0 * 2048 + 1024>(dst[0][1], aaddr); ds_rd128<PG8_SA(b, h) + 1 * 2048 + 1024>(dst[1][1], aaddr); ds_rd128<PG8_SA(b, h) + 2 * 2048 + 1024>(dst[2][1], aaddr); ds_rd128<PG8_SA(b, h) + 3 * 2048 + 1024>(dst[3][1], aaddr); } while (0)
#define PG8_RDB(dst, b, h) do { ds_rd128<PG8_SA(b, h)>(dst[0][0], baddr); ds_rd128<PG8_SA(b, h) + 2048>(dst[1][0], baddr); ds_rd128<PG8_SA(b, h) + 1024>(dst[0][1], baddr); ds_rd128<PG8_SA(b, h) + 2048 + 1024>(dst[1][1], baddr); } while (0)
#define PG8_WAITA(n, F, k) asm volatile("s_waitcnt lgkmcnt(" #n ")" : "+v"(F[0][k]), "+v"(F[1][k]), "+v"(F[2][k]), "+v"(F[3][k]) :: "memory")
#define PG8_WAITB(n, F, k) asm volatile("s_waitcnt lgkmcnt(" #n ")" : "+v"(F[0][k]), "+v"(F[1][k]) :: "memory")
#define PG8_WAITAB(n, FA, FB) asm volatile("s_waitcnt lgkmcnt(" #n ")" : "+v"(FA[0][0]), "+v"(FA[1][0]), "+v"(FA[2][0]), "+v"(FA[3][0]), "+v"(FB[0][0]), "+v"(FB[1][0]), "+v"(FB[0][1]), "+v"(FB[1][1]) :: "memory")
#define PG8_MMAK(ai, bj, At, Bt, k) do { _Pragma("unroll") for (int m = 0; m < 4; ++m) _Pragma("unroll") for (int n = 0; n < 2; ++n) \
        acc[ai][bj][m][n] = __builtin_amdgcn_mfma_f32_16x16x32_bf16(Bt[n][k], At[m][k], acc[ai][bj][m][n], 0, 0, 0); } while (0)
#define PG8_PRIO(x) __builtin_amdgcn_s_setprio(x)
#define PG8_WAIT_V(n) asm volatile("s_waitcnt vmcnt(" #n ")" ::: "memory")
#define PG8_WAIT_L(n) asm volatile("s_waitcnt lgkmcnt(" #n ")" ::: "memory")
#define PG8_BAR __builtin_amdgcn_s_barrier()
#define PG8_SCHED __builtin_amdgcn_sched_barrier(0)
    Unit cur, nxt; int ui = 0;
    if (!S.next(0, cur)) return;
    f32x4 acc[2][2][4][2];
#pragma unroll
    for (int a = 0; a < 2; ++a)
#pragma unroll
        for (int b = 0; b < 2; ++b)
#pragma unroll
            for (int m = 0; m < 4; ++m)
#pragma unroll
                for (int n = 0; n < 2; ++n) acc[a][b][m][n] = (f32x4){0.f, 0.f, 0.f, 0.f};
    bf16x8 At[4][2], B0[2][2], B1[2][2];
    const char* cA = (const char*)g.A + (size_t)cur.pm * tsA + (size_t)cur.pn * g.a_pn_bytes; const char* cB = (const char*)g.Bt + (size_t)cur.pn * tsB;
    PG8_STAGE(PG8_SB(0, 0), cB, voffB); PG8_STAGE(PG8_SA(0, 0), cA, voffA); PG8_STAGE(PG8_SB(0, 1), cB + hsB, voffB); PG8_STAGE(PG8_SA(0, 1), cA + hsA, voffA);
    if (wr == 1) PG8_BAR;
    PG8_WAIT_V(4); PG8_BAR;
    PG8_STAGE(PG8_SB(1, 0), cB + kstep, voffB); PG8_STAGE(PG8_SA(1, 0), cA + kstep, voffA); PG8_STAGE(PG8_SB(1, 1), cB + hsB + kstep, voffB);
    PG8_WAIT_V(6); PG8_BAR;
    PG8_RDB(B0, 0, 0);
    for (;;) {
        const bool has_next = S.next(ui + 1, nxt);
        const char* nA = has_next ? (const char*)g.A + (size_t)nxt.pm * tsA + (size_t)nxt.pn * g.a_pn_bytes : cA; const char* nB = has_next ? (const char*)g.Bt + (size_t)nxt.pn * tsB : cB;
#pragma unroll 1
        for (int t = 0; t < nt; t += 2) {
            const bool last = (t == nt - 2);
            const char* a1 = cA + (size_t)(t + 1) * kstep;
            const char* a2 = last ? nA : cA + (size_t)(t + 2) * kstep; const char* b2 = last ? nB : cB + (size_t)(t + 2) * kstep;
            const char* a3 = a2 + kstep; const char* b3 = b2 + kstep;
            PG8_RDA(At, 0, 0); PG8_STAGE(PG8_SA(1, 1), a1 + hsA, voffA);
            PG8_WAIT_V(10); PG8_BAR; PG8_PRIO(1); PG8_WAITAB(4, At, B0); PG8_SCHED; PG8_MMAK(0, 0, At, B0, 0); PG8_SCHED; PG8_WAITA(0, At, 1); PG8_SCHED; PG8_MMAK(0, 0, At, B0, 1); PG8_PRIO(0); PG8_BAR; PG8_SCHED;
            PG8_RDB(B1, 0, 1); PG8_STAGE(PG8_SB(0, 0), b2, voffB);
            PG8_WAIT_V(10); PG8_BAR; PG8_PRIO(1); PG8_WAITB(2, B1, 0); PG8_SCHED; if (!NARROW) PG8_MMAK(0, 1, At, B1, 0); PG8_SCHED; PG8_WAITB(0, B1, 1); PG8_SCHED; if (!NARROW) PG8_MMAK(0, 1, At, B1, 1); PG8_PRIO(0); PG8_BAR; PG8_SCHED;
            PG8_RDA(At, 0, 1); PG8_STAGE(PG8_SA(0, 0), a2, voffA);
            PG8_WAIT_V(10); PG8_BAR; PG8_PRIO(1); PG8_WAITA(4, At, 0); PG8_SCHED; PG8_MMAK(1, 0, At, B0, 0); PG8_SCHED; PG8_WAITA(0, At, 1); PG8_SCHED; PG8_MMAK(1, 0, At, B0, 1); PG8_PRIO(0); PG8_BAR; PG8_SCHED;
            PG8_RDB(B0, 1, 0); PG8_STAGE(PG8_SB(0, 1), b2 + hsB, voffB);
            PG8_WAIT_V(10); PG8_BAR; if (!NARROW) PG8_MMA(1, 1, At, B1); PG8_BAR; PG8_SCHED;
            PG8_RDA(At, 1, 0); PG8_STAGE(PG8_SA(0, 1), a2 + hsA, voffA);
            PG8_WAIT_V(10); PG8_BAR; PG8_PRIO(1); PG8_WAITAB(4, At, B0); PG8_SCHED; PG8_MMAK(0, 0, At, B0, 0); PG8_SCHED; PG8_WAITA(0, At, 1); PG8_SCHED; PG8_MMAK(0, 0, At, B0, 1); PG8_PRIO(0); PG8_BAR; PG8_SCHED;
            PG8_RDB(B1, 1, 1); PG8_STAGE(PG8_SB(1, 0), b3, voffB);
            PG8_WAIT_V(10); PG8_BAR; PG8_PRIO(1); PG8_WAITB(2, B1, 0); PG8_SCHED; if (!NARROW) PG8_MMAK(0, 1, At, B1, 0); PG8_SCHED; PG8_WAITB(0, B1, 1); PG8_SCHED; if (!NARROW) PG8_MMAK(0, 1, At, B1, 1); PG8_PRIO(0); PG8_BAR; PG8_SCHED;
            PG8_RDA(At, 1, 1); PG8_STAGE(PG8_SA(1, 0), a3, voffA);
            PG8_WAIT_V(10); PG8_BAR; PG8_PRIO(1); PG8_WAITA(4, At, 0); PG8_SCHED; PG8_MMAK(1, 0, At, B0, 0); PG8_SCHED; PG8_WAITA(0, At, 1); PG8_SCHED; PG8_MMAK(1, 0, At, B0, 1); PG8_PRIO(0); PG8_BAR; PG8_SCHED;
            if (!last) PG8_RDB(B0, 0, 0);
            PG8_STAGE(PG8_SB(1, 1), b3 + hsB, voffB);
            PG8_WAIT_V(10); PG8_BAR; if (!NARROW) PG8_MMA(1, 1, At, B1); PG8_BAR; PG8_SCHED;
        }
        E(acc, cur, wr, wc, fr, fq);
        if (!has_next) break;
#pragma unroll
        for (int a = 0; a < 2; ++a)
#pragma unroll
            for (int b = 0; b < 2; ++b)
#pragma unroll
                for (int m = 0; m < 4; ++m)
#pragma unroll
                    for (int n = 0; n < 2; ++n) acc[a][b][m][n] = (f32x4){0.f, 0.f, 0.f, 0.f};
        cur = nxt; cA = nA; cB = nB; ++ui;
        PG8_RDB(B0, 0, 0);
    }
    PG8_WAIT_V(0);
    if (wr == 0) PG8_BAR;
    PG8_BAR;
#undef PG8_SA
#undef PG8_SB
#undef PG8_STAGE
#undef PG8_LDA
#undef PG8_LDB
#undef PG8_MMA
#undef PG8_MMAK
#undef PG8_RDA
#undef PG8_RDB
#undef PG8_WAITA
#undef PG8_WAITB
#undef PG8_WAITAB
#undef PG8_PRIO
#undef PG8_WAIT_V
#undef PG8_WAIT_L
#undef PG8_BAR
#undef PG8_SCHED
}

typedef const f32x4 (&AccRef)[2][2][4][2];

struct EpiG1 {
    static constexpr bool PERM = true;
    bf16_t* zs; bf16_t* xbc; float* dtb; const float* dt_bias; int pn_off;
    __device__ __forceinline__ void operator()(AccRef acc, const Unit& u, int wr, int wc, int fr, int fq) const {
        const int row0 = u.pm * BM + wr * 64 + fr, pn = u.pn + pn_off;
        if (pn < 24) {
            const bool act = pn < 8;
            bf16_t* base = act ? zs : xbc; const int ld = act ? 2048 : 4096; const int colt = act ? pn * 256 : (pn - 8) * 256;
            const int col0 = colt + wc * 32 + 8 * fq;
#pragma unroll
            for (int ai = 0; ai < 2; ++ai)
#pragma unroll
                for (int m = 0; m < 4; ++m) { bf16_t* rowp = base + (size_t)(row0 + ai * HALF + m * 16) * ld + col0;
#pragma unroll
                    for (int bj = 0; bj < 2; ++bj) { f32x4 v0 = acc[ai][bj][m][0], v1 = acc[ai][bj][m][1];
                        if (act) {
#pragma unroll
                            for (int j = 0; j < 4; ++j) { v0[j] = siluf_(v0[j]); v1[j] = siluf_(v1[j]); } }
                        *(u32x4*)(rowp + bj * HALF) = pack8(v0, v1); } }
        } else if (wc == 0) {
            const int c0 = 8 * fq; const f32x4 b0 = *(const f32x4*)(dt_bias + c0), b1 = *(const f32x4*)(dt_bias + c0 + 4);
#pragma unroll
            for (int ai = 0; ai < 2; ++ai)
#pragma unroll
                for (int m = 0; m < 4; ++m) { float* rowp = dtb + (size_t)(row0 + ai * HALF + m * 16) * 32 + c0;
                    f32x4 v0 = acc[ai][0][m][0] + b0, v1 = acc[ai][0][m][1] + b1;
#pragma unroll
                    for (int j = 0; j < 4; ++j) { v0[j] = softplusf_(v0[j]); v1[j] = softplusf_(v1[j]); }
                    *(f32x4*)rowp = v0; *(f32x4*)(rowp + 4) = v1; }
        }
    }
};
struct EpiG2 {
    static constexpr bool PERM = true;
    bf16_t* upool; bf16_t* gates; const float* b_gates;
    __device__ __forceinline__ void operator()(AccRef acc, const Unit& u, int wr, int wc, int fr, int fq) const {
        const int row0 = u.pm * BM + wr * 64 + fr, pn = u.pn;
        const bool act = pn >= 4;
        bf16_t* base = act ? gates : upool; const int ld = act ? 2048 : 1024; const int colt = act ? (pn - 4) * 256 : pn * 256;
        const int col0 = colt + wc * 32 + 8 * fq;
        f32x4 bv[2][2];
#pragma unroll
        for (int bj = 0; bj < 2; ++bj)
#pragma unroll
            for (int n = 0; n < 2; ++n) bv[bj][n] = act ? *(const f32x4*)(b_gates + col0 + bj * HALF + 4 * n) : (f32x4){0.f, 0.f, 0.f, 0.f};
#pragma unroll
        for (int ai = 0; ai < 2; ++ai)
#pragma unroll
            for (int m = 0; m < 4; ++m) { bf16_t* rowp = base + (size_t)(row0 + ai * HALF + m * 16) * ld + col0;
#pragma unroll
                for (int bj = 0; bj < 2; ++bj) { f32x4 v0 = acc[ai][bj][m][0] + bv[bj][0], v1 = acc[ai][bj][m][1] + bv[bj][1];
                    if (act) {
#pragma unroll
                        for (int j = 0; j < 4; ++j) { v0[j] = sigmoidf_(v0[j]); v1[j] = sigmoidf_(v1[j]); } }
                    *(u32x4*)(rowp + bj * HALF) = pack8(v0, v1); } }
    }
};
template <bool FIRST> struct EpiPool {
    static constexpr bool PERM = true;
    bf16_t* merged; const bf16_t* gates;
    __device__ __forceinline__ void operator()(AccRef acc, const Unit& u, int wr, int wc, int fr, int fq) const {
        const int row0 = u.pm * BM + wr * 64 + fr; const int col0 = u.pn * 256 + wc * 32 + 8 * fq;
#pragma unroll
        for (int ai = 0; ai < 2; ++ai) {
            u32x4 gw[4][2], pw[4][2];
#pragma unroll
            for (int m = 0; m < 4; ++m)
#pragma unroll
                for (int bj = 0; bj < 2; ++bj) { const size_t row = (size_t)(row0 + ai * HALF + m * 16);
                    gw[m][bj] = *(const u32x4*)(gates + row * 2048 + col0 + bj * HALF); if (!FIRST) pw[m][bj] = *(const u32x4*)(merged + row * 1024 + col0 + bj * HALF); }
#pragma unroll
            for (int m = 0; m < 4; ++m) { const size_t row = (size_t)(row0 + ai * HALF + m * 16);
#pragma unroll
                for (int bj = 0; bj < 2; ++bj) { f32x4 g0, g1, p0 = {0.f, 0.f, 0.f, 0.f}, p1 = {0.f, 0.f, 0.f, 0.f}; unpack8(gw[m][bj], g0, g1); if (!FIRST) unpack8(pw[m][bj], p0, p1);
                    const f32x4 v0 = p0 + acc[ai][bj][m][0] * g0, v1 = p1 + acc[ai][bj][m][1] * g1;
                    *(u32x4*)(merged + row * 1024 + col0 + bj * HALF) = pack8(v0, v1); } }
            asm volatile("" ::: "memory");
        }
    }
};
template <bool FIRST> struct EpiSsd {
    static constexpr bool PERM = true;
    bf16_t* merged; const bf16_t* gates;
    __device__ __forceinline__ void operator()(AccRef acc, const Unit& u, int wr, int wc, int fr, int fq) const {
        const int row0 = u.pm * BM + wr * 64 + fr; const int col0 = u.pn * 256 + wc * 32 + 8 * fq;
#pragma unroll
        for (int ai = 0; ai < 2; ++ai) {
            u32x4 gw[4][2], pw[4][2];
#pragma unroll
            for (int m = 0; m < 4; ++m)
#pragma unroll
                for (int bj = 0; bj < 2; ++bj) { const size_t row = (size_t)(row0 + ai * HALF + m * 16);
                    gw[m][bj] = *(const u32x4*)(gates + row * 2048 + 1024 + col0 + bj * HALF); if (!FIRST) pw[m][bj] = *(const u32x4*)(merged + row * 1024 + col0 + bj * HALF); }
#pragma unroll
            for (int m = 0; m < 4; ++m) { const size_t row = (size_t)(row0 + ai * HALF + m * 16);
#pragma unroll
                for (int bj = 0; bj < 2; ++bj) { f32x4 g0, g1, p0 = {0.f, 0.f, 0.f, 0.f}, p1 = {0.f, 0.f, 0.f, 0.f}; unpack8(gw[m][bj], g0, g1); if (!FIRST) unpack8(pw[m][bj], p0, p1);
                    const f32x4 v0 = p0 + acc[ai][bj][m][0] * g0, v1 = p1 + acc[ai][bj][m][1] * g1;
                    *(u32x4*)(merged + row * 1024 + col0 + bj * HALF) = pack8(v0, v1); } }
            asm volatile("" ::: "memory");
        }
    }
};
struct EpiUp {
    static constexpr bool PERM = true;
    bf16_t* upb;
    __device__ __forceinline__ void operator()(AccRef acc, const Unit& u, int wr, int wc, int fr, int fq) const {
        const int row0 = u.pm * BM + wr * 64 + fr; const int col0 = u.pn * 256 + wc * 32 + 8 * fq;
#pragma unroll
        for (int ai = 0; ai < 2; ++ai)
#pragma unroll
            for (int m = 0; m < 4; ++m) { bf16_t* rowp = upb + (size_t)(row0 + ai * HALF + m * 16) * DFF + col0;
#pragma unroll
                for (int bj = 0; bj < 2; ++bj) { f32x4 v0 = acc[ai][bj][m][0], v1 = acc[ai][bj][m][1];
#pragma unroll
                    for (int j = 0; j < 4; ++j) { const float a = fmaxf(v0[j], 0.f), b = fmaxf(v1[j], 0.f); v0[j] = a * a; v1[j] = b * b; }
                    *(u32x4*)(rowp + bj * HALF) = pack8(v0, v1); } }
    }
};
struct EpiOut {
    static constexpr bool PERM = true;
    const float* x; bf16_t* v;
    __device__ __forceinline__ void operator()(AccRef acc, const Unit& u, int wr, int wc, int fr, int fq) const {
        const int row0 = u.pm * BM + wr * 64 + fr, col0 = u.pn * BM + wc * 32 + 8 * fq;
#pragma unroll
        for (int ai = 0; ai < 2; ++ai) {
            f32x4 xv[4][2][2];
#pragma unroll
            for (int m = 0; m < 4; ++m)
#pragma unroll
                for (int bj = 0; bj < 2; ++bj)
#pragma unroll
                    for (int n = 0; n < 2; ++n) xv[m][bj][n] = *(const f32x4*)(x + (size_t)(row0 + ai * HALF + m * 16) * DM + col0 + bj * HALF + n * 4);
#pragma unroll
            for (int m = 0; m < 4; ++m) { const size_t off = (size_t)(row0 + ai * HALF + m * 16) * DM + col0;
#pragma unroll
                for (int bj = 0; bj < 2; ++bj) *(u32x4*)(v + off + bj * HALF) = pack8(xv[m][bj][0] * ALPHA + acc[ai][bj][m][0], xv[m][bj][1] * ALPHA + acc[ai][bj][m][1]); }
            asm volatile("" ::: "memory");
        }
    }
};
struct EpiDown {
    static constexpr bool PERM = true;
    const bf16_t* h1b; bf16_t* y;
    __device__ __forceinline__ void operator()(AccRef acc, const Unit& u, int wr, int wc, int fr, int fq) const {
        const int row0 = u.pm * BM + wr * 64 + fr, col0 = u.pn * BM + wc * 32 + 8 * fq;
        u32x4 hw[2][4][2];
#pragma unroll
        for (int ai = 0; ai < 2; ++ai)
#pragma unroll
            for (int m = 0; m < 4; ++m)
#pragma unroll
                for (int bj = 0; bj < 2; ++bj) hw[ai][m][bj] = *(const u32x4*)(h1b + (size_t)(row0 + ai * HALF + m * 16) * DM + col0 + bj * HALF);
#pragma unroll
        for (int ai = 0; ai < 2; ++ai)
#pragma unroll
            for (int m = 0; m < 4; ++m) { const size_t off = (size_t)(row0 + ai * HALF + m * 16) * DM + col0;
#pragma unroll
                for (int bj = 0; bj < 2; ++bj) { f32x4 h0, h1; unpack8(hw[ai][m][bj], h0, h1);
                    *(u32x4*)(y + off + bj * HALF) = pack8(h0 * ALPHA + acc[ai][bj][m][0], h1 * ALPHA + acc[ai][bj][m][1]); } }
    }
};
}

struct TrJob { const float* src; int ld_src, col0, K, ncols, nvalid; bf16_t* dst; int ld_dst; const float* cscale; };
__device__ __forceinline__ int tr_tiles(int K, int ncols) { return (K / 64) * (ncols / 256); }
__device__ __forceinline__ bool tr_pick(const Params& p, int gt, TrJob& J, int& lt) {
    unsigned char* ws = p.ws; const float* w_in = p.in[1];
    bf16_t* win1 = (bf16_t*)(ws + WS_WIN1); bf16_t* win2 = (bf16_t*)(ws + WS_WIN2);
    int base = 0, n;
#define TRJ(SRC, LDS_, COL0, K_, NC, NV, DST, LDD, CS) do { n = tr_tiles((K_), (NC)); if (gt < base + n) { J.src = (SRC); J.ld_src = (LDS_); J.col0 = (COL0); J.K = (K_); J.ncols = (NC); J.nvalid = (NV); J.dst = (DST); J.ld_dst = (LDD); J.cscale = (CS); lt = gt - base; return true; } base += n; } while (0)
    TRJ(w_in, 9248, 3072, 1024, 4096, 4096, win1 + (size_t)2048 * 1024, 1024, nullptr);
    TRJ(p.in[15], 4096, 0, 1024, 4096, 4096, (bf16_t*)(ws + WS_WUP), 1024, nullptr);
    TRJ(p.in[16], 1024, 0, 4096, 1024, 1024, (bf16_t*)(ws + WS_WDN), 4096, nullptr);
    TRJ(w_in, 9248, 1024, 1024, 2048, 2048, win1, 1024, nullptr);
    TRJ(w_in, 9248, 7200, 1024, 2048, 2048, win2 + (size_t)1024 * 1024, 1024, nullptr);
    TRJ(p.in[9], 1024, 0, 2048, 1024, 1024, (bf16_t*)(ws + WS_WSSD), 2048, nullptr);
    TRJ(w_in, 9248, 0, 1024, 1024, 1024, win2, 1024, nullptr);
    TRJ(p.in[12], 1024, 0, 1024, 1024, 1024, (bf16_t*)(ws + WS_WOUT), 1024, nullptr);
    TRJ(w_in, 9248, 7168, 1024, 256, 32, win1 + (size_t)6144 * 1024, 1024, nullptr);
    TRJ(p.in[10], 256, 0, 256, 256, 256, (bf16_t*)(ws + WS_WP), 256, p.in[11]);
    TRJ(p.in[10] + 65536, 256, 0, 256, 256, 256, (bf16_t*)(ws + WS_WP) + 65536, 256, p.in[11] + 256);
    TRJ(p.in[10] + 2 * 65536, 256, 0, 256, 256, 256, (bf16_t*)(ws + WS_WP) + 2 * 65536, 256, p.in[11] + 512);
    TRJ(p.in[10] + 3 * 65536, 256, 0, 256, 256, 256, (bf16_t*)(ws + WS_WP) + 3 * 65536, 256, p.in[11] + 768);
#undef TRJ
    return false;
}
__device__ void phase0(const Params& p, unsigned char* smem) {
    unsigned char* ws = p.ws;
    { const float* __restrict__ x = p.in[0]; bf16_t* __restrict__ xb = (bf16_t*)(ws + WS_RC);
      const size_t nvec = (size_t)T_TOK * DM / 8, stride = (size_t)gridDim.x * blockDim.x;
      for (size_t i = (size_t)blockIdx.x * blockDim.x + threadIdx.x; i < nvec; i += 4 * stride) {
          f32x4 a[4], b[4];
#pragma unroll
          for (int k = 0; k < 4; ++k) { a[k] = *(const f32x4*)(x + (i + k * stride) * 8); b[k] = *(const f32x4*)(x + (i + k * stride) * 8 + 4); }
#pragma unroll
          for (int k = 0; k < 4; ++k) *(u32x4*)(xb + (i + k * stride) * 8) = pack8(a[k], b[k]); } }
    float* t = (float*)smem;
    const int tid = threadIdx.x;
    for (int gt = blockIdx.x; ; gt += gridDim.x) {
        TrJob J; int lt;
        if (!tr_pick(p, gt, J, lt)) break;
        const int tn = J.ncols / 256; const int k0 = (lt / tn) * 64, n0 = (lt % tn) * 256;
        __syncthreads();
        float v[4][8];
#pragma unroll
        for (int sb = 0; sb < 4; ++sb)
#pragma unroll
            for (int i = 0; i < 8; ++i) { const int k = (tid >> 6) + 8 * i, n = n0 + sb * 64 + (tid & 63); const int nc = n < J.nvalid ? n : 0;
                const float ld = J.src[(size_t)(k0 + k) * J.ld_src + J.col0 + nc]; v[sb][i] = n < J.nvalid ? ld : 0.f; }
#pragma unroll
        for (int sb = 0; sb < 4; ++sb) { const float sc = J.cscale ? J.cscale[n0 + sb * 64 + (tid & 63)] : 1.0f;
#pragma unroll
            for (int i = 0; i < 8; ++i) t[(sb * 64 + (tid >> 6) + 8 * i) * 65 + (tid & 63)] = v[sb][i] * sc; }
        __syncthreads();
        const int n = tid >> 3, kk = (tid & 7) * 8;
#pragma unroll
        for (int sb = 0; sb < 4; ++sb) { float e[8];
#pragma unroll
            for (int j = 0; j < 8; ++j) e[j] = t[(sb * 64 + kk + j) * 65 + n];
            u32x4 w; w.x = cvt_pk_bf16(e[0], e[1]); w.y = cvt_pk_bf16(e[2], e[3]); w.z = cvt_pk_bf16(e[4], e[5]); w.w = cvt_pk_bf16(e[6], e[7]);
            *(u32x4*)(J.dst + (size_t)(n0 + sb * 64 + n) * J.ld_dst + k0 + kk) = w; }
    }
}

__device__ void phase_ssd_simple(const Params& p, unsigned char* smem) {
    unsigned char* ws = p.ws;
    const bf16_t* xbc = (const bf16_t*)(ws + WS_RA); bf16_t* zy = (bf16_t*)(ws + WS_RB); const float* dtb = (const float*)(ws + WS_DT);
    const float* conv_w = p.in[3]; const float* conv_b = p.in[4]; const float* a_log = p.in[6]; const float* d_skip = p.in[7]; const float* norm_w = p.in[8];
    float* sX = (float*)smem;
    float* sY = sX + 16 * 512;
    float* sdt = sY + 16 * 256;
    const int tid = threadIdx.x;
    for (int item = blockIdx.x; item < 256; item += gridDim.x) {
        const int b = item >> 3, g = item & 7;
        const int ch = tid; int gcol;
        if (ch < 256) gcol = g * 256 + ch; else if (ch < 384) gcol = 2048 + g * 128 + (ch - 256); else gcol = 3072 + g * 128 + (ch - 384);
        const float cw0 = conv_w[gcol], cw1 = conv_w[4096 + gcol], cw2 = conv_w[8192 + gcol], cw3 = conv_w[12288 + gcol], cb = conv_b[gcol];
        float u1 = 0.f, u2 = 0.f, u3 = 0.f;
        const int r = tid >> 7, pp = (tid & 127) >> 1, nh = tid & 1;
        const float a_r = -__expf(a_log[g * 4 + r]), d_r = d_skip[g * 4 + r];
        float hst[64];
#pragma unroll
        for (int i = 0; i < 64; ++i) hst[i] = 0.f;
        for (int blk = 0; blk < SEQ / 16; ++blk) {
            const size_t t0 = (size_t)b * SEQ + (size_t)blk * 16;
#pragma unroll 4
            for (int tt = 0; tt < 16; ++tt) { const float raw = bf2f(xbc[(t0 + tt) * 4096 + gcol]);
                const float y = cb + cw0 * u1 + cw1 * u2 + cw2 * u3 + cw3 * raw; u1 = u2; u2 = u3; u3 = raw;
                sX[tt * 512 + ch] = siluf_(y); }
            if (tid < 64) sdt[tid] = dtb[(t0 + (tid >> 2)) * 32 + g * 4 + (tid & 3)];
            __syncthreads();
            for (int tt = 0; tt < 16; ++tt) {
                const float dt = sdt[tt * 4 + r], dec = __expf(dt * a_r), xv = sX[tt * 512 + r * 64 + pp], xdt = xv * dt;
                const float* Bp = sX + tt * 512 + 256 + nh * 64; const float* Cp = sX + tt * 512 + 384 + nh * 64;
                float y = 0.f;
#pragma unroll
                for (int i = 0; i < 64; ++i) { hst[i] = hst[i] * dec + xdt * Bp[i]; y += hst[i] * Cp[i]; }
                y += __shfl_xor(y, 1);
                if (nh == 0) { const float zv = bf2f(zy[(t0 + tt) * 2048 + g * 256 + r * 64 + pp]); sY[tt * 256 + r * 64 + pp] = (y + d_r * xv) * zv; }
            }
            __syncthreads();
            { const int tt = tid >> 5, c0 = (tid & 31) * 8; float e[8]; float ss = 0.f;
#pragma unroll
              for (int j = 0; j < 8; ++j) { e[j] = sY[tt * 256 + c0 + j]; ss += e[j] * e[j]; }
              ss += __shfl_xor(ss, 16); ss += __shfl_xor(ss, 8); ss += __shfl_xor(ss, 4); ss += __shfl_xor(ss, 2); ss += __shfl_xor(ss, 1);
              const float rstd = rsqrtf(ss * (1.0f / 256.0f) + RMS_EPS);
              const f32x4 w0 = *(const f32x4*)(norm_w + g * 256 + c0), w1 = *(const f32x4*)(norm_w + g * 256 + c0 + 4);
              u32x4 o; o.x = cvt_pk_bf16(e[0] * rstd * w0[0], e[1] * rstd * w0[1]); o.y = cvt_pk_bf16(e[2] * rstd * w0[2], e[3] * rstd * w0[3]);
              o.z = cvt_pk_bf16(e[4] * rstd * w1[0], e[5] * rstd * w1[1]); o.w = cvt_pk_bf16(e[6] * rstd * w1[2], e[7] * rstd * w1[3]);
              *(u32x4*)(zy + (t0 + tt) * 2048 + g * 256 + c0) = o; }
            __syncthreads();
        }
    }
}


constexpr int SX_STR = 144, SN_STR = 272, SZ_STR = 528;
constexpr int O_XT = 0;
constexpr int O_BT = O_XT + 256 * SX_STR;
constexpr int O_BN = O_BT + 128 * SX_STR;
constexpr int O_CN = O_BN + 64 * SN_STR;
constexpr int O_CB = O_CN + 64 * SN_STR;
constexpr int O_ZT = O_CB + 64 * SN_STR;
constexpr int O_ACS = O_ZT + 64 * SZ_STR;
constexpr int O_DT = O_ACS + 1024;
constexpr int O_WG = O_DT + 1024;
constexpr int O_EA = O_WG + 1024;
constexpr int O_SSQ = O_EA + 1024;
constexpr int O_RSTD = O_SSQ + 2048;
constexpr int O_CW = O_RSTD + 256;
constexpr int O_RSW = O_CW + 5 * 512 * 4;
constexpr int SSD_LDS = O_RSW + 2048;
static_assert(SSD_LDS <= LDS_BYTES, "LDS");
#define MFMA16(a, b, c) __builtin_amdgcn_mfma_f32_16x16x32_bf16((a), (b), (c), 0, 0, 0)

template <int CTRL> __device__ __forceinline__ float dpp_add(float v) { return v + __builtin_bit_cast(float, __builtin_amdgcn_update_dpp(0, __builtin_bit_cast(int, v), CTRL, 0xf, 0xf, false)); }
__device__ __forceinline__ float row16_sum(float v) { v = dpp_add<0xB1>(v); v = dpp_add<0x4E>(v); v = dpp_add<0x124>(v); v = dpp_add<0x128>(v); return v; }
__device__ __forceinline__ f32x4 unpack4(u32x2 w) { return (f32x4){bf_lo(w.x), bf_hi(w.x), bf_lo(w.y), bf_hi(w.y)}; }

__device__ void phase_ssd(const Params& p, LAS unsigned char* sm) {
    unsigned char* ws = p.ws;
    const bf16_t* xbc = (const bf16_t*)(ws + WS_RA); bf16_t* zy = (bf16_t*)(ws + WS_RB); const float* dtb = (const float*)(ws + WS_DT);
    const float* conv_w = p.in[3]; const float* conv_b = p.in[4]; const float* a_log = p.in[6]; const float* d_skip = p.in[7]; const float* norm_w = p.in[8];
    const int tid = threadIdx.x, lane = tid & 63, w = __builtin_amdgcn_readfirstlane(tid >> 6), c = lane & 15, q = lane >> 4;
    const int r = w >> 1, ph = w & 1;
    const int tq = tid >> 7, ch0 = (tid & 127) * 4;
    LAS float* ACS = (LAS float*)(sm + O_ACS); LAS float* DTV = (LAS float*)(sm + O_DT); LAS float* WG = (LAS float*)(sm + O_WG); LAS float* EA = (LAS float*)(sm + O_EA);
    LAS float* SSQ = (LAS float*)(sm + O_SSQ); LAS float* RSTD = (LAS float*)(sm + O_RSTD);
    for (int item = blockIdx.x; item < 256; item += gridDim.x) {
        const int b = item >> 3, g = item & 7;
#define SSD_GCOL(CH) ((CH) < 256 ? g * 256 + (CH) : ((CH) < 384 ? 1792 + g * 128 + (CH) : 2688 + g * 128 + (CH)))
        { const int gcol = SSD_GCOL(ch0);
        __syncthreads();
        if (tq == 0) {
#pragma unroll
            for (int k = 0; k < 4; ++k) *(LAS f32x4*)(sm + O_CW + (k * 512 + ch0) * 4) = *(const f32x4*)(conv_w + k * 4096 + gcol);
            *(LAS f32x4*)(sm + O_CW + (4 * 512 + ch0) * 4) = *(const f32x4*)(conv_b + gcol); }
        __syncthreads(); }
        const float d_r = d_skip[g * 4 + r];
        const float a_w = -__expf(a_log[g * 4 + (w & 3)]);
        const int prow0 = r * 64 + ph * 32 + c;
        const float nw0 = norm_w[g * 256 + prow0], nw1 = norm_w[g * 256 + prow0 + 16];
        f32x4 accH[8][2];
#pragma unroll
        for (int nt = 0; nt < 8; ++nt)
#pragma unroll
            for (int pt = 0; pt < 2; ++pt) accH[nt][pt] = (f32x4){0.f, 0.f, 0.f, 0.f};
        u32x2 raw[19]; u32x4 zr[4]; float dtn = 0.f;
#define SSD_ISSUE(SUBN) do { int sn_ = (SUBN); asm volatile("" : "+s"(sn_)); int tid_ = tid; asm volatile("" : "+v"(tid_)); const int ch_ = (tid_ & 127) * 4; const int gc_ = SSD_GCOL(ch_); \
            const int sl0_ = sn_ * 64 + (tid_ >> 7) * 16 - 3; const bf16_t* rp_ = xbc + ((size_t)b * SEQ + (sl0_ < 0 ? 0 : sl0_)) * 4096 + gc_; \
            _Pragma("unroll") for (int i = 0; i < 19; ++i) { const int sl = sl0_ + i; \
                const u32x2 v = *(const u32x2*)(rp_ + (sl0_ < 0 ? (i < 3 ? 0 : i - 3) : i) * 4096); raw[i].x = sl < 0 ? 0u : v.x; raw[i].y = sl < 0 ? 0u : v.y; } \
            const bf16_t* zp_ = zy + ((size_t)b * SEQ + (size_t)sn_ * 64 + (tid_ >> 5)) * 2048 + g * 256 + (tid_ & 31) * 8; \
            _Pragma("unroll") for (int k = 0; k < 4; ++k) zr[k] = *(const u32x4*)(zp_ + (size_t)k * 16 * 2048); \
            if (w < 4) dtn = dtb[((size_t)b * SEQ + (size_t)sn_ * 64 + lane) * 32 + g * 4 + w]; } while (0)
        SSD_ISSUE(0);
#pragma unroll 1
        for (int sub = 0; sub < SEQ / 64; ++sub) {
            const size_t t0 = (size_t)b * SEQ + (size_t)sub * 64;
            {
                const f32x4 cw0 = *(const LAS f32x4*)(sm + O_CW + ch0 * 4), cw1 = *(const LAS f32x4*)(sm + O_CW + (512 + ch0) * 4), cw2 = *(const LAS f32x4*)(sm + O_CW + (1024 + ch0) * 4),
                            cw3 = *(const LAS f32x4*)(sm + O_CW + (1536 + ch0) * 4), cbv = *(const LAS f32x4*)(sm + O_CW + (2048 + ch0) * 4);
                f32x4 u0 = unpack4(raw[0]), u1 = unpack4(raw[1]), u2 = unpack4(raw[2]);
                unsigned tr[4][8]; f32x4 pv = {0.f, 0.f, 0.f, 0.f};
                LAS unsigned char* nb = ch0 < 384 ? sm + O_BN + (ch0 - 256) * 2 : sm + O_CN + (ch0 - 384) * 2;
#pragma unroll
                for (int i = 0; i < 16; ++i) {
                    const f32x4 u3 = unpack4(raw[i + 3]);
                    f32x4 y = cbv + cw0 * u0 + cw1 * u1 + cw2 * u2 + cw3 * u3;
#pragma unroll
                    for (int j = 0; j < 4; ++j) y[j] = siluf_(y[j]);
                    if (ch0 >= 256) *(LAS u32x2*)(nb + (tq * 16 + i) * SN_STR) = (u32x2){cvt_pk_bf16(y[0], y[1]), cvt_pk_bf16(y[2], y[3])};
                    if (i & 1) {
#pragma unroll
                        for (int j = 0; j < 4; ++j) tr[j][i >> 1] = cvt_pk_bf16(pv[j], y[j]); }
                    else pv = y;
                    u0 = u1; u1 = u2; u2 = u3;
                }
                if (ch0 < 384) {
                    LAS unsigned char* tb = ch0 < 256 ? sm + O_XT + ch0 * SX_STR : sm + O_BT + (ch0 - 256) * SX_STR;
#pragma unroll
                    for (int j = 0; j < 4; ++j) { *(LAS u32x4*)(tb + j * SX_STR + tq * 32) = (u32x4){tr[j][0], tr[j][1], tr[j][2], tr[j][3]};
                        *(LAS u32x4*)(tb + j * SX_STR + tq * 32 + 16) = (u32x4){tr[j][4], tr[j][5], tr[j][6], tr[j][7]}; }
                }
            }
            if (w < 4) {
                const float dt = dtn; float x = dt * a_w;
#pragma unroll
                for (int o = 1; o < 64; o <<= 1) { const float v = __shfl_up(x, o); if (lane >= o) x += v; }
                const float last = __shfl(x, 63);
                ACS[w * 64 + lane] = x; DTV[w * 64 + lane] = dt; WG[w * 64 + lane] = dt * __expf(last - x); EA[w * 64 + lane] = __expf(x);
            }
            __syncthreads();
            {
#pragma unroll
                for (int k = 0; k < 4; ++k) { const int v = tid + 512 * k, l = v >> 5, c8 = (v & 31) * 8; *(LAS u32x4*)(sm + O_ZT + l * SZ_STR + c8 * 2) = zr[k]; }
                const int lt = w >> 1;
#pragma unroll
                for (int sti = 0; sti < 2; ++sti) { const int st = 2 * (w & 1) + sti; f32x4 acc = {0.f, 0.f, 0.f, 0.f};
#pragma unroll
                    for (int ks = 0; ks < 4; ++ks) { const bf16x8 a = *(const LAS bf16x8*)(sm + O_CN + (16 * lt + c) * SN_STR + (32 * ks + 8 * q) * 2);
                        const bf16x8 bb = *(const LAS bf16x8*)(sm + O_BN + (16 * st + c) * SN_STR + (32 * ks + 8 * q) * 2); acc = MFMA16(a, bb, acc); }
#pragma unroll
                    for (int rg = 0; rg < 4; ++rg) *(LAS float*)(sm + O_CB + (16 * lt + 4 * q + rg) * SN_STR + (16 * st + c) * 4) = acc[rg]; }
            }
            __syncthreads();
            f32x4 accY[4][2];
#pragma unroll
            for (int lt = 0; lt < 4; ++lt)
#pragma unroll
                for (int pt = 0; pt < 2; ++pt) accY[lt][pt] = (f32x4){0.f, 0.f, 0.f, 0.f};
#pragma unroll
            for (int ks = 0; ks < 4; ++ks) {
                bf16x8 hb[2];
#pragma unroll
                for (int pt = 0; pt < 2; ++pt) hb[pt] = __builtin_bit_cast(bf16x8, pack8(accH[2 * ks][pt], accH[2 * ks + 1][pt]));
#pragma unroll
                for (int lt = 0; lt < 4; ++lt) { const LAS unsigned char* cp = sm + O_CN + (16 * lt + c) * SN_STR + (32 * ks + 4 * q) * 2;
                    const u32x2 lo = *(const LAS u32x2*)cp, hi = *(const LAS u32x2*)(cp + 32);
                    const bf16x8 a = __builtin_bit_cast(bf16x8, (u32x4){lo.x, lo.y, hi.x, hi.y});
#pragma unroll
                    for (int pt = 0; pt < 2; ++pt) accY[lt][pt] = MFMA16(a, hb[pt], accY[lt][pt]); }
            }
#pragma unroll
            for (int lt = 0; lt < 4; ++lt) { const f32x4 e = *(const LAS f32x4*)(EA + r * 64 + 16 * lt + 4 * q);
#pragma unroll
                for (int pt = 0; pt < 2; ++pt) accY[lt][pt] *= e; }
            bf16x8 xf[2][2];
#pragma unroll
            for (int ks = 0; ks < 2; ++ks)
#pragma unroll
                for (int pt = 0; pt < 2; ++pt) xf[ks][pt] = *(const LAS bf16x8*)(sm + O_XT + (prow0 + 16 * pt) * SX_STR + (32 * ks + 8 * q) * 2);
#pragma unroll
            for (int lt = 0; lt < 4; ++lt)
#pragma unroll
                for (int ks = 0; ks < 2; ++ks) {
                    if (ks == 1 && lt < 2) continue;
                    const int l = 16 * lt + c; const float acl = ACS[r * 64 + l];
                    const LAS float* cbp = (const LAS float*)(sm + O_CB + l * SN_STR) + 32 * ks + 8 * q;
                    const f32x4 cb0 = *(const LAS f32x4*)cbp, cb1 = *(const LAS f32x4*)(cbp + 4);
                    const f32x4 as0 = *(const LAS f32x4*)(ACS + r * 64 + 32 * ks + 8 * q), as1 = *(const LAS f32x4*)(ACS + r * 64 + 32 * ks + 8 * q + 4);
                    const f32x4 d0 = *(const LAS f32x4*)(DTV + r * 64 + 32 * ks + 8 * q), d1 = *(const LAS f32x4*)(DTV + r * 64 + 32 * ks + 8 * q + 4);
                    f32x4 m0, m1;
#pragma unroll
                    for (int j = 0; j < 4; ++j) { const int s0 = 32 * ks + 8 * q + j, s1 = s0 + 4;
                        m0[j] = (s0 <= l) ? cb0[j] * __expf(acl - as0[j]) * d0[j] : 0.f;
                        m1[j] = (s1 <= l) ? cb1[j] * __expf(acl - as1[j]) * d1[j] : 0.f; }
                    const bf16x8 mf = __builtin_bit_cast(bf16x8, pack8(m0, m1));
#pragma unroll
                    for (int pt = 0; pt < 2; ++pt) accY[lt][pt] = MFMA16(mf, xf[ks][pt], accY[lt][pt]);
                }
#pragma unroll
            for (int lt = 0; lt < 4; ++lt) {
#pragma unroll
                for (int pt = 0; pt < 2; ++pt) { const int prow = prow0 + 16 * pt;
                    const f32x4 xv = unpack4(*(const LAS u32x2*)(sm + O_XT + prow * SX_STR + (16 * lt + 4 * q) * 2));
#pragma unroll
                    for (int rg = 0; rg < 4; ++rg) { const int l = 16 * lt + 4 * q + rg; const float zv = bf2f(*(const LAS bf16_t*)(sm + O_ZT + l * SZ_STR + prow * 2));
                        accY[lt][pt][rg] = (accY[lt][pt][rg] + d_r * xv[rg]) * zv; } }
                f32x4 sv;
#pragma unroll
                for (int rg = 0; rg < 4; ++rg) sv[rg] = row16_sum(accY[lt][0][rg] * accY[lt][0][rg] + accY[lt][1][rg] * accY[lt][1][rg]);
                if (c == 0) *(LAS f32x4*)(SSQ + w * 64 + 16 * lt + 4 * q) = sv;
            }
            {
                const float dec = __expf(ACS[r * 64 + 63]);
#pragma unroll
                for (int nt = 0; nt < 8; ++nt)
#pragma unroll
                    for (int pt = 0; pt < 2; ++pt) accH[nt][pt] *= dec;
                bf16x8 xw[2][2];
#pragma unroll
                for (int ks = 0; ks < 2; ++ks) { const f32x4 w0 = *(const LAS f32x4*)(WG + r * 64 + 32 * ks + 8 * q), w1 = *(const LAS f32x4*)(WG + r * 64 + 32 * ks + 8 * q + 4);
#pragma unroll
                    for (int pt = 0; pt < 2; ++pt) { f32x4 a, bq; unpack8(__builtin_bit_cast(u32x4, xf[ks][pt]), a, bq); xw[ks][pt] = __builtin_bit_cast(bf16x8, pack8(a * w0, bq * w1)); } }
#pragma unroll
                for (int nt = 0; nt < 8; ++nt)
#pragma unroll
                    for (int ks = 0; ks < 2; ++ks) { const bf16x8 bfr = *(const LAS bf16x8*)(sm + O_BT + (16 * nt + c) * SX_STR + (32 * ks + 8 * q) * 2);
#pragma unroll
                        for (int pt = 0; pt < 2; ++pt) accH[nt][pt] = MFMA16(bfr, xw[ks][pt], accH[nt][pt]); }
            }
            SSD_ISSUE(sub + 1 < SEQ / 64 ? sub + 1 : sub);
            __syncthreads();
            { float s = 0.f;
#pragma unroll
              for (int k = 0; k < 8; ++k) s += SSQ[k * 64 + lane];
              LAS float* RSW = (LAS float*)(sm + O_RSW) + w * 64;
              RSW[lane] = rsqrtf(s * (1.0f / 256.0f) + RMS_EPS);
#pragma unroll
              for (int lt = 0; lt < 4; ++lt) { const f32x4 rs = *(const LAS f32x4*)(RSW + 16 * lt + 4 * q);
#pragma unroll
                for (int pt = 0; pt < 2; ++pt) { const float nw = pt ? nw1 : nw0;
#pragma unroll
                    for (int rg = 0; rg < 4; ++rg) { const int l = 16 * lt + 4 * q + rg;
                        *(LAS bf16_t*)(sm + O_ZT + l * SZ_STR + (prow0 + 16 * pt) * 2) = (bf16_t)(cvt_pk_bf16(accY[lt][pt][rg] * rs[rg] * nw, 0.f) & 0xffffu); } } }
#pragma unroll
              for (int k = 0; k < 4; ++k) { const int row = (lane >> 2) + 16 * k, pc = lane & 3;
                *(u32x4*)(zy + (t0 + row) * 2048 + g * 256 + r * 64 + ph * 32 + pc * 8) = *(const LAS u32x4*)(sm + O_ZT + row * SZ_STR + (r * 64 + ph * 32 + pc * 8) * 2); }
            }
        }
    }
}

template <int W, int RUN = 16>
__device__ __forceinline__ void pool_task(const bf16_t* __restrict__ colp, bf16_t* __restrict__ outp, int t0, int s0) {
    constexpr int H = W - 1;
    u32x4 rw[RUN + H];
#pragma unroll
    for (int j = 0; j < RUN + H; ++j) { int tt = t0 - H + j; tt = tt < 0 ? 0 : tt; rw[j] = *(const u32x4*)(colp + (size_t)tt * 1024); }
    f32x4 S0 = {0.f, 0.f, 0.f, 0.f}, S1 = {0.f, 0.f, 0.f, 0.f};
#pragma unroll
    for (int j = 1; j <= H; ++j) { f32x4 a, b; unpack8(rw[H - j], a, b); const bool ok = (s0 - j >= 0); S0 += ok ? a : (f32x4){0.f, 0.f, 0.f, 0.f}; S1 += ok ? b : (f32x4){0.f, 0.f, 0.f, 0.f}; }
#pragma unroll
    for (int tt = 0; tt < RUN; ++tt) { const int s = s0 + tt;
        f32x4 a, b; unpack8(rw[H + tt], a, b); S0 += a; S1 += b;
        const float inv = 1.0f / (float)(s + 1 < W ? s + 1 : W);
        *(u32x4*)(outp + (size_t)(t0 + tt) * 1024) = pack8(S0 * inv - a, S1 * inv - b);
        f32x4 c, d; unpack8(rw[tt], c, d);
        if (s - W + 1 >= 0) { S0 -= c; S1 -= d; } }
}
__device__ __forceinline__ void pool_tile(const Params& p, int pm, int g) {
    const bf16_t* up = (const bf16_t*)(p.ws + WS_RA); bf16_t* pooled = (bf16_t*)(p.ws + WS_RA + 384 * MiB);
    int tl = threadIdx.x; asm volatile("" : "+v"(tl));
    const int vec = g * 32 + (tl & 31), run = tl >> 5;
    const int t0 = pm * 256 + run * 16, s0 = t0 & (SEQ - 1);
    const bf16_t* colp = up + vec * 8; bf16_t* outp = pooled + vec * 8;
    if (g == 0) pool_task<2>(colp, outp, t0, s0); else if (g == 1) pool_task<4>(colp, outp, t0, s0);
    else if (g == 2) pool_task<8>(colp, outp, t0, s0); else { pool_task<16, 8>(colp, outp, t0, s0); pool_task<16, 8>(colp, outp, t0 + 8, s0 + 8); }
}

template <bool OUT_BF16>
__device__ void phase_ln(const bf16_t* __restrict__ src, void* __restrict__ dst, const float* __restrict__ gam, const float* __restrict__ bet) {
    const int lane = threadIdx.x & 63, wv = threadIdx.x >> 6;
    f32x4 gv[4], bv[4];
#pragma unroll
    for (int i = 0; i < 2; ++i) { gv[2 * i] = *(const f32x4*)(gam + lane * 8 + 512 * i); gv[2 * i + 1] = *(const f32x4*)(gam + lane * 8 + 512 * i + 4);
        bv[2 * i] = *(const f32x4*)(bet + lane * 8 + 512 * i); bv[2 * i + 1] = *(const f32x4*)(bet + lane * 8 + 512 * i + 4); }
    for (int row0 = (blockIdx.x * 8 + wv) * 4; row0 < T_TOK; row0 += gridDim.x * 8 * 4) {
        u32x4 rw[4][2];
#pragma unroll
        for (int rr = 0; rr < 4; ++rr)
#pragma unroll
            for (int i = 0; i < 2; ++i) rw[rr][i] = *(const u32x4*)(src + (size_t)(row0 + rr) * DM + lane * 8 + 512 * i);
#pragma unroll
        for (int rr = 0; rr < 4; ++rr) {
            f32x4 v[4]; unpack8(rw[rr][0], v[0], v[1]); unpack8(rw[rr][1], v[2], v[3]);
            float s = 0.f;
#pragma unroll
            for (int i = 0; i < 4; ++i) s += (v[i][0] + v[i][1]) + (v[i][2] + v[i][3]);
#pragma unroll
            for (int o = 32; o >= 1; o >>= 1) s += __shfl_xor(s, o);
            const float mu = s * (1.0f / 1024.0f); float q = 0.f;
#pragma unroll
            for (int i = 0; i < 4; ++i) { v[i] -= mu; q += (v[i][0] * v[i][0] + v[i][1] * v[i][1]) + (v[i][2] * v[i][2] + v[i][3] * v[i][3]); }
#pragma unroll
            for (int o = 32; o >= 1; o >>= 1) q += __shfl_xor(q, o);
            const float rstd = rsqrtf(q * (1.0f / 1024.0f) + LN_EPS);
#pragma unroll
            for (int i = 0; i < 2; ++i) { const f32x4 o0 = v[2 * i] * rstd * gv[2 * i] + bv[2 * i], o1 = v[2 * i + 1] * rstd * gv[2 * i + 1] + bv[2 * i + 1];
                if (OUT_BF16) *(u32x4*)((bf16_t*)dst + (size_t)(row0 + rr) * DM + lane * 8 + 512 * i) = pack8(o0, o1);
                else { float* op = (float*)dst + (size_t)(row0 + rr) * DM + lane * 8 + 512 * i; *(f32x4*)op = o0; *(f32x4*)(op + 4) = o1; } }
        }
    }
}

__device__ __forceinline__ void ln_panel_bf16(const bf16_t* __restrict__ src, bf16_t* __restrict__ dst, const float* __restrict__ gam, const float* __restrict__ bet, int r0) {
    int tl = threadIdx.x; asm volatile("" : "+v"(tl));
    const int lane = tl & 63, wv = tl >> 6;
    f32x4 gv[4], bv[4];
#pragma unroll
    for (int i = 0; i < 2; ++i) { gv[2 * i] = *(const f32x4*)(gam + lane * 8 + 512 * i); gv[2 * i + 1] = *(const f32x4*)(gam + lane * 8 + 512 * i + 4);
        bv[2 * i] = *(const f32x4*)(bet + lane * 8 + 512 * i); bv[2 * i + 1] = *(const f32x4*)(bet + lane * 8 + 512 * i + 4); }
#pragma unroll 1
    for (int k = 0; k < 8; ++k) { const int row0 = r0 + wv * 32 + k * 4;
        u32x4 rw[4][2];
#pragma unroll
        for (int rr = 0; rr < 4; ++rr)
#pragma unroll
            for (int i = 0; i < 2; ++i) rw[rr][i] = *(const u32x4*)(src + (size_t)(row0 + rr) * DM + lane * 8 + 512 * i);
#pragma unroll
        for (int rr = 0; rr < 4; ++rr) {
            f32x4 v[4]; unpack8(rw[rr][0], v[0], v[1]); unpack8(rw[rr][1], v[2], v[3]);
            float sm = 0.f;
#pragma unroll
            for (int i = 0; i < 4; ++i) sm += (v[i][0] + v[i][1]) + (v[i][2] + v[i][3]);
#pragma unroll
            for (int o = 32; o >= 1; o >>= 1) sm += __shfl_xor(sm, o);
            const float mu = sm * (1.0f / 1024.0f); float q = 0.f;
#pragma unroll
            for (int i = 0; i < 4; ++i) { v[i] -= mu; q += (v[i][0] * v[i][0] + v[i][1] * v[i][1]) + (v[i][2] * v[i][2] + v[i][3] * v[i][3]); }
#pragma unroll
            for (int o = 32; o >= 1; o >>= 1) q += __shfl_xor(q, o);
            const float rstd = rsqrtf(q * (1.0f / 1024.0f) + LN_EPS);
#pragma unroll
            for (int i = 0; i < 2; ++i) *(u32x4*)(dst + (size_t)(row0 + rr) * DM + lane * 8 + 512 * i) = pack8(v[2 * i] * rstd * gv[2 * i] + bv[2 * i], v[2 * i + 1] * rstd * gv[2 * i + 1] + bv[2 * i + 1]);
        }
    }
}

__global__ void __launch_bounds__(512, 2) mega(Params p) {
    extern __shared__ __attribute__((aligned(16))) unsigned char lds_raw[];
    LAS unsigned char* lds = (LAS unsigned char*)lds_raw;
    cg::grid_group grid = cg::this_grid();
    unsigned char* ws = p.ws;
    const int G = gridDim.x, c = blockIdx.x;
#ifndef PHMASK
#define PHMASK 0x7ff
#endif
#define IN(k) (((PHMASK >> (k)) & 1) && p.ph_lo <= (k) && (k) < p.ph_hi)
#define SEAM(k) do { if (IN(k) && IN((k) + 1)) grid.sync(); } while (0)
    if (IN(0)) phase0(p, lds_raw);
    SEAM(0);
    if (IN(1)) {
        { pg8::Gemm g{(const bf16_t*)(ws + WS_RC), (const bf16_t*)(ws + WS_WIN1), T_TOK, N1 - 256, 1024, 1024, 1024, 0};
          pg8::StaticOrder S; S.init(T_TOK, N1 - 256, G, c);
          pg8::EpiG1 E{(bf16_t*)(ws + WS_RB), (bf16_t*)(ws + WS_RA), (float*)(ws + WS_DT), p.in[5], 0};
          pg8::gemm_phase<pg8::EpiG1>(lds, g, S, E); }
        { pg8::Gemm g{(const bf16_t*)(ws + WS_RC), (const bf16_t*)(ws + WS_WIN1) + (size_t)(N1 - 256) * 1024, T_TOK, 256, 1024, 1024, 1024, 0};
          pg8::StaticOrder S; S.init(T_TOK, 256, G, c);
          pg8::EpiG1 E{(bf16_t*)(ws + WS_RB), (bf16_t*)(ws + WS_RA), (float*)(ws + WS_DT), p.in[5], 24};
          pg8::gemm_phase<pg8::EpiG1, true>(lds, g, S, E); }
    }
    SEAM(1);
    #ifdef SSD_SIMPLE
    if (IN(2)) phase_ssd_simple(p, lds_raw);
#else
    if (IN(2)) phase_ssd(p, lds);
#endif
    SEAM(2);
    if (IN(3)) {
        pg8::Gemm g{(const bf16_t*)(ws + WS_RC), (const bf16_t*)(ws + WS_WIN2), T_TOK, N2, 1024, 1024, 1024, 0};
        pg8::StaticOrder S; S.init(T_TOK, N2, G, c);
        pg8::EpiG2 E{(bf16_t*)(ws + WS_RA), (bf16_t*)(ws + WS_RA + 128 * MiB), p.in[2]};
        pg8::gemm_phase<pg8::EpiG2>(lds, g, S, E);
    }
    SEAM(3);
    if (IN(5)) {
        bf16_t* merged = (bf16_t*)(ws + WS_RC); const bf16_t* gates = (const bf16_t*)(ws + WS_RA + 128 * MiB);
        pg8::StaticOrder S; S.init(T_TOK, 1024, G, c);
        const pg8::Gemm gp{(const bf16_t*)(ws + WS_RA + 384 * MiB), (const bf16_t*)(ws + WS_WP), T_TOK, 1024, 256, 1024, 256, 512};
        const pg8::Gemm gs{(const bf16_t*)(ws + WS_RB), (const bf16_t*)(ws + WS_WSSD), T_TOK, 1024, 2048, 2048, 2048, 0};
        if ((c & 1) == 0) {
            { pg8::Unit u; for (int i = 0; S.next(i, u); ++i) pool_tile(p, u.pm, u.pn); }
            __syncthreads();
            { pg8::EpiPool<true> E{merged, gates}; pg8::gemm_phase<pg8::EpiPool<true>>(lds, gp, S, E); }
            { pg8::EpiSsd<false> E{merged, gates}; pg8::gemm_phase<pg8::EpiSsd<false>>(lds, gs, S, E); }
        } else {
            { pg8::EpiSsd<true> E{merged, gates}; pg8::gemm_phase<pg8::EpiSsd<true>>(lds, gs, S, E); }
            { pg8::Unit u; for (int i = 0; S.next(i, u); ++i) pool_tile(p, u.pm, u.pn); }
            __syncthreads();
            { pg8::EpiPool<false> E{merged, gates}; pg8::gemm_phase<pg8::EpiPool<false>>(lds, gp, S, E); }
        }
    }
    SEAM(5);
    if (IN(6)) {
        pg8::Gemm g{(const bf16_t*)(ws + WS_RC), (const bf16_t*)(ws + WS_WOUT), T_TOK, 1024, 1024, 1024, 1024, 0};
        pg8::StaticOrder S; S.init(T_TOK, 1024, G, c, 1);
        pg8::EpiOut E{p.in[0], (bf16_t*)(ws + WS_RB)};
        pg8::gemm_phase<pg8::EpiOut>(lds, g, S, E);
        __syncthreads();
        for (int pm = c; pm < T_TOK / 256; pm += G) ln_panel_bf16((const bf16_t*)(ws + WS_RB), (bf16_t*)(ws + WS_RC), p.in[13], p.in[14], pm * 256);
    }
    SEAM(6);
    if (IN(8)) {
        pg8::Gemm g{(const bf16_t*)(ws + WS_RC), (const bf16_t*)(ws + WS_WUP), T_TOK, DFF, 1024, 1024, 1024, 0};
        pg8::StaticOrder S; S.init(T_TOK, DFF, G, c);
        pg8::EpiUp E{(bf16_t*)(ws + WS_RA)};
        pg8::gemm_phase<pg8::EpiUp>(lds, g, S, E);
    }
    SEAM(8);
    if (IN(9)) {
        pg8::Gemm g{(const bf16_t*)(ws + WS_RA), (const bf16_t*)(ws + WS_WDN), T_TOK, 1024, DFF, DFF, DFF, 0};
        pg8::StaticOrder S; S.init(T_TOK, 1024, G, c);
        pg8::EpiDown E{(const bf16_t*)(ws + WS_RC), (bf16_t*)(ws + WS_RB)};
        pg8::gemm_phase<pg8::EpiDown>(lds, g, S, E);
    }
    SEAM(9);
    if (IN(10)) phase_ln<false>((const bf16_t*)(ws + WS_RB), (void*)p.out, p.in[17], p.in[18]);
#undef IN
#undef SEAM
}

#ifndef DUPMASK
#define DUPMASK 0
#endif
#ifndef ONE_LAUNCH
#define ONE_LAUNCH 1
#endif
extern "C" void kernel_launch(void* const* d_in, const int* in_sizes, int n_in, void* d_out, int out_size, void* d_ws, size_t ws_size, hipStream_t stream) {
    static int grid = 0;
    if (grid == 0) {
        if (n_in != 19 || ws_size < WS_END) { fprintf(stderr, "kernel_launch: need 19 inputs and >= %zu bytes of workspace; got %d, %zu\n", (size_t)WS_END, n_in, ws_size); grid = -1; return; }
        int dev = 0, cus = 0, per_cu = 0;
        hipGetDevice(&dev); hipDeviceGetAttribute(&cus, hipDeviceAttributeMultiprocessorCount, dev);
        if (hipFuncSetAttribute((const void*)mega, hipFuncAttributeMaxDynamicSharedMemorySize, LDS_BYTES) != hipSuccess) { fprintf(stderr, "kernel_launch: hipFuncSetAttribute failed\n"); grid = -1; return; }
        if (hipOccupancyMaxActiveBlocksPerMultiprocessor(&per_cu, (const void*)mega, 512, LDS_BYTES) != hipSuccess || per_cu < 1) { fprintf(stderr, "kernel_launch: occupancy query says %d\n", per_cu); per_cu = 1; }
        (void)hipGetLastError();
        grid = cus;
    }
    if (grid < 0) return;
    Params p{};
    for (int i = 0; i < 19; ++i) p.in[i] = (const float*)d_in[i];
    p.out = (float*)d_out; p.ws = (unsigned char*)d_ws;
#if ONE_LAUNCH
    p.ph_lo = 0; p.ph_hi = NPHASE;
    void* args[] = {&p};
    hipError_t e = hipLaunchCooperativeKernel((const void*)mega, dim3(grid), dim3(512), args, LDS_BYTES, stream);
    if (e != hipSuccess) fprintf(stderr, "cooperative launch failed: %s (grid %d)\n", hipGetErrorString(e), grid);
#else
    for (int ph = 0; ph < NPHASE; ++ph) { p.ph_lo = ph; p.ph_hi = ph + 1;
        for (int rep = 0; rep < (((DUPMASK >> ph) & 1) ? 2 : 1); ++rep) hipLaunchKernelGGL(mega, dim3(grid), dim3(512), LDS_BYTES, stream, p); }
#endif
}
```

```cpp
#include <hip/hip_runtime.h>
#include <hip/hip_cooperative_groups.h>
#include <cstdio>
namespace cg = cooperative_groups;

#define LAS __attribute__((address_space(3)))
typedef unsigned short bf16_t;
typedef short bf16x8 __attribute__((ext_vector_type(8)));
typedef float f32x4 __attribute__((ext_vector_type(4)));
typedef float f32x2 __attribute__((ext_vector_type(2)));
typedef unsigned u32x4 __attribute__((ext_vector_type(4)));
typedef unsigned u32x2 __attribute__((ext_vector_type(2)));

constexpr int T_TOK = 65536, SEQ = 2048, DM = 1024, DFF = 4096;
constexpr int N1 = 6400;
constexpr int N2 = 3072;
constexpr float ALPHA = 1.189207115002721f;
constexpr float LN_EPS = 1e-5f, RMS_EPS = 1e-5f;
constexpr size_t MiB = 1024ull * 1024ull;
constexpr size_t WS_RA = 0;
constexpr size_t WS_RB = 512 * MiB;
constexpr size_t WS_RC = 768 * MiB;
constexpr size_t WS_DT = 896 * MiB;
constexpr size_t WS_W  = 904 * MiB;
constexpr size_t WS_WIN1 = WS_W;
constexpr size_t WS_WIN2 = WS_WIN1 + (size_t)N1 * 1024 * 2;
constexpr size_t WS_WP   = WS_WIN2 + (size_t)N2 * 1024 * 2;
constexpr size_t WS_WSSD = WS_WP + (size_t)1024 * 256 * 2;
constexpr size_t WS_WOUT = WS_WSSD + (size_t)1024 * 2048 * 2;
constexpr size_t WS_WUP  = WS_WOUT + (size_t)1024 * 1024 * 2;
constexpr size_t WS_WDN  = WS_WUP + (size_t)4096 * 1024 * 2;
constexpr size_t WS_END  = WS_WDN + (size_t)4096 * 1024 * 2;
constexpr size_t WS_X2   = WS_END;
constexpr size_t WS_CNT2 = WS_X2 + (size_t)T_TOK * 4 * 8;
constexpr size_t WS_END2 = WS_CNT2 + 256 * 256;
constexpr int LDS_BYTES = 160000;
constexpr int NPHASE = 11;

struct Params { const float* in[19]; float* out; unsigned char* ws; int ph_lo, ph_hi; };

__device__ __forceinline__ unsigned cvt_pk_bf16(float lo, float hi) { unsigned r; asm volatile("v_cvt_pk_bf16_f32 %0, %1, %2" : "=v"(r) : "v"(lo), "v"(hi)); return r; }
__device__ __forceinline__ float bf_lo(unsigned u) { return __uint_as_float(u << 16); }
__device__ __forceinline__ float bf_hi(unsigned u) { return __uint_as_float(u & 0xffff0000u); }
__device__ __forceinline__ float bf2f(bf16_t b) { return __uint_as_float(((unsigned)b) << 16); }
__device__ __forceinline__ float sigmoidf_(float v) { return __builtin_amdgcn_rcpf(1.0f + __expf(-v)); }
__device__ __forceinline__ float siluf_(float v) { return v * __builtin_amdgcn_rcpf(1.0f + __expf(-v)); }
__device__ __forceinline__ float softplusf_(float v) { return fmaxf(v, 0.f) + log1pf(__expf(-fabsf(v))); }
__device__ __forceinline__ u32x4 pack8(f32x4 a, f32x4 b) { u32x4 w; w.x = cvt_pk_bf16(a[0], a[1]); w.y = cvt_pk_bf16(a[2], a[3]); w.z = cvt_pk_bf16(b[0], b[1]); w.w = cvt_pk_bf16(b[2], b[3]); return w; }
__device__ __forceinline__ f32x4 unpack4(u32x2 w) { return (f32x4){bf_lo(w.x), bf_hi(w.x), bf_lo(w.y), bf_hi(w.y)}; }
__device__ __forceinline__ void unpack8(u32x4 w, f32x4& a, f32x4& b) { a = (f32x4){bf_lo(w.x), bf_hi(w.x), bf_lo(w.y), bf_hi(w.y)}; b = (f32x4){bf_lo(w.z), bf_hi(w.z), bf_lo(w.w), bf_hi(w.w)}; }

namespace pg8 {
constexpr int BM = 256, BK = 64, HALF = 128, HTB = HALF * BK * 2, STAGE_BYTES = 8 * HTB, NXCD = 8, WGM = 8;
__device__ __forceinline__ int lds_byte(int r, int c) { const int st = (r >> 4) * 2 + (c >> 5), rr = r & 15, cc = c & 31, ob = rr * 64 + cc * 2; return st * 1024 + (ob ^ (((ob >> 9) & 1) << 5)); }
__device__ __forceinline__ void stage_rc(int b, int& R, int& C) { const int st = b / 1024, sb = b % 1024, swz = sb ^ (((sb >> 9) & 1) << 5); R = (st >> 1) * 16 + swz / 64; C = (st & 1) * 32 + (swz % 64) / 2; }
__device__ __forceinline__ int perm32(int rho) { const int n = rho >> 4, i = rho & 15; return 8 * (i >> 2) + 4 * n + (i & 3); }
struct Unit { int pm, pn; };
struct Gemm { const bf16_t* A; const bf16_t* Bt; int M, N, K, lda, ldb, a_pn_bytes; };
struct StaticOrder {
    int nM, nN, nwg, G, c, owner;
    __device__ void init(int M, int N, int G_, int c_, int owner_ = 0) { nM = M / BM; nN = N / BM; nwg = nM * nN; G = G_; c = c_; owner = owner_; }
    __device__ bool next(int i, Unit& u) const {
        if (owner) { const int pm = c + (i / nN) * G; if (pm >= nM) return false; u.pm = pm; u.pn = i % nN; return true; }
        const long L = (long)i * G + c; if (L >= nwg) return false;
        int wgid = (int)L; { const int q = nwg / NXCD, r = nwg % NXCD, xcd = wgid % NXCD, off = wgid / NXCD; wgid = (xcd < r ? xcd * (q + 1) : r * (q + 1) + (xcd - r) * q) + off; }
        const int nig = WGM * nN, gid = wgid / nig, fm = gid * WGM, gsz = (nM - fm) < WGM ? (nM - fm) : WGM;
        u.pm = fm + ((wgid % nig) % gsz); u.pn = (wgid % nig) / gsz; return true;
    }
};

template <int OFF> __device__ __forceinline__ void ds_rd128(bf16x8& dst, unsigned addr) { asm volatile("ds_read_b128 %0, %1 offset:%2" : "=v"(dst) : "v"(addr), "n"(OFF)); }
template <class Epi, bool NARROW = false>
__device__ __forceinline__ void gemm_phase(LAS unsigned char* lds, const Gemm g, const StaticOrder& S, const Epi& E) {
    int tid_l = threadIdx.x; asm volatile("" : "+v"(tid_l));
    const int tid = tid_l, wid = __builtin_amdgcn_readfirstlane(tid >> 6), lane = tid & 63, wr = wid >> 2, wc = wid & 3, fr = lane & 15, fq = lane >> 4;
    const int K = g.K, nt = K / BK;
    unsigned voffA[2], voffB[2];
#pragma unroll
    for (int i = 0; i < 2; ++i) { int R, C; stage_rc(tid * 16 + i * 8192, R, C); const int Rb = Epi::PERM ? ((R & ~31) + perm32(R & 31)) : R;
        voffA[i] = (unsigned)(R * g.lda + C) * 2u; voffB[i] = (unsigned)(Rb * g.ldb + C) * 2u; }
    const size_t kstep = (size_t)(BK * 2);
    const size_t hsA = (size_t)HALF * g.lda * 2, hsB = (size_t)HALF * g.ldb * 2;
    const size_t tsA = 2 * hsA, tsB = 2 * hsB;
    const unsigned ldsw = (unsigned)wid * 1024u;
    const int aoff = lds_byte(wr * 64 + fr, fq * 8), boff = lds_byte(wc * 32 + fr, fq * 8);
    const unsigned aaddr = (unsigned)(unsigned long long)(lds + aoff), baddr = (unsigned)(unsigned long long)(lds + 4 * HTB + boff);
#define PG8_SA(b, h) (((b) * 2 + (h)) * HTB)
#define PG8_SB(b, h) ((4 + (b) * 2 + (h)) * HTB)
#define PG8_STAGE(bufoff, gbase, voff) do { _Pragma("unroll") for (int _i = 0; _i < 2; ++_i) \
        __builtin_amdgcn_global_load_lds((const unsigned*)((const char*)(gbase) + (voff)[_i]), (LAS unsigned*)(lds + (bufoff) + ldsw + _i * 8192), 16, 0, 0); } while (0)
#define PG8_LDA(dst, b, h) do { _Pragma("unroll") for (int m = 0; m < 4; ++m) _Pragma("unroll") for (int k = 0; k < 2; ++k) dst[m][k] = *(const LAS bf16x8*)(lds + PG8_SA(b, h) + aoff + m * 2048 + k * 1024); } while (0)
#define PG8_LDB(dst, b, h) do { _Pragma("unroll") for (int n = 0; n < 2; ++n) _Pragma("unroll") for (int k = 0; k < 2; ++k) dst[n][k] = *(const LAS bf16x8*)(lds + PG8_SB(b, h) + boff + n * 2048 + k * 1024); } while (0)
#define PG8_MMA(ai, bj, At, Bt) do { __builtin_amdgcn_s_setprio(1); _Pragma("unroll") for (int m = 0; m < 4; ++m) _Pragma("unroll") for (int n = 0; n < 2; ++n) _Pragma("unroll") for (int k = 0; k < 2; ++k) \
        acc[ai][bj][m][n] = __builtin_amdgcn_mfma_f32_16x16x32_bf16(Bt[n][k], At[m][k], acc[ai][bj][m][n], 0, 0, 0); __builtin_amdgcn_s_setprio(0); } while (0)
#define PG8_RDA(dst, b, h) do { ds_rd128<PG8_SA(b, h) + 0 * 2048>(dst[0][0], aaddr); ds_rd128<PG8_SA(b, h) + 1 * 2048>(dst[1][0], aaddr); ds_rd128<PG8_SA(b, h) + 2 * 2048>(dst[2][0], aaddr); ds_rd128<PG8_SA(b, h) + 3 * 2048>(dst[3][0], aaddr); \
        ds_rd128<PG8_SA(b, h) + 0 * 2048 + 1024>(dst[0][1], aaddr); ds_rd128<PG8_SA(b, h) + 1 * 2048 + 1024>(dst[1][1], aaddr); ds_rd128<PG8_SA(b, h) + 2 * 2048 + 1024>(dst[2][1], aaddr); ds_rd128<PG8_SA(b, h) + 3 * 2048 + 1024>(dst[3][1], aaddr); } while (0)
#define PG8_RDB(dst, b, h) do { ds_rd128<PG8_SA(b, h)>(dst[0][0], baddr); ds_rd128<PG8_SA(b, h) + 2048>(dst[1][0], baddr); ds_rd128<PG8_SA(b, h) + 1024>(dst[0][1], baddr); ds_rd128<PG8_SA(b, h) + 2048 + 1024>(dst[1][1], baddr); } while (0)
#define PG8_WAITA(n, F, k) asm volatile("s_waitcnt lgkmcnt(" #n ")" : "+v"(F[0][k]), "+v"(F[1][k]), "+v"(F[2][k]), "+v"(F[3][k]) :: "memory")
#define PG8_WAITB(n, F, k) asm volatile("s_waitcnt lgkmcnt(" #n ")" : "+v"(F[0][k]), "+v"(F[1][k]) :: "memory")
#define PG8_WAITAB(n, FA, FB) asm volatile("s_waitcnt lgkmcnt(" #n ")" : "+v"(FA[0][0]), "+v"(FA[1][0]), "+v"(FA[2][0]), "+v"(FA[3][0]), "+v"(FB[0][0]), "+v"(FB[1][0]), "+v"(FB[0][1]), "+v"(FB[1][1]) :: "memory")
#define PG8_MMAK(ai, bj, At, Bt, k) do { _Pragma("unroll") for (int m = 0; m < 4; ++m) _Pragma("unroll") for (int n = 0; n < 2; ++n) \
        acc[ai][bj][m][n] = __builtin_amdgcn_mfma_f32_16x16x32_bf16(Bt[n][k], At[m][k], acc[ai][bj][m][n], 0, 0, 0); } while (0)
#define PG8_PRIO(x) __builtin_amdgcn_s_setprio(x)
#define PG8_WAIT_V(n) asm volatile("s_waitcnt vmcnt(" #n ")" ::: "memory")
#define PG8_WAIT_L(n) asm volatile("s_waitcnt lgkmcnt(" #n ")" ::: "memory")
#define PG8_BAR __builtin_amdgcn_s_barrier()
#define PG8_SCHED __builtin_amdgcn_sched_barrier(0)
    Unit cur, nxt; int ui = 0;
    if (!S.next(0, cur)) return;
    f32x4 acc[2][2][4][2];
#pragma unroll
    for (int a = 0; a < 2; ++a)
#pragma unroll
        for (int b = 0; b < 2; ++b)
#pragma unroll
            for (int m = 0; m < 4; ++m)
#pragma unroll
                for (int n = 0; n < 2; ++n) acc[a][b][m][n] = (f32x4){0.f, 0.f, 0.f, 0.f};
    bf16x8 At[4][2], B0[2][2], B1[2][2];
    const char* cA = (const char*)g.A + (size_t)cur.pm * tsA + (size_t)cur.pn * g.a_pn_bytes; const char* cB = (const char*)g.Bt + (size_t)cur.pn * tsB;
    PG8_STAGE(PG8_SB(0, 0), cB, voffB); PG8_STAGE(PG8_SA(0, 0), cA, voffA); PG8_STAGE(PG8_SB(0, 1), cB + hsB, voffB); PG8_STAGE(PG8_SA(0, 1), cA + hsA, voffA);
    if (wr == 1) PG8_BAR;
    PG8_WAIT_V(4); PG8_BAR;
    PG8_STAGE(PG8_SB(1, 0), cB + kstep, voffB); PG8_STAGE(PG8_SA(1, 0), cA + kstep, voffA); PG8_STAGE(PG8_SB(1, 1), cB + hsB + kstep, voffB);
    PG8_WAIT_V(6); PG8_BAR;
    PG8_RDB(B0, 0, 0);
    for (;;) {
        const bool has_next = S.next(ui + 1, nxt);
        const char* nA = has_next ? (const char*)g.A + (size_t)nxt.pm * tsA + (size_t)nxt.pn * g.a_pn_bytes : cA; const char* nB = has_next ? (const char*)g.Bt + (size_t)nxt.pn * tsB : cB;
#pragma unroll 1
        for (int t = 0; t < nt; t += 2) {
            const bool last = (t == nt - 2);
            const char* a1 = cA + (size_t)(t + 1) * kstep;
            const char* a2 = last ? nA : cA + (size_t)(t + 2) * kstep; const char* b2 = last ? nB : cB + (size_t)(t + 2) * kstep;
            const char* a3 = a2 + kstep; const char* b3 = b2 + kstep;
            PG8_RDA(At, 0, 0); PG8_STAGE(PG8_SA(1, 1), a1 + hsA, voffA);
            PG8_WAIT_V(10); PG8_BAR; PG8_PRIO(1); PG8_WAITAB(4, At, B0); PG8_SCHED; PG8_MMAK(0, 0, At, B0, 0); PG8_SCHED; PG8_WAITA(0, At, 1); PG8_SCHED; PG8_MMAK(0, 0, At, B0, 1); PG8_PRIO(0); PG8_BAR; PG8_SCHED;
            PG8_RDB(B1, 0, 1); PG8_STAGE(PG8_SB(0, 0), b2, voffB);
            PG8_WAIT_V(10); PG8_BAR; PG8_PRIO(1); PG8_WAITB(2, B1, 0); PG8_SCHED; if (!NARROW) PG8_MMAK(0, 1, At, B1, 0); PG8_SCHED; PG8_WAITB(0, B1, 1); PG8_SCHED; if (!NARROW) PG8_MMAK(0, 1, At, B1, 1); PG8_PRIO(0); PG8_BAR; PG8_SCHED;
            PG8_RDA(At, 0, 1); PG8_STAGE(PG8_SA(0, 0), a2, voffA);
            PG8_WAIT_V(10); PG8_BAR; PG8_PRIO(1); PG8_WAITA(4, At, 0); PG8_SCHED; PG8_MMAK(1, 0, At, B0, 0); PG8_SCHED; PG8_WAITA(0, At, 1); PG8_SCHED; PG8_MMAK(1, 0, At, B0, 1); PG8_PRIO(0); PG8_BAR; PG8_SCHED;
            PG8_RDB(B0, 1, 0); PG8_STAGE(PG8_SB(0, 1), b2 + hsB, voffB);
            PG8_WAIT_V(10); PG8_BAR; if (!NARROW) PG8_MMA(1, 1, At, B1); PG8_BAR; PG8_SCHED;
            PG8_RDA(At, 1, 0); PG8_STAGE(PG8_SA(0, 1), a2 + hsA, voffA);
            PG8_WAIT_V(10); PG8_BAR; PG8_PRIO(1); PG8_WAITAB(4, At, B0); PG8_SCHED; PG8_MMAK(0, 0, At, B0, 0); PG8_SCHED; PG8_WAITA(0, At, 1); PG8_SCHED; PG8_MMAK(0, 0, At, B0, 1); PG8_PRIO(0); PG8_BAR; PG8_SCHED;
            PG8_RDB(B1, 1, 1); PG8_STAGE(PG8_SB(1, 0), b3, voffB);
            PG8_WAIT_V(10); PG8_BAR; PG8_PRIO(1); PG8_WAITB(2, B1, 0); PG8_SCHED; if (!NARROW) PG8_MMAK(0, 1, At, B1, 0); PG8_SCHED; PG8_WAITB(0, B1, 1); PG8_SCHED; if (!NARROW) PG8_MMAK(0, 1, At, B1, 1); PG8_PRIO(0); PG8_BAR; PG8_SCHED;
            PG8_RDA(At, 1, 1); PG8_STAGE(PG8_SA(1, 0), a3, voffA);
            PG8_WAIT_V(10); PG8_BAR; PG8_PRIO(1); PG8_WAITA(4, At, 0); PG8_SCHED; PG8_MMAK(1, 0, At, B0, 0); PG8_SCHED; PG8_WAITA(0, At, 1); PG8_SCHED; PG8_MMAK(1, 0, At, B0, 1); PG8_PRIO(0); PG8_BAR; PG8_SCHED;
            if (!last) PG8_RDB(B0, 0, 0);
            PG8_STAGE(PG8_SB(1, 1), b3 + hsB, voffB);
            PG8_WAIT_V(10); PG8_BAR; if (!NARROW) PG8_MMA(1, 1, At, B1); PG8_BAR; PG8_SCHED;
        }
        E(acc, cur, wr, wc, fr, fq);
        if (!has_next) break;
#pragma unroll
        for (int a = 0; a < 2; ++a)
#pragma unroll
            for (int b = 0; b < 2; ++b)
#pragma unroll
                for (int m = 0; m < 4; ++m)
#pragma unroll
                    for (int n = 0; n < 2; ++n) acc[a][b][m][n] = (f32x4){0.f, 0.f, 0.f, 0.f};
        cur = nxt; cA = nA; cB = nB; ++ui;
        PG8_RDB(B0, 0, 0);
    }
    PG8_WAIT_V(0);
    if (wr == 0) PG8_BAR;
    PG8_BAR;
#undef PG8_SA
#undef PG8_SB
#undef PG8_STAGE
#undef PG8_LDA
#undef PG8_LDB
#undef PG8_MMA
#undef PG8_MMAK
#undef PG8_RDA
#undef PG8_RDB
#undef PG8_WAITA
#undef PG8_WAITB
#undef PG8_WAITAB
#undef PG8_PRIO
#undef PG8_WAIT_V
#undef PG8_WAIT_L
#undef PG8_BAR
#undef PG8_SCHED
}

typedef const f32x4 (&AccRef)[2][2][4][2];

struct EpiG1 {
    static constexpr bool PERM = true;
    bf16_t* zs; bf16_t* xbc; float* dtb; const float* dt_bias; int pn_off;
    __device__ __forceinline__ void operator()(AccRef acc, const Unit& u, int wr, int wc, int fr, int fq) const {
        const int row0 = u.pm * BM + wr * 64 + fr, pn = u.pn + pn_off;
        if (pn < 24) {
            const bool act = pn < 8;
            bf16_t* base = act ? zs : xbc; const int ld = act ? 2048 : 4096; const int colt = act ? pn * 256 : (pn - 8) * 256;
            const int col0 = colt + wc * 32 + 8 * fq;
#pragma unroll
            for (int ai = 0; ai < 2; ++ai)
#pragma unroll
                for (int m = 0; m < 4; ++m) { bf16_t* rowp = base + (size_t)(row0 + ai * HALF + m * 16) * ld + col0;
#pragma unroll
                    for (int bj = 0; bj < 2; ++bj) { f32x4 v0 = acc[ai][bj][m][0], v1 = acc[ai][bj][m][1];
                        if (act) {
#pragma unroll
                            for (int j = 0; j < 4; ++j) { v0[j] = siluf_(v0[j]); v1[j] = siluf_(v1[j]); } }
                        *(u32x4*)(rowp + bj * HALF) = pack8(v0, v1); } }
        } else if (wc == 0) {
            const int c0 = 8 * fq; const f32x4 b0 = *(const f32x4*)(dt_bias + c0), b1 = *(const f32x4*)(dt_bias + c0 + 4);
#pragma unroll
            for (int ai = 0; ai < 2; ++ai)
#pragma unroll
                for (int m = 0; m < 4; ++m) { float* rowp = dtb + (size_t)(row0 + ai * HALF + m * 16) * 32 + c0;
                    f32x4 v0 = acc[ai][0][m][0] + b0, v1 = acc[ai][0][m][1] + b1;
#pragma unroll
                    for (int j = 0; j < 4; ++j) { v0[j] = softplusf_(v0[j]); v1[j] = softplusf_(v1[j]); }
                    *(f32x4*)rowp = v0; *(f32x4*)(rowp + 4) = v1; }
        }
    }
};
struct EpiG2 {
    static constexpr bool PERM = true;
    bf16_t* upool; bf16_t* gates; const float* b_gates;
    __device__ __forceinline__ void operator()(AccRef acc, const Unit& u, int wr, int wc, int fr, int fq) const {
        const int row0 = u.pm * BM + wr * 64 + fr, pn = u.pn;
        const bool act = pn >= 4;
        bf16_t* base = act ? gates : upool; const int ld = act ? 2048 : 1024; const int colt = act ? (pn - 4) * 256 : pn * 256;
        const int col0 = colt + wc * 32 + 8 * fq;
        f32x4 bv[2][2];
#pragma unroll
        for (int bj = 0; bj < 2; ++bj)
#pragma unroll
            for (int n = 0; n < 2; ++n) bv[bj][n] = act ? *(const f32x4*)(b_gates + col0 + bj * HALF + 4 * n) : (f32x4){0.f, 0.f, 0.f, 0.f};
#pragma unroll
        for (int ai = 0; ai < 2; ++ai)
#pragma unroll
            for (int m = 0; m < 4; ++m) { bf16_t* rowp = base + (size_t)(row0 + ai * HALF + m * 16) * ld + col0;
#pragma unroll
                for (int bj = 0; bj < 2; ++bj) { f32x4 v0 = acc[ai][bj][m][0] + bv[bj][0], v1 = acc[ai][bj][m][1] + bv[bj][1];
                    if (act) {
#pragma unroll
                        for (int j = 0; j < 4; ++j) { v0[j] = sigmoidf_(v0[j]); v1[j] = sigmoidf_(v1[j]); } }
                    *(u32x4*)(rowp + bj * HALF) = pack8(v0, v1); } }
    }
};
template <bool FIRST> struct EpiPool {
    static constexpr bool PERM = true;
    bf16_t* merged; const bf16_t* gates;
    __device__ __forceinline__ void operator()(AccRef acc, const Unit& u, int wr, int wc, int fr, int fq) const {
        const int row0 = u.pm * BM + wr * 64 + fr; const int col0 = u.pn * 256 + wc * 32 + 8 * fq;
#pragma unroll
        for (int ai = 0; ai < 2; ++ai) {
            u32x4 gw[4][2], pw[4][2];
#pragma unroll
            for (int m = 0; m < 4; ++m)
#pragma unroll
                for (int bj = 0; bj < 2; ++bj) { const size_t row = (size_t)(row0 + ai * HALF + m * 16);
                    gw[m][bj] = *(const u32x4*)(gates + row * 2048 + col0 + bj * HALF); if (!FIRST) pw[m][bj] = *(const u32x4*)(merged + row * 1024 + col0 + bj * HALF); }
#pragma unroll
            for (int m = 0; m < 4; ++m) { const size_t row = (size_t)(row0 + ai * HALF + m * 16);
#pragma unroll
                for (int bj = 0; bj < 2; ++bj) { f32x4 g0, g1, p0 = {0.f, 0.f, 0.f, 0.f}, p1 = {0.f, 0.f, 0.f, 0.f}; unpack8(gw[m][bj], g0, g1); if (!FIRST) unpack8(pw[m][bj], p0, p1);
                    const f32x4 v0 = p0 + acc[ai][bj][m][0] * g0, v1 = p1 + acc[ai][bj][m][1] * g1;
                    *(u32x4*)(merged + row * 1024 + col0 + bj * HALF) = pack8(v0, v1); } }
            asm volatile("" ::: "memory");
        }
    }
};
template <bool FIRST> struct EpiSsd {
    static constexpr bool PERM = true;
    bf16_t* merged; const bf16_t* gates;
    __device__ __forceinline__ void operator()(AccRef acc, const Unit& u, int wr, int wc, int fr, int fq) const {
        const int row0 = u.pm * BM + wr * 64 + fr; const int col0 = u.pn * 256 + wc * 32 + 8 * fq;
#pragma unroll
        for (int ai = 0; ai < 2; ++ai) {
            u32x4 gw[4][2], pw[4][2];
#pragma unroll
            for (int m = 0; m < 4; ++m)
#pragma unroll
                for (int bj = 0; bj < 2; ++bj) { const size_t row = (size_t)(row0 + ai * HALF + m * 16);
                    gw[m][bj] = *(const u32x4*)(gates + row * 2048 + 1024 + col0 + bj * HALF); if (!FIRST) pw[m][bj] = *(const u32x4*)(merged + row * 1024 + col0 + bj * HALF); }
#pragma unroll
            for (int m = 0; m < 4; ++m) { const size_t row = (size_t)(row0 + ai * HALF + m * 16);
#pragma unroll
                for (int bj = 0; bj < 2; ++bj) { f32x4 g0, g1, p0 = {0.f, 0.f, 0.f, 0.f}, p1 = {0.f, 0.f, 0.f, 0.f}; unpack8(gw[m][bj], g0, g1); if (!FIRST) unpack8(pw[m][bj], p0, p1);
                    const f32x4 v0 = p0 + acc[ai][bj][m][0] * g0, v1 = p1 + acc[ai][bj][m][1] * g1;
                    *(u32x4*)(merged + row * 1024 + col0 + bj * HALF) = pack8(v0, v1); } }
            asm volatile("" ::: "memory");
        }
    }
};
struct EpiUp {
    static constexpr bool PERM = true;
    bf16_t* upb;
    __device__ __forceinline__ void operator()(AccRef acc, const Unit& u, int wr, int wc, int fr, int fq) const {
        const int row0 = u.pm * BM + wr * 64 + fr; const int col0 = u.pn * 256 + wc * 32 + 8 * fq;
#pragma unroll
        for (int ai = 0; ai < 2; ++ai)
#pragma unroll
            for (int m = 0; m < 4; ++m) { bf16_t* rowp = upb + (size_t)(row0 + ai * HALF + m * 16) * DFF + col0;
#pragma unroll
                for (int bj = 0; bj < 2; ++bj) { f32x4 v0 = acc[ai][bj][m][0], v1 = acc[ai][bj][m][1];
#pragma unroll
                    for (int j = 0; j < 4; ++j) { const float a = fmaxf(v0[j], 0.f), b = fmaxf(v1[j], 0.f); v0[j] = a * a; v1[j] = b * b; }
                    *(u32x4*)(rowp + bj * HALF) = pack8(v0, v1); } }
    }
};
struct EpiOut {
    static constexpr bool PERM = true;
    const float* x; bf16_t* v;
    __device__ __forceinline__ void operator()(AccRef acc, const Unit& u, int wr, int wc, int fr, int fq) const {
        const int row0 = u.pm * BM + wr * 64 + fr, col0 = u.pn * BM + wc * 32 + 8 * fq;
#pragma unroll
        for (int ai = 0; ai < 2; ++ai) {
            f32x4 xv[4][2][2];
#pragma unroll
            for (int m = 0; m < 4; ++m)
#pragma unroll
                for (int bj = 0; bj < 2; ++bj)
#pragma unroll
                    for (int n = 0; n < 2; ++n) xv[m][bj][n] = *(const f32x4*)(x + (size_t)(row0 + ai * HALF + m * 16) * DM + col0 + bj * HALF + n * 4);
#pragma unroll
            for (int m = 0; m < 4; ++m) { const size_t off = (size_t)(row0 + ai * HALF + m * 16) * DM + col0;
#pragma unroll
                for (int bj = 0; bj < 2; ++bj) *(u32x4*)(v + off + bj * HALF) = pack8(xv[m][bj][0] * ALPHA + acc[ai][bj][m][0], xv[m][bj][1] * ALPHA + acc[ai][bj][m][1]); }
            asm volatile("" ::: "memory");
        }
    }
};
struct EpiDownLN {
    static constexpr bool PERM = false;
    const bf16_t* h1b; float* out; unsigned long long* xs; unsigned* cnt; const float* g2; const float* b2; LAS unsigned char* tab;
    __device__ __forceinline__ void operator()(f32x4 (&acc)[2][2][4][2], const Unit& u, int wr, int wc, int fr, int fq) const {
        const int row0 = u.pm * BM + wr * 64 + fr, col0 = u.pn * BM + wc * 32 + 4 * fq;
        LAS f32x2* P = (LAS f32x2*)tab;
        LAS f32x2* S = (LAS f32x2*)(tab + 8192);
#pragma unroll
        for (int ai = 0; ai < 2; ++ai) {
            u32x2 hw[4][2][2];
#pragma unroll
            for (int m = 0; m < 4; ++m)
#pragma unroll
                for (int bj = 0; bj < 2; ++bj)
#pragma unroll
                    for (int n = 0; n < 2; ++n) hw[m][bj][n] = *(const u32x2*)(h1b + (size_t)(row0 + ai * HALF + m * 16) * DM + col0 + bj * HALF + n * 16);
#pragma unroll
            for (int m = 0; m < 4; ++m) { float s1 = 0.f, s2 = 0.f;
#pragma unroll
                for (int bj = 0; bj < 2; ++bj)
#pragma unroll
                    for (int n = 0; n < 2; ++n) { const f32x4 v = unpack4(hw[m][bj][n]) * ALPHA + acc[ai][bj][m][n]; acc[ai][bj][m][n] = v;
                        s1 += (v[0] + v[1]) + (v[2] + v[3]); s2 += (v[0] * v[0] + v[1] * v[1]) + (v[2] * v[2] + v[3] * v[3]); }
                s1 += __shfl_xor(s1, 16); s2 += __shfl_xor(s2, 16); s1 += __shfl_xor(s1, 32); s2 += __shfl_xor(s2, 32);
                if (fq == 0) P[(ai * HALF + wr * 64 + m * 16 + fr) * 4 + wc] = (f32x2){s1, s2}; }
            asm volatile("" ::: "memory");
        }
        asm volatile("s_waitcnt lgkmcnt(0)" ::: "memory"); __builtin_amdgcn_s_barrier(); __builtin_amdgcn_s_barrier(); asm volatile("" ::: "memory");
        const int tid = threadIdx.x;
        if (tid < 256) { const f32x2 a = P[tid * 4 + 0], b = P[tid * 4 + 1], c = P[tid * 4 + 2], d = P[tid * 4 + 3];
            const float t1 = (a.x + b.x) + (c.x + d.x), t2 = (a.y + b.y) + (c.y + d.y);
            __hip_atomic_store(xs + ((size_t)(u.pm * BM + tid) * 4 + u.pn), ((unsigned long long)__float_as_uint(t2) << 32) | __float_as_uint(t1), __ATOMIC_RELAXED, __HIP_MEMORY_SCOPE_AGENT);
            asm volatile("s_waitcnt vmcnt(0)" ::: "memory");
            if ((tid & 63) == 0) __hip_atomic_fetch_add(cnt + 64 * u.pm, 1u, __ATOMIC_RELEASE, __HIP_MEMORY_SCOPE_AGENT); }
        if (tid < 64) { while ((unsigned)__builtin_amdgcn_readfirstlane(__hip_atomic_load(cnt + 64 * u.pm, __ATOMIC_RELAXED, __HIP_MEMORY_SCOPE_AGENT)) < 16u) __builtin_amdgcn_s_sleep(2);
            __builtin_amdgcn_fence(__ATOMIC_ACQUIRE, "agent"); asm volatile("s_waitcnt vmcnt(0)" ::: "memory"); }
        asm volatile("s_waitcnt vmcnt(0) lgkmcnt(0)" ::: "memory"); __builtin_amdgcn_s_barrier(); __builtin_amdgcn_s_barrier(); asm volatile("" ::: "memory");
        if (tid < 256) { float t1 = 0.f, t2 = 0.f;
#pragma unroll
            for (int t = 0; t < 4; ++t) { const unsigned long long w = __hip_atomic_load(xs + ((size_t)(u.pm * BM + tid) * 4 + t), __ATOMIC_RELAXED, __HIP_MEMORY_SCOPE_AGENT); t1 += __uint_as_float((unsigned)w); t2 += __uint_as_float((unsigned)(w >> 32)); }
            const float mu = t1 * (1.0f / 1024.0f); S[tid] = (f32x2){mu, rsqrtf(fmaxf(t2 * (1.0f / 1024.0f) - mu * mu, 0.f) + LN_EPS)}; }
        asm volatile("s_waitcnt vmcnt(0) lgkmcnt(0)" ::: "memory"); __builtin_amdgcn_s_barrier(); __builtin_amdgcn_s_barrier(); asm volatile("" ::: "memory");
        f32x4 gv[2][2], bv[2][2];
#pragma unroll
        for (int bj = 0; bj < 2; ++bj)
#pragma unroll
            for (int n = 0; n < 2; ++n) { gv[bj][n] = *(const f32x4*)(g2 + col0 + bj * HALF + n * 16); bv[bj][n] = *(const f32x4*)(b2 + col0 + bj * HALF + n * 16); }
#pragma unroll
        for (int ai = 0; ai < 2; ++ai)
#pragma unroll
            for (int m = 0; m < 4; ++m) { const int r = ai * HALF + wr * 64 + m * 16 + fr; const f32x2 sr = S[r]; const size_t off = (size_t)(u.pm * BM + r) * DM + col0;
#pragma unroll
                for (int bj = 0; bj < 2; ++bj)
#pragma unroll
                    for (int n = 0; n < 2; ++n) *(f32x4*)(out + off + bj * HALF + n * 16) = (acc[ai][bj][m][n] - sr.x) * sr.y * gv[bj][n] + bv[bj][n]; }
        asm volatile("s_waitcnt lgkmcnt(0)" ::: "memory"); __builtin_amdgcn_s_barrier(); __builtin_amdgcn_s_barrier(); asm volatile("" ::: "memory");
    }
};
}

struct TrJob { const float* src; int ld_src, col0, K, ncols, nvalid; bf16_t* dst; int ld_dst; const float* cscale; };
__device__ __forceinline__ int tr_tiles(int K, int ncols) { return (K / 64) * (ncols / 256); }
__device__ __forceinline__ bool tr_pick(const Params& p, int gt, TrJob& J, int& lt) {
    unsigned char* ws = p.ws; const float* w_in = p.in[1];
    bf16_t* win1 = (bf16_t*)(ws + WS_WIN1); bf16_t* win2 = (bf16_t*)(ws + WS_WIN2);
    int base = 0, n;
#define TRJ(SRC, LDS_, COL0, K_, NC, NV, DST, LDD, CS) do { n = tr_tiles((K_), (NC)); if (gt < base + n) { J.src = (SRC); J.ld_src = (LDS_); J.col0 = (COL0); J.K = (K_); J.ncols = (NC); J.nvalid = (NV); J.dst = (DST); J.ld_dst = (LDD); J.cscale = (CS); lt = gt - base; return true; } base += n; } while (0)
    TRJ(w_in, 9248, 3072, 1024, 4096, 4096, win1 + (size_t)2048 * 1024, 1024, nullptr);
    TRJ(p.in[15], 4096, 0, 1024, 4096, 4096, (bf16_t*)(ws + WS_WUP), 1024, nullptr);
    TRJ(p.in[16], 1024, 0, 4096, 1024, 1024, (bf16_t*)(ws + WS_WDN), 4096, nullptr);
    TRJ(w_in, 9248, 1024, 1024, 2048, 2048, win1, 1024, nullptr);
    TRJ(w_in, 9248, 7200, 1024, 2048, 2048, win2 + (size_t)1024 * 1024, 1024, nullptr);
    TRJ(p.in[9], 1024, 0, 2048, 1024, 1024, (bf16_t*)(ws + WS_WSSD), 2048, nullptr);
    TRJ(w_in, 9248, 0, 1024, 1024, 1024, win2, 1024, nullptr);
    TRJ(p.in[12], 1024, 0, 1024, 1024, 1024, (bf16_t*)(ws + WS_WOUT), 1024, nullptr);
    TRJ(w_in, 9248, 7168, 1024, 256, 32, win1 + (size_t)6144 * 1024, 1024, nullptr);
    TRJ(p.in[10], 256, 0, 256, 256, 256, (bf16_t*)(ws + WS_WP), 256, p.in[11]);
    TRJ(p.in[10] + 65536, 256, 0, 256, 256, 256, (bf16_t*)(ws + WS_WP) + 65536, 256, p.in[11] + 256);
    TRJ(p.in[10] + 2 * 65536, 256, 0, 256, 256, 256, (bf16_t*)(ws + WS_WP) + 2 * 65536, 256, p.in[11] + 512);
    TRJ(p.in[10] + 3 * 65536, 256, 0, 256, 256, 256, (bf16_t*)(ws + WS_WP) + 3 * 65536, 256, p.in[11] + 768);
#undef TRJ
    return false;
}
__device__ void phase0(const Params& p, unsigned char* smem) {
    unsigned char* ws = p.ws;
    { unsigned* cz = (unsigned*)(ws + WS_CNT2); const int gt_ = blockIdx.x * blockDim.x + threadIdx.x; if (gt_ < 256 * 64) cz[gt_] = 0u; }
    { const float* __restrict__ x = p.in[0]; bf16_t* __restrict__ xb = (bf16_t*)(ws + WS_RC);
      const size_t nvec = (size_t)T_TOK * DM / 8, stride = (size_t)gridDim.x * blockDim.x;
      for (size_t i = (size_t)blockIdx.x * blockDim.x + threadIdx.x; i < nvec; i += 4 * stride) {
          f32x4 a[4], b[4];
#pragma unroll
          for (int k = 0; k < 4; ++k) { a[k] = *(const f32x4*)(x + (i + k * stride) * 8); b[k] = *(const f32x4*)(x + (i + k * stride) * 8 + 4); }
#pragma unroll
          for (int k = 0; k < 4; ++k) *(u32x4*)(xb + (i + k * stride) * 8) = pack8(a[k], b[k]); } }
    float* t = (float*)smem;
    const int tid = threadIdx.x;
    for (int gt = blockIdx.x; ; gt += gridDim.x) {
        TrJob J; int lt;
        if (!tr_pick(p, gt, J, lt)) break;
        const int tn = J.ncols / 256; const int k0 = (lt / tn) * 64, n0 = (lt % tn) * 256;
        __syncthreads();
        float v[4][8];
#pragma unroll
        for (int sb = 0; sb < 4; ++sb)
#pragma unroll
            for (int i = 0; i < 8; ++i) { const int k = (tid >> 6) + 8 * i, n = n0 + sb * 64 + (tid & 63); const int nc = n < J.nvalid ? n : 0;
                const float ld = J.src[(size_t)(k0 + k) * J.ld_src + J.col0 + nc]; v[sb][i] = n < J.nvalid ? ld : 0.f; }
#pragma unroll
        for (int sb = 0; sb < 4; ++sb) { const float sc = J.cscale ? J.cscale[n0 + sb * 64 + (tid & 63)] : 1.0f;
#pragma unroll
            for (int i = 0; i < 8; ++i) t[(sb * 64 + (tid >> 6) + 8 * i) * 65 + (tid & 63)] = v[sb][i] * sc; }
        __syncthreads();
        const int n = tid >> 3, kk = (tid & 7) * 8;
#pragma unroll
        for (int sb = 0; sb < 4; ++sb) { float e[8];
#pragma unroll
            for (int j = 0; j < 8; ++j) e[j] = t[(sb * 64 + kk + j) * 65 + n];
            u32x4 w; w.x = cvt_pk_bf16(e[0], e[1]); w.y = cvt_pk_bf16(e[2], e[3]); w.z = cvt_pk_bf16(e[4], e[5]); w.w = cvt_pk_bf16(e[6], e[7]);
            *(u32x4*)(J.dst + (size_t)(n0 + sb * 64 + n) * J.ld_dst + k0 + kk) = w; }
    }
}

__device__ void phase_ssd_simple(const Params& p, unsigned char* smem) {
    unsigned char* ws = p.ws;
    const bf16_t* xbc = (const bf16_t*)(ws + WS_RA); bf16_t* zy = (bf16_t*)(ws + WS_RB); const float* dtb = (const float*)(ws + WS_DT);
    const float* conv_w = p.in[3]; const float* conv_b = p.in[4]; const float* a_log = p.in[6]; const float* d_skip = p.in[7]; const float* norm_w = p.in[8];
    float* sX = (float*)smem;
    float* sY = sX + 16 * 512;
    float* sdt = sY + 16 * 256;
    const int tid = threadIdx.x;
    for (int item = blockIdx.x; item < 256; item += gridDim.x) {
        const int b = item >> 3, g = item & 7;
        const int ch = tid; int gcol;
        if (ch < 256) gcol = g * 256 + ch; else if (ch < 384) gcol = 2048 + g * 128 + (ch - 256); else gcol = 3072 + g * 128 + (ch - 384);
        const float cw0 = conv_w[gcol], cw1 = conv_w[4096 + gcol], cw2 = conv_w[8192 + gcol], cw3 = conv_w[12288 + gcol], cb = conv_b[gcol];
        float u1 = 0.f, u2 = 0.f, u3 = 0.f;
        const int r = tid >> 7, pp = (tid & 127) >> 1, nh = tid & 1;
        const float a_r = -__expf(a_log[g * 4 + r]), d_r = d_skip[g * 4 + r];
        float hst[64];
#pragma unroll
        for (int i = 0; i < 64; ++i) hst[i] = 0.f;
        for (int blk = 0; blk < SEQ / 16; ++blk) {
            const size_t t0 = (size_t)b * SEQ + (size_t)blk * 16;
#pragma unroll 4
            for (int tt = 0; tt < 16; ++tt) { const float raw = bf2f(xbc[(t0 + tt) * 4096 + gcol]);
                const float y = cb + cw0 * u1 + cw1 * u2 + cw2 * u3 + cw3 * raw; u1 = u2; u2 = u3; u3 = raw;
                sX[tt * 512 + ch] = siluf_(y); }
            if (tid < 64) sdt[tid] = dtb[(t0 + (tid >> 2)) * 32 + g * 4 + (tid & 3)];
            __syncthreads();
            for (int tt = 0; tt < 16; ++tt) {
                const float dt = sdt[tt * 4 + r], dec = __expf(dt * a_r), xv = sX[tt * 512 + r * 64 + pp], xdt = xv * dt;
                const float* Bp = sX + tt * 512 + 256 + nh * 64; const float* Cp = sX + tt * 512 + 384 + nh * 64;
                float y = 0.f;
#pragma unroll
                for (int i = 0; i < 64; ++i) { hst[i] = hst[i] * dec + xdt * Bp[i]; y += hst[i] * Cp[i]; }
                y += __shfl_xor(y, 1);
                if (nh == 0) { const float zv = bf2f(zy[(t0 + tt) * 2048 + g * 256 + r * 64 + pp]); sY[tt * 256 + r * 64 + pp] = (y + d_r * xv) * zv; }
            }
            __syncthreads();
            { const int tt = tid >> 5, c0 = (tid & 31) * 8; float e[8]; float ss = 0.f;
#pragma unroll
              for (int j = 0; j < 8; ++j) { e[j] = sY[tt * 256 + c0 + j]; ss += e[j] * e[j]; }
              ss += __shfl_xor(ss, 16); ss += __shfl_xor(ss, 8); ss += __shfl_xor(ss, 4); ss += __shfl_xor(ss, 2); ss += __shfl_xor(ss, 1);
              const float rstd = rsqrtf(ss * (1.0f / 256.0f) + RMS_EPS);
              const f32x4 w0 = *(const f32x4*)(norm_w + g * 256 + c0), w1 = *(const f32x4*)(norm_w + g * 256 + c0 + 4);
              u32x4 o; o.x = cvt_pk_bf16(e[0] * rstd * w0[0], e[1] * rstd * w0[1]); o.y = cvt_pk_bf16(e[2] * rstd * w0[2], e[3] * rstd * w0[3]);
              o.z = cvt_pk_bf16(e[4] * rstd * w1[0], e[5] * rstd * w1[1]); o.w = cvt_pk_bf16(e[6] * rstd * w1[2], e[7] * rstd * w1[3]);
              *(u32x4*)(zy + (t0 + tt) * 2048 + g * 256 + c0) = o; }
            __syncthreads();
        }
    }
}


constexpr int SX_STR = 144, SN_STR = 272, SZ_STR = 528;
constexpr int O_XT = 0;
constexpr int O_BT = O_XT + 256 * SX_STR;
constexpr int O_BN = O_BT + 128 * SX_STR;
constexpr int O_CN = O_BN + 64 * SN_STR;
constexpr int O_CB = O_CN + 64 * SN_STR;
constexpr int O_ZT = O_CB + 64 * SN_STR;
constexpr int O_ACS = O_ZT + 64 * SZ_STR;
constexpr int O_DT = O_ACS + 1024;
constexpr int O_WG = O_DT + 1024;
constexpr int O_EA = O_WG + 1024;
constexpr int O_SSQ = O_EA + 1024;
constexpr int O_RSTD = O_SSQ + 2048;
constexpr int O_CW = O_RSTD + 256;
constexpr int O_RSW = O_CW + 5 * 512 * 4;
constexpr int SSD_LDS = O_RSW + 2048;
static_assert(SSD_LDS <= LDS_BYTES, "LDS");
#define MFMA16(a, b, c) __builtin_amdgcn_mfma_f32_16x16x32_bf16((a), (b), (c), 0, 0, 0)

template <int CTRL> __device__ __forceinline__ float dpp_add(float v) { return v + __builtin_bit_cast(float, __builtin_amdgcn_update_dpp(0, __builtin_bit_cast(int, v), CTRL, 0xf, 0xf, false)); }
__device__ __forceinline__ float row16_sum(float v) { v = dpp_add<0xB1>(v); v = dpp_add<0x4E>(v); v = dpp_add<0x124>(v); v = dpp_add<0x128>(v); return v; }

__device__ void phase_ssd(const Params& p, LAS unsigned char* sm) {
    unsigned char* ws = p.ws;
    const bf16_t* xbc = (const bf16_t*)(ws + WS_RA); bf16_t* zy = (bf16_t*)(ws + WS_RB); const float* dtb = (const float*)(ws + WS_DT);
    const float* conv_w = p.in[3]; const float* conv_b = p.in[4]; const float* a_log = p.in[6]; const float* d_skip = p.in[7]; const float* norm_w = p.in[8];
    const int tid = threadIdx.x, lane = tid & 63, w = __builtin_amdgcn_readfirstlane(tid >> 6), c = lane & 15, q = lane >> 4;
    const int r = w >> 1, ph = w & 1;
    const int tq = tid >> 7, ch0 = (tid & 127) * 4;
    LAS float* ACS = (LAS float*)(sm + O_ACS); LAS float* DTV = (LAS float*)(sm + O_DT); LAS float* WG = (LAS float*)(sm + O_WG); LAS float* EA = (LAS float*)(sm + O_EA);
    LAS float* SSQ = (LAS float*)(sm + O_SSQ); LAS float* RSTD = (LAS float*)(sm + O_RSTD);
    for (int item = blockIdx.x; item < 256; item += gridDim.x) {
        const int b = item >> 3, g = item & 7;
#define SSD_GCOL(CH) ((CH) < 256 ? g * 256 + (CH) : ((CH) < 384 ? 1792 + g * 128 + (CH) : 2688 + g * 128 + (CH)))
        { const int gcol = SSD_GCOL(ch0);
        __syncthreads();
        if (tq == 0) {
#pragma unroll
            for (int k = 0; k < 4; ++k) *(LAS f32x4*)(sm + O_CW + (k * 512 + ch0) * 4) = *(const f32x4*)(conv_w + k * 4096 + gcol);
            *(LAS f32x4*)(sm + O_CW + (4 * 512 + ch0) * 4) = *(const f32x4*)(conv_b + gcol); }
        __syncthreads(); }
        const float d_r = d_skip[g * 4 + r];
        const float a_w = -__expf(a_log[g * 4 + (w & 3)]);
        const int prow0 = r * 64 + ph * 32 + c;
        const float nw0 = norm_w[g * 256 + prow0], nw1 = norm_w[g * 256 + prow0 + 16];
        f32x4 accH[8][2];
#pragma unroll
        for (int nt = 0; nt < 8; ++nt)
#pragma unroll
            for (int pt = 0; pt < 2; ++pt) accH[nt][pt] = (f32x4){0.f, 0.f, 0.f, 0.f};
        u32x2 raw[19]; u32x4 zr[4]; float dtn = 0.f;
#define SSD_ISSUE(SUBN) do { int sn_ = (SUBN); asm volatile("" : "+s"(sn_)); int tid_ = tid; asm volatile("" : "+v"(tid_)); const int ch_ = (tid_ & 127) * 4; const int gc_ = SSD_GCOL(ch_); \
            const int sl0_ = sn_ * 64 + (tid_ >> 7) * 16 - 3; const bf16_t* rp_ = xbc + ((size_t)b * SEQ + (sl0_ < 0 ? 0 : sl0_)) * 4096 + gc_; \
            _Pragma("unroll") for (int i = 0; i < 19; ++i) { const int sl = sl0_ + i; \
                const u32x2 v = *(const u32x2*)(rp_ + (sl0_ < 0 ? (i < 3 ? 0 : i - 3) : i) * 4096); raw[i].x = sl < 0 ? 0u : v.x; raw[i].y = sl < 0 ? 0u : v.y; } \
            const bf16_t* zp_ = zy + ((size_t)b * SEQ + (size_t)sn_ * 64 + (tid_ >> 5)) * 2048 + g * 256 + (tid_ & 31) * 8; \
            _Pragma("unroll") for (int k = 0; k < 4; ++k) zr[k] = *(const u32x4*)(zp_ + (size_t)k * 16 * 2048); \
            if (w < 4) dtn = dtb[((size_t)b * SEQ + (size_t)sn_ * 64 + lane) * 32 + g * 4 + w]; } while (0)
        SSD_ISSUE(0);
#pragma unroll 1
        for (int sub = 0; sub < SEQ / 64; ++sub) {
            const size_t t0 = (size_t)b * SEQ + (size_t)sub * 64;
            {
                const f32x4 cw0 = *(const LAS f32x4*)(sm + O_CW + ch0 * 4), cw1 = *(const LAS f32x4*)(sm + O_CW + (512 + ch0) * 4), cw2 = *(const LAS f32x4*)(sm + O_CW + (1024 + ch0) * 4),
                            cw3 = *(const LAS f32x4*)(sm + O_CW + (1536 + ch0) * 4), cbv = *(const LAS f32x4*)(sm + O_CW + (2048 + ch0) * 4);
                f32x4 u0 = unpack4(raw[0]), u1 = unpack4(raw[1]), u2 = unpack4(raw[2]);
                unsigned tr[4][8]; f32x4 pv = {0.f, 0.f, 0.f, 0.f};
                LAS unsigned char* nb = ch0 < 384 ? sm + O_BN + (ch0 - 256) * 2 : sm + O_CN + (ch0 - 384) * 2;
#pragma unroll
                for (int i = 0; i < 16; ++i) {
                    const f32x4 u3 = unpack4(raw[i + 3]);
                    f32x4 y = cbv + cw0 * u0 + cw1 * u1 + cw2 * u2 + cw3 * u3;
#pragma unroll
                    for (int j = 0; j < 4; ++j) y[j] = siluf_(y[j]);
                    if (ch0 >= 256) *(LAS u32x2*)(nb + (tq * 16 + i) * SN_STR) = (u32x2){cvt_pk_bf16(y[0], y[1]), cvt_pk_bf16(y[2], y[3])};
                    if (i & 1) {
#pragma unroll
                        for (int j = 0; j < 4; ++j) tr[j][i >> 1] = cvt_pk_bf16(pv[j], y[j]); }
                    else pv = y;
                    u0 = u1; u1 = u2; u2 = u3;
                }
                if (ch0 < 384) {
                    LAS unsigned char* tb = ch0 < 256 ? sm + O_XT + ch0 * SX_STR : sm + O_BT + (ch0 - 256) * SX_STR;
#pragma unroll
                    for (int j = 0; j < 4; ++j) { *(LAS u32x4*)(tb + j * SX_STR + tq * 32) = (u32x4){tr[j][0], tr[j][1], tr[j][2], tr[j][3]};
                        *(LAS u32x4*)(tb + j * SX_STR + tq * 32 + 16) = (u32x4){tr[j][4], tr[j][5], tr[j][6], tr[j][7]}; }
                }
            }
            if (w < 4) {
                const float dt = dtn; float x = dt * a_w;
#pragma unroll
                for (int o = 1; o < 64; o <<= 1) { const float v = __shfl_up(x, o); if (lane >= o) x += v; }
                const float last = __shfl(x, 63);
                ACS[w * 64 + lane] = x; DTV[w * 64 + lane] = dt; WG[w * 64 + lane] = dt * __expf(last - x); EA[w * 64 + lane] = __expf(x);
            }
            __syncthreads();
            {
#pragma unroll
                for (int k = 0; k < 4; ++k) { const int v = tid + 512 * k, l = v >> 5, c8 = (v & 31) * 8; *(LAS u32x4*)(sm + O_ZT + l * SZ_STR + c8 * 2) = zr[k]; }
                const int lt = w >> 1;
#pragma unroll
                for (int sti = 0; sti < 2; ++sti) { const int st = 2 * (w & 1) + sti; f32x4 acc = {0.f, 0.f, 0.f, 0.f};
#pragma unroll
                    for (int ks = 0; ks < 4; ++ks) { const bf16x8 a = *(const LAS bf16x8*)(sm + O_CN + (16 * lt + c) * SN_STR + (32 * ks + 8 * q) * 2);
                        const bf16x8 bb = *(const LAS bf16x8*)(sm + O_BN + (16 * st + c) * SN_STR + (32 * ks + 8 * q) * 2); acc = MFMA16(a, bb, acc); }
#pragma unroll
                    for (int rg = 0; rg < 4; ++rg) *(LAS float*)(sm + O_CB + (16 * lt + 4 * q + rg) * SN_STR + (16 * st + c) * 4) = acc[rg]; }
            }
            __syncthreads();
            f32x4 accY[4][2];
#pragma unroll
            for (int lt = 0; lt < 4; ++lt)
#pragma unroll
                for (int pt = 0; pt < 2; ++pt) accY[lt][pt] = (f32x4){0.f, 0.f, 0.f, 0.f};
#pragma unroll
            for (int ks = 0; ks < 4; ++ks) {
                bf16x8 hb[2];
#pragma unroll
                for (int pt = 0; pt < 2; ++pt) hb[pt] = __builtin_bit_cast(bf16x8, pack8(accH[2 * ks][pt], accH[2 * ks + 1][pt]));
#pragma unroll
                for (int lt = 0; lt < 4; ++lt) { const LAS unsigned char* cp = sm + O_CN + (16 * lt + c) * SN_STR + (32 * ks + 4 * q) * 2;
                    const u32x2 lo = *(const LAS u32x2*)cp, hi = *(const LAS u32x2*)(cp + 32);
                    const bf16x8 a = __builtin_bit_cast(bf16x8, (u32x4){lo.x, lo.y, hi.x, hi.y});
#pragma unroll
                    for (int pt = 0; pt < 2; ++pt) accY[lt][pt] = MFMA16(a, hb[pt], accY[lt][pt]); }
            }
#pragma unroll
            for (int lt = 0; lt < 4; ++lt) { const f32x4 e = *(const LAS f32x4*)(EA + r * 64 + 16 * lt + 4 * q);
#pragma unroll
                for (int pt = 0; pt < 2; ++pt) accY[lt][pt] *= e; }
            bf16x8 xf[2][2];
#pragma unroll
            for (int ks = 0; ks < 2; ++ks)
#pragma unroll
                for (int pt = 0; pt < 2; ++pt) xf[ks][pt] = *(const LAS bf16x8*)(sm + O_XT + (prow0 + 16 * pt) * SX_STR + (32 * ks + 8 * q) * 2);
#pragma unroll
            for (int lt = 0; lt < 4; ++lt)
#pragma unroll
                for (int ks = 0; ks < 2; ++ks) {
                    if (ks == 1 && lt < 2) continue;
                    const int l = 16 * lt + c; const float acl = ACS[r * 64 + l];
                    const LAS float* cbp = (const LAS float*)(sm + O_CB + l * SN_STR) + 32 * ks + 8 * q;
                    const f32x4 cb0 = *(const LAS f32x4*)cbp, cb1 = *(const LAS f32x4*)(cbp + 4);
                    const f32x4 as0 = *(const LAS f32x4*)(ACS + r * 64 + 32 * ks + 8 * q), as1 = *(const LAS f32x4*)(ACS + r * 64 + 32 * ks + 8 * q + 4);
                    const f32x4 d0 = *(const LAS f32x4*)(DTV + r * 64 + 32 * ks + 8 * q), d1 = *(const LAS f32x4*)(DTV + r * 64 + 32 * ks + 8 * q + 4);
                    f32x4 m0, m1;
#pragma unroll
                    for (int j = 0; j < 4; ++j) { const int s0 = 32 * ks + 8 * q + j, s1 = s0 + 4;
                        m0[j] = (s0 <= l) ? cb0[j] * __expf(acl - as0[j]) * d0[j] : 0.f;
                        m1[j] = (s1 <= l) ? cb1[j] * __expf(acl - as1[j]) * d1[j] : 0.f; }
                    const bf16x8 mf = __builtin_bit_cast(bf16x8, pack8(m0, m1));
#pragma unroll
                    for (int pt = 0; pt < 2; ++pt) accY[lt][pt] = MFMA16(mf, xf[ks][pt], accY[lt][pt]);
                }
#pragma unroll
            for (int lt = 0; lt < 4; ++lt) {
#pragma unroll
                for (int pt = 0; pt < 2; ++pt) { const int prow = prow0 + 16 * pt;
                    const f32x4 xv = unpack4(*(const LAS u32x2*)(sm + O_XT + prow * SX_STR + (16 * lt + 4 * q) * 2));
#pragma unroll
                    for (int rg = 0; rg < 4; ++rg) { const int l = 16 * lt + 4 * q + rg; const float zv = bf2f(*(const LAS bf16_t*)(sm + O_ZT + l * SZ_STR + prow * 2));
                        accY[lt][pt][rg] = (accY[lt][pt][rg] + d_r * xv[rg]) * zv; } }
                f32x4 sv;
#pragma unroll
                for (int rg = 0; rg < 4; ++rg) sv[rg] = row16_sum(accY[lt][0][rg] * accY[lt][0][rg] + accY[lt][1][rg] * accY[lt][1][rg]);
                if (c == 0) *(LAS f32x4*)(SSQ + w * 64 + 16 * lt + 4 * q) = sv;
            }
            {
                const float dec = __expf(ACS[r * 64 + 63]);
#pragma unroll
                for (int nt = 0; nt < 8; ++nt)
#pragma unroll
                    for (int pt = 0; pt < 2; ++pt) accH[nt][pt] *= dec;
                bf16x8 xw[2][2];
#pragma unroll
                for (int ks = 0; ks < 2; ++ks) { const f32x4 w0 = *(const LAS f32x4*)(WG + r * 64 + 32 * ks + 8 * q), w1 = *(const LAS f32x4*)(WG + r * 64 + 32 * ks + 8 * q + 4);
#pragma unroll
                    for (int pt = 0; pt < 2; ++pt) { f32x4 a, bq; unpack8(__builtin_bit_cast(u32x4, xf[ks][pt]), a, bq); xw[ks][pt] = __builtin_bit_cast(bf16x8, pack8(a * w0, bq * w1)); } }
#pragma unroll
                for (int nt = 0; nt < 8; ++nt)
#pragma unroll
                    for (int ks = 0; ks < 2; ++ks) { const bf16x8 bfr = *(const LAS bf16x8*)(sm + O_BT + (16 * nt + c) * SX_STR + (32 * ks + 8 * q) * 2);
#pragma unroll
                        for (int pt = 0; pt < 2; ++pt) accH[nt][pt] = MFMA16(bfr, xw[ks][pt], accH[nt][pt]); }
            }
            SSD_ISSUE(sub + 1 < SEQ / 64 ? sub + 1 : sub);
            __syncthreads();
            { float s = 0.f;
#pragma unroll
              for (int k = 0; k < 8; ++k) s += SSQ[k * 64 + lane];
              LAS float* RSW = (LAS float*)(sm + O_RSW) + w * 64;
              RSW[lane] = rsqrtf(s * (1.0f / 256.0f) + RMS_EPS);
#pragma unroll
              for (int lt = 0; lt < 4; ++lt) { const f32x4 rs = *(const LAS f32x4*)(RSW + 16 * lt + 4 * q);
#pragma unroll
                for (int pt = 0; pt < 2; ++pt) { const float nw = pt ? nw1 : nw0;
#pragma unroll
                    for (int rg = 0; rg < 4; ++rg) { const int l = 16 * lt + 4 * q + rg;
                        *(LAS bf16_t*)(sm + O_ZT + l * SZ_STR + (prow0 + 16 * pt) * 2) = (bf16_t)(cvt_pk_bf16(accY[lt][pt][rg] * rs[rg] * nw, 0.f) & 0xffffu); } } }
#pragma unroll
              for (int k = 0; k < 4; ++k) { const int row = (lane >> 2) + 16 * k, pc = lane & 3;
                *(u32x4*)(zy + (t0 + row) * 2048 + g * 256 + r * 64 + ph * 32 + pc * 8) = *(const LAS u32x4*)(sm + O_ZT + row * SZ_STR + (r * 64 + ph * 32 + pc * 8) * 2); }
            }
        }
    }
}

template <int W, int RUN = 16>
__device__ __forceinline__ void pool_task(const bf16_t* __restrict__ colp, bf16_t* __restrict__ outp, int t0, int s0) {
    constexpr int H = W - 1;
    u32x4 rw[RUN + H];
#pragma unroll
    for (int j = 0; j < RUN + H; ++j) { int tt = t0 - H + j; tt = tt < 0 ? 0 : tt; rw[j] = *(const u32x4*)(colp + (size_t)tt * 1024); }
    f32x4 S0 = {0.f, 0.f, 0.f, 0.f}, S1 = {0.f, 0.f, 0.f, 0.f};
#pragma unroll
    for (int j = 1; j <= H; ++j) { f32x4 a, b; unpack8(rw[H - j], a, b); const bool ok = (s0 - j >= 0); S0 += ok ? a : (f32x4){0.f, 0.f, 0.f, 0.f}; S1 += ok ? b : (f32x4){0.f, 0.f, 0.f, 0.f}; }
#pragma unroll
    for (int tt = 0; tt < RUN; ++tt) { const int s = s0 + tt;
        f32x4 a, b; unpack8(rw[H + tt], a, b); S0 += a; S1 += b;
        const float inv = 1.0f / (float)(s + 1 < W ? s + 1 : W);
        *(u32x4*)(outp + (size_t)(t0 + tt) * 1024) = pack8(S0 * inv - a, S1 * inv - b);
        f32x4 c, d; unpack8(rw[tt], c, d);
        if (s - W + 1 >= 0) { S0 -= c; S1 -= d; } }
}
__device__ __forceinline__ void pool_tile(const Params& p, int pm, int g) {
    const bf16_t* up = (const bf16_t*)(p.ws + WS_RA); bf16_t* pooled = (bf16_t*)(p.ws + WS_RA + 384 * MiB);
    int tl = threadIdx.x; asm volatile("" : "+v"(tl));
    const int vec = g * 32 + (tl & 31), run = tl >> 5;
    const int t0 = pm * 256 + run * 16, s0 = t0 & (SEQ - 1);
    const bf16_t* colp = up + vec * 8; bf16_t* outp = pooled + vec * 8;
    if (g == 0) pool_task<2>(colp, outp, t0, s0); else if (g == 1) pool_task<4>(colp, outp, t0, s0);
    else if (g == 2) pool_task<8>(colp, outp, t0, s0); else { pool_task<16, 8>(colp, outp, t0, s0); pool_task<16, 8>(colp, outp, t0 + 8, s0 + 8); }
}

template <bool OUT_BF16>
__device__ void phase_ln(const bf16_t* __restrict__ src, void* __restrict__ dst, const float* __restrict__ gam, const float* __restrict__ bet) {
    const int lane = threadIdx.x & 63, wv = threadIdx.x >> 6;
    f32x4 gv[4], bv[4];
#pragma unroll
    for (int i = 0; i < 2; ++i) { gv[2 * i] = *(const f32x4*)(gam + lane * 8 + 512 * i); gv[2 * i + 1] = *(const f32x4*)(gam + lane * 8 + 512 * i + 4);
        bv[2 * i] = *(const f32x4*)(bet + lane * 8 + 512 * i); bv[2 * i + 1] = *(const f32x4*)(bet + lane * 8 + 512 * i + 4); }
    for (int row0 = (blockIdx.x * 8 + wv) * 4; row0 < T_TOK; row0 += gridDim.x * 8 * 4) {
        u32x4 rw[4][2];
#pragma unroll
        for (int rr = 0; rr < 4; ++rr)
#pragma unroll
            for (int i = 0; i < 2; ++i) rw[rr][i] = *(const u32x4*)(src + (size_t)(row0 + rr) * DM + lane * 8 + 512 * i);
#pragma unroll
        for (int rr = 0; rr < 4; ++rr) {
            f32x4 v[4]; unpack8(rw[rr][0], v[0], v[1]); unpack8(rw[rr][1], v[2], v[3]);
            float s = 0.f;
#pragma unroll
            for (int i = 0; i < 4; ++i) s += (v[i][0] + v[i][1]) + (v[i][2] + v[i][3]);
#pragma unroll
            for (int o = 32; o >= 1; o >>= 1) s += __shfl_xor(s, o);
            const float mu = s * (1.0f / 1024.0f); float q = 0.f;
#pragma unroll
            for (int i = 0; i < 4; ++i) { v[i] -= mu; q += (v[i][0] * v[i][0] + v[i][1] * v[i][1]) + (v[i][2] * v[i][2] + v[i][3] * v[i][3]); }
#pragma unroll
            for (int o = 32; o >= 1; o >>= 1) q += __shfl_xor(q, o);
            const float rstd = rsqrtf(q * (1.0f / 1024.0f) + LN_EPS);
#pragma unroll
            for (int i = 0; i < 2; ++i) { const f32x4 o0 = v[2 * i] * rstd * gv[2 * i] + bv[2 * i], o1 = v[2 * i + 1] * rstd * gv[2 * i + 1] + bv[2 * i + 1];
                if (OUT_BF16) *(u32x4*)((bf16_t*)dst + (size_t)(row0 + rr) * DM + lane * 8 + 512 * i) = pack8(o0, o1);
                else { float* op = (float*)dst + (size_t)(row0 + rr) * DM + lane * 8 + 512 * i; *(f32x4*)op = o0; *(f32x4*)(op + 4) = o1; } }
        }
    }
}

__device__ __forceinline__ void ln_panel_bf16(const bf16_t* __restrict__ src, bf16_t* __restrict__ dst, const float* __restrict__ gam, const float* __restrict__ bet, int r0) {
    int tl = threadIdx.x; asm volatile("" : "+v"(tl));
    const int lane = tl & 63, wv = tl >> 6;
    f32x4 gv[4], bv[4];
#pragma unroll
    for (int i = 0; i < 2; ++i) { gv[2 * i] = *(const f32x4*)(gam + lane * 8 + 512 * i); gv[2 * i + 1] = *(const f32x4*)(gam + lane * 8 + 512 * i + 4);
        bv[2 * i] = *(const f32x4*)(bet + lane * 8 + 512 * i); bv[2 * i + 1] = *(const f32x4*)(bet + lane * 8 + 512 * i + 4); }
#pragma unroll 1
    for (int k = 0; k < 8; ++k) { const int row0 = r0 + wv * 32 + k * 4;
        u32x4 rw[4][2];
#pragma unroll
        for (int rr = 0; rr < 4; ++rr)
#pragma unroll
            for (int i = 0; i < 2; ++i) rw[rr][i] = *(const u32x4*)(src + (size_t)(row0 + rr) * DM + lane * 8 + 512 * i);
#pragma unroll
        for (int rr = 0; rr < 4; ++rr) {
            f32x4 v[4]; unpack8(rw[rr][0], v[0], v[1]); unpack8(rw[rr][1], v[2], v[3]);
            float sm = 0.f;
#pragma unroll
            for (int i = 0; i < 4; ++i) sm += (v[i][0] + v[i][1]) + (v[i][2] + v[i][3]);
#pragma unroll
            for (int o = 32; o >= 1; o >>= 1) sm += __shfl_xor(sm, o);
            const float mu = sm * (1.0f / 1024.0f); float q = 0.f;
#pragma unroll
            for (int i = 0; i < 4; ++i) { v[i] -= mu; q += (v[i][0] * v[i][0] + v[i][1] * v[i][1]) + (v[i][2] * v[i][2] + v[i][3] * v[i][3]); }
#pragma unroll
            for (int o = 32; o >= 1; o >>= 1) q += __shfl_xor(q, o);
            const float rstd = rsqrtf(q * (1.0f / 1024.0f) + LN_EPS);
#pragma unroll
            for (int i = 0; i < 2; ++i) *(u32x4*)(dst + (size_t)(row0 + rr) * DM + lane * 8 + 512 * i) = pack8(v[2 * i] * rstd * gv[2 * i] + bv[2 * i], v[2 * i + 1] * rstd * gv[2 * i + 1] + bv[2 * i + 1]);
        }
    }
}

__global__ void __launch_bounds__(512, 2) mega(Params p) {
    extern __shared__ __attribute__((aligned(16))) unsigned char lds_raw[];
    LAS unsigned char* lds = (LAS unsigned char*)lds_raw;
    cg::grid_group grid = cg::this_grid();
    unsigned char* ws = p.ws;
    const int G = gridDim.x, c = blockIdx.x;
#ifndef PHMASK
#define PHMASK 0x7ff
#endif
#define IN(k) (((PHMASK >> (k)) & 1) && p.ph_lo <= (k) && (k) < p.ph_hi)
#define SEAM(k) do { if (IN(k) && IN((k) + 1)) grid.sync(); } while (0)
    if (IN(0)) phase0(p, lds_raw);
    SEAM(0);
    if (IN(1)) {
        { pg8::Gemm g{(const bf16_t*)(ws + WS_RC), (const bf16_t*)(ws + WS_WIN1), T_TOK, N1 - 256, 1024, 1024, 1024, 0};
          pg8::StaticOrder S; S.init(T_TOK, N1 - 256, G, c);
          pg8::EpiG1 E{(bf16_t*)(ws + WS_RB), (bf16_t*)(ws + WS_RA), (float*)(ws + WS_DT), p.in[5], 0};
          pg8::gemm_phase<pg8::EpiG1>(lds, g, S, E); }
        { pg8::Gemm g{(const bf16_t*)(ws + WS_RC), (const bf16_t*)(ws + WS_WIN1) + (size_t)(N1 - 256) * 1024, T_TOK, 256, 1024, 1024, 1024, 0};
          pg8::StaticOrder S; S.init(T_TOK, 256, G, c);
          pg8::EpiG1 E{(bf16_t*)(ws + WS_RB), (bf16_t*)(ws + WS_RA), (float*)(ws + WS_DT), p.in[5], 24};
          pg8::gemm_phase<pg8::EpiG1, true>(lds, g, S, E); }
    }
    SEAM(1);
    #ifdef SSD_SIMPLE
    if (IN(2)) phase_ssd_simple(p, lds_raw);
#else
    if (IN(2)) phase_ssd(p, lds);
#endif
    SEAM(2);
    if (IN(3)) {
        pg8::Gemm g{(const bf16_t*)(ws + WS_RC), (const bf16_t*)(ws + WS_WIN2), T_TOK, N2, 1024, 1024, 1024, 0};
        pg8::StaticOrder S; S.init(T_TOK, N2, G, c);
        pg8::EpiG2 E{(bf16_t*)(ws + WS_RA), (bf16_t*)(ws + WS_RA + 128 * MiB), p.in[2]};
        pg8::gemm_phase<pg8::EpiG2>(lds, g, S, E);
    }
    SEAM(3);
    if (IN(5)) {
        bf16_t* merged = (bf16_t*)(ws + WS_RC); const bf16_t* gates = (const bf16_t*)(ws + WS_RA + 128 * MiB);
        pg8::StaticOrder S; S.init(T_TOK, 1024, G, c);
        const pg8::Gemm gp{(const bf16_t*)(ws + WS_RA + 384 * MiB), (const bf16_t*)(ws + WS_WP), T_TOK, 1024, 256, 1024, 256, 512};
        const pg8::Gemm gs{(const bf16_t*)(ws + WS_RB), (const bf16_t*)(ws + WS_WSSD), T_TOK, 1024, 2048, 2048, 2048, 0};
        if ((c & 1) == 0) {
            { pg8::Unit u; for (int i = 0; S.next(i, u); ++i) pool_tile(p, u.pm, u.pn); }
            __syncthreads();
            { pg8::EpiPool<true> E{merged, gates}; pg8::gemm_phase<pg8::EpiPool<true>>(lds, gp, S, E); }
            { pg8::EpiSsd<false> E{merged, gates}; pg8::gemm_phase<pg8::EpiSsd<false>>(lds, gs, S, E); }
        } else {
            { pg8::EpiSsd<true> E{merged, gates}; pg8::gemm_phase<pg8::EpiSsd<true>>(lds, gs, S, E); }
            { pg8::Unit u; for (int i = 0; S.next(i, u); ++i) pool_tile(p, u.pm, u.pn); }
            __syncthreads();
            { pg8::EpiPool<false> E{merged, gates}; pg8::gemm_phase<pg8::EpiPool<false>>(lds, gp, S, E); }
        }
    }
    SEAM(5);
    if (IN(6)) {
        pg8::Gemm g{(const bf16_t*)(ws + WS_RC), (const bf16_t*)(ws + WS_WOUT), T_TOK, 1024, 1024, 1024, 1024, 0};
        pg8::StaticOrder S; S.init(T_TOK, 1024, G, c, 1);
        pg8::EpiOut E{p.in[0], (bf16_t*)(ws + WS_RB)};
        pg8::gemm_phase<pg8::EpiOut>(lds, g, S, E);
        __syncthreads();
        for (int pm = c; pm < T_TOK / 256; pm += G) ln_panel_bf16((const bf16_t*)(ws + WS_RB), (bf16_t*)(ws + WS_RC), p.in[13], p.in[14], pm * 256);
    }
    SEAM(6);
    if (IN(8)) {
        pg8::Gemm g{(const bf16_t*)(ws + WS_RC), (const bf16_t*)(ws + WS_WUP), T_TOK, DFF, 1024, 1024, 1024, 0};
        pg8::StaticOrder S; S.init(T_TOK, DFF, G, c);
        pg8::EpiUp E{(bf16_t*)(ws + WS_RA)};
        pg8::gemm_phase<pg8::EpiUp>(lds, g, S, E);
    }
    SEAM(8);
    if (IN(9)) {
        pg8::Gemm g{(const bf16_t*)(ws + WS_RA), (const bf16_t*)(ws + WS_WDN), T_TOK, 1024, DFF, DFF, DFF, 0};
        pg8::StaticOrder S; S.init(T_TOK, 1024, G, c);
        pg8::EpiDownLN E{(const bf16_t*)(ws + WS_RC), p.out, (unsigned long long*)(ws + WS_X2), (unsigned*)(ws + WS_CNT2), p.in[17], p.in[18], lds + 131072};
        pg8::gemm_phase<pg8::EpiDownLN>(lds, g, S, E);
    }
#undef IN
#undef SEAM
}

#ifndef DUPMASK
#define DUPMASK 0
#endif
#ifndef ONE_LAUNCH
#define ONE_LAUNCH 1
#endif
extern "C" void kernel_launch(void* const* d_in, const int* in_sizes, int n_in, void* d_out, int out_size, void* d_ws, size_t ws_size, hipStream_t stream) {
    static int grid = 0;
    if (grid == 0) {
        if (n_in != 19 || ws_size < WS_END2) { fprintf(stderr, "kernel_launch: need 19 inputs and >= %zu bytes of workspace; got %d, %zu\n", (size_t)WS_END, n_in, ws_size); grid = -1; return; }
        int dev = 0, cus = 0, per_cu = 0;
        hipGetDevice(&dev); hipDeviceGetAttribute(&cus, hipDeviceAttributeMultiprocessorCount, dev);
        if (hipFuncSetAttribute((const void*)mega, hipFuncAttributeMaxDynamicSharedMemorySize, LDS_BYTES) != hipSuccess) { fprintf(stderr, "kernel_launch: hipFuncSetAttribute failed\n"); grid = -1; return; }
        if (hipOccupancyMaxActiveBlocksPerMultiprocessor(&per_cu, (const void*)mega, 512, LDS_BYTES) != hipSuccess || per_cu < 1) { fprintf(stderr, "kernel_launch: occupancy query says %d\n", per_cu); per_cu = 1; }
        (void)hipGetLastError();
        grid = cus;
    }
    if (grid < 0) return;
    Params p{};
    for (int i = 0; i < 19; ++i) p.in[i] = (const float*)d_in[i];
    p.out = (float*)d_out; p.ws = (unsigned char*)d_ws;
#if ONE_LAUNCH
    p.ph_lo = 0; p.ph_hi = NPHASE;
    void* args[] = {&p};
    hipError_t e = hipLaunchCooperativeKernel((const void*)mega, dim3(grid), dim3(512), args, LDS_BYTES, stream);
    if (e != hipSuccess) fprintf(stderr, "cooperative launch failed: %s (grid %d)\n", hipGetErrorString(e), grid);
#else
    for (int ph = 0; ph < NPHASE; ++ph) { p.ph_lo = ph; p.ph_hi = ph + 1;
        for (int rep = 0; rep < (((DUPMASK >> ph) & 1) ? 2 : 1); ++rep) hipLaunchKernelGGL(mega, dim3(grid), dim3(512), LDS_BYTES, stream, p); }
#endif
}
```

```cpp
#include <hip/hip_runtime.h>
#include <hip/hip_cooperative_groups.h>
#include <cstdio>
namespace cg = cooperative_groups;

#define LAS __attribute__((address_space(3)))
typedef unsigned short bf16_t;
typedef short bf16x8 __attribute__((ext_vector_type(8)));
typedef float f32x4 __attribute__((ext_vector_type(4)));
typedef float f32x2 __attribute__((ext_vector_type(2)));
typedef unsigned u32x4 __attribute__((ext_vector_type(4)));
typedef unsigned u32x2 __attribute__((ext_vector_type(2)));

constexpr int T_TOK = 65536, SEQ = 2048, DM = 1024, DFF = 4096;
constexpr int N1 = 6400;
constexpr int N2 = 3072;
constexpr float ALPHA = 1.189207115002721f;
constexpr float LN_EPS = 1e-5f, RMS_EPS = 1e-5f;
constexpr size_t MiB = 1024ull * 1024ull;
constexpr size_t WS_RA = 0;
constexpr size_t WS_RB = 512 * MiB;
constexpr size_t WS_RC = 768 * MiB;
constexpr size_t WS_DT = 896 * MiB;
constexpr size_t WS_W  = 904 * MiB;
constexpr size_t WS_WIN1 = WS_W;
constexpr size_t WS_WIN2 = WS_WIN1 + (size_t)N1 * 1024 * 2;
constexpr size_t WS_WP   = WS_WIN2 + (size_t)N2 * 1024 * 2;
constexpr size_t WS_WSSD = WS_WP + (size_t)1024 * 256 * 2;
constexpr size_t WS_WOUT = WS_WSSD + (size_t)1024 * 2048 * 2;
constexpr size_t WS_WUP  = WS_WOUT + (size_t)1024 * 1024 * 2;
constexpr size_t WS_WDN  = WS_WUP + (size_t)4096 * 1024 * 2;
constexpr size_t WS_END  = WS_WDN + (size_t)4096 * 1024 * 2;
constexpr size_t WS_BAR = WS_END;
constexpr int LDS_BYTES = 160016;
constexpr int LDS_XB = 160000;
constexpr int NPHASE = 11;

struct Params { const float* in[19]; float* out; unsigned char* ws; int ph_lo, ph_hi; };

__device__ __forceinline__ unsigned cvt_pk_bf16(float lo, float hi) { unsigned r; asm volatile("v_cvt_pk_bf16_f32 %0, %1, %2" : "=v"(r) : "v"(lo), "v"(hi)); return r; }
__device__ __forceinline__ float bf_lo(unsigned u) { return __uint_as_float(u << 16); }
__device__ __forceinline__ float bf_hi(unsigned u) { return __uint_as_float(u & 0xffff0000u); }
__device__ __forceinline__ float bf2f(bf16_t b) { return __uint_as_float(((unsigned)b) << 16); }
__device__ __forceinline__ float sigmoidf_(float v) { return __builtin_amdgcn_rcpf(1.0f + __expf(-v)); }
__device__ __forceinline__ float siluf_(float v) { return v * __builtin_amdgcn_rcpf(1.0f + __expf(-v)); }
__device__ __forceinline__ float softplusf_(float v) { return fmaxf(v, 0.f) + log1pf(__expf(-fabsf(v))); }
__device__ __forceinline__ u32x4 pack8(f32x4 a, f32x4 b) { u32x4 w; w.x = cvt_pk_bf16(a[0], a[1]); w.y = cvt_pk_bf16(a[2], a[3]); w.z = cvt_pk_bf16(b[0], b[1]); w.w = cvt_pk_bf16(b[2], b[3]); return w; }
__device__ __forceinline__ void unpack8(u32x4 w, f32x4& a, f32x4& b) { a = (f32x4){bf_lo(w.x), bf_hi(w.x), bf_lo(w.y), bf_hi(w.y)}; b = (f32x4){bf_lo(w.z), bf_hi(w.z), bf_lo(w.w), bf_hi(w.w)}; }

namespace pg8 {
constexpr int BM = 256, BK = 64, HALF = 128, HTB = HALF * BK * 2, STAGE_BYTES = 8 * HTB, NXCD = 8, WGM = 8;
__device__ __forceinline__ int lds_byte(int r, int c) { const int st = (r >> 4) * 2 + (c >> 5), rr = r & 15, cc = c & 31, ob = rr * 64 + cc * 2; return st * 1024 + (ob ^ (((ob >> 9) & 1) << 5)); }
__device__ __forceinline__ void stage_rc(int b, int& R, int& C) { const int st = b / 1024, sb = b % 1024, swz = sb ^ (((sb >> 9) & 1) << 5); R = (st >> 1) * 16 + swz / 64; C = (st & 1) * 32 + (swz % 64) / 2; }
__device__ __forceinline__ int perm32(int rho) { const int n = rho >> 4, i = rho & 15; return 8 * (i >> 2) + 4 * n + (i & 3); }
struct Unit { int pm, pn; };
struct Gemm { const bf16_t* A; const bf16_t* Bt; int M, N, K, lda, ldb, a_pn_bytes; };
struct StaticOrder {
    int nM, nN, nwg, G, c, owner;
    __device__ void init(int M, int N, int G_, int c_, int owner_ = 0) { nM = M / BM; nN = N / BM; nwg = nM * nN; G = G_; c = c_; owner = owner_; }
    __device__ bool next(int i, Unit& u) const {
        if (owner) { const int pm = c + (i / nN) * G; if (pm >= nM) return false; u.pm = pm; u.pn = i % nN; return true; }
        const long L = (long)i * G + c; if (L >= nwg) return false;
        int wgid = (int)L; { const int q = nwg / NXCD, r = nwg % NXCD, xcd = wgid % NXCD, off = wgid / NXCD; wgid = (xcd < r ? xcd * (q + 1) : r * (q + 1) + (xcd - r) * q) + off; }
        const int nig = WGM * nN, gid = wgid / nig, fm = gid * WGM, gsz = (nM - fm) < WGM ? (nM - fm) : WGM;
        u.pm = fm + ((wgid % nig) % gsz); u.pn = (wgid % nig) / gsz; return true;
    }
};

template <int OFF> __device__ __forceinline__ void ds_rd128(bf16x8& dst, unsigned addr) { asm volatile("ds_read_b128 %0, %1 offset:%2" : "=v"(dst) : "v"(addr), "n"(OFF)); }
template <class Epi, bool NARROW = false>
__device__ __forceinline__ void gemm_phase(LAS unsigned char* lds, const Gemm g, const StaticOrder& S, const Epi& E) {
    int tid_l = threadIdx.x; asm volatile("" : "+v"(tid_l));
    const int tid = tid_l, wid = __builtin_amdgcn_readfirstlane(tid >> 6), lane = tid & 63, wr = wid >> 2, wc = wid & 3, fr = lane & 15, fq = lane >> 4;
    const int K = g.K, nt = K / BK;
    unsigned voffA[2], voffB[2];
#pragma unroll
    for (int i = 0; i < 2; ++i) { int R, C; stage_rc(tid * 16 + i * 8192, R, C); const int Rb = Epi::PERM ? ((R & ~31) + perm32(R & 31)) : R;
        voffA[i] = (unsigned)(R * g.lda + C) * 2u; voffB[i] = (unsigned)(Rb * g.ldb + C) * 2u; }
    const size_t kstep = (size_t)(BK * 2);
    const size_t hsA = (size_t)HALF * g.lda * 2, hsB = (size_t)HALF * g.ldb * 2;
    const size_t tsA = 2 * hsA, tsB = 2 * hsB;
    const unsigned ldsw = (unsigned)wid * 1024u;
    const int aoff = lds_byte(wr * 64 + fr, fq * 8), boff = lds_byte(wc * 32 + fr, fq * 8);
    const unsigned aaddr = (unsigned)(unsigned long long)(lds + aoff), baddr = (unsigned)(unsigned long long)(lds + 4 * HTB + boff);
#define PG8_SA(b, h) (((b) * 2 + (h)) * HTB)
#define PG8_SB(b, h) ((4 + (b) * 2 + (h)) * HTB)
#define PG8_STAGE(bufoff, gbase, voff) do { _Pragma("unroll") for (int _i = 0; _i < 2; ++_i) \
        __builtin_amdgcn_global_load_lds((const unsigned*)((const char*)(gbase) + (voff)[_i]), (LAS unsigned*)(lds + (bufoff) + ldsw + _i * 8192), 16, 0, 0); } while (0)
#define PG8_LDA(dst, b, h) do { _Pragma("unroll") for (int m = 0; m < 4; ++m) _Pragma("unroll") for (int k = 0; k < 2; ++k) dst[m][k] = *(const LAS bf16x8*)(lds + PG8_SA(b, h) + aoff + m * 2048 + k * 1024); } while (0)
#define PG8_LDB(dst, b, h) do { _Pragma("unroll") for (int n = 0; n < 2; ++n) _Pragma("unroll") for (int k = 0; k < 2; ++k) dst[n][k] = *(const LAS bf16x8*)(lds + PG8_SB(b, h) + boff + n * 2048 + k * 1024); } while (0)
#define PG8_MMA(ai, bj, At, Bt) do { __builtin_amdgcn_s_setprio(1); _Pragma("unroll") for (int m = 0; m < 4; ++m) _Pragma("unroll") for (int n = 0; n < 2; ++n) _Pragma("unroll") for (int k = 0; k < 2; ++k) \
        acc[ai][bj][m][n] = __builtin_amdgcn_mfma_f32_16x16x32_bf16(Bt[n][k], At[m][k], acc[ai][bj][m][n], 0, 0, 0); __builtin_amdgcn_s_setprio(0); } while (0)
#define PG8_RDA(dst, b, h) do { ds_rd128<PG8_SA(b, h) + 0 * 2048>(dst[0][0], aaddr); ds_rd128<PG8_SA(b, h) + 1 * 2048>(dst[1][0], aaddr); ds_rd128<PG8_SA(b, h) + 2 * 2048>(dst[2][0], aaddr); ds_rd128<PG8_SA(b, h) + 3 * 2048>(dst[3][0], aaddr); \
        ds_rd128<PG8_SA(b, h) + 0 * 2048 + 1024>(dst[0][1], aaddr); ds_rd128<PG8_SA(b, h) + 1 * 2048 + 1024>(dst[1][1], aaddr); ds_rd128<PG8_SA(b, h) + 2 * 2048 + 1024>(dst[2][1], aaddr); ds_rd128<PG8_SA(b, h) + 3 * 2048 + 1024>(dst[3][1], aaddr); } while (0)
#define PG8_RDB(dst, b, h) do { ds_rd128<PG8_SA(b, h)>(dst[0][0], baddr); ds_rd128<PG8_SA(b, h) + 2048>(dst[1][0], baddr); ds_rd128<PG8_SA(b, h) + 1024>(dst[0][1], baddr); ds_rd128<PG8_SA(b, h) + 2048 + 1024>(dst[1][1], baddr); } while (0)
#define PG8_WAITA(n, F, k) asm volatile("s_waitcnt lgkmcnt(" #n ")" : "+v"(F[0][k]), "+v"(F[1][k]), "+v"(F[2][k]), "+v"(F[3][k]) :: "memory")
#define PG8_WAITB(n, F, k) asm volatile("s_waitcnt lgkmcnt(" #n ")" : "+v"(F[0][k]), "+v"(F[1][k]) :: "memory")
#define PG8_WAITAB(n, FA, FB) asm volatile("s_waitcnt lgkmcnt(" #n ")" : "+v"(FA[0][0]), "+v"(FA[1][0]), "+v"(FA[2][0]), "+v"(FA[3][0]), "+v"(FB[0][0]), "+v"(FB[1][0]), "+v"(FB[0][1]), "+v"(FB[1][1]) :: "memory")
#define PG8_MMAK(ai, bj, At, Bt, k) do { _Pragma("unroll") for (int m = 0; m < 4; ++m) _Pragma("unroll") for (int n = 0; n < 2; ++n) \
        acc[ai][bj][m][n] = __builtin_amdgcn_mfma_f32_16x16x32_bf16(Bt[n][k], At[m][k], acc[ai][bj][m][n], 0, 0, 0); } while (0)
#define PG8_PRIO(x) __builtin_amdgcn_s_setprio(x)
#define PG8_WAIT_V(n) asm volatile("s_waitcnt vmcnt(" #n ")" ::: "memory")
#define PG8_WAIT_L(n) asm volatile("s_waitcnt lgkmcnt(" #n ")" ::: "memory")
#define PG8_BAR __builtin_amdgcn_s_barrier()
#define PG8_SCHED __builtin_amdgcn_sched_barrier(0)
    Unit cur, nxt; int ui = 0;
    if (!S.next(0, cur)) return;
    f32x4 acc[2][2][4][2];
#pragma unroll
    for (int a = 0; a < 2; ++a)
#pragma unroll
        for (int b = 0; b < 2; ++b)
#pragma unroll
            for (int m = 0; m < 4; ++m)
#pragma unroll
                for (int n = 0; n < 2; ++n) acc[a][b][m][n] = (f32x4){0.f, 0.f, 0.f, 0.f};
    bf16x8 At[4][2], B0[2][2], B1[2][2];
    const char* cA = (const char*)g.A + (size_t)cur.pm * tsA + (size_t)cur.pn * g.a_pn_bytes; const char* cB = (const char*)g.Bt + (size_t)cur.pn * tsB;
    PG8_STAGE(PG8_SB(0, 0), cB, voffB); PG8_STAGE(PG8_SA(0, 0), cA, voffA); PG8_STAGE(PG8_SB(0, 1), cB + hsB, voffB); PG8_STAGE(PG8_SA(0, 1), cA + hsA, voffA);
    if (wr == 1) PG8_BAR;
    PG8_WAIT_V(4); PG8_BAR;
    PG8_STAGE(PG8_SB(1, 0), cB + kstep, voffB); PG8_STAGE(PG8_SA(1, 0), cA + kstep, voffA); PG8_STAGE(PG8_SB(1, 1), cB + hsB + kstep, voffB);
    PG8_WAIT_V(6); PG8_BAR;
    PG8_RDB(B0, 0, 0);
    for (;;) {
        const bool has_next = S.next(ui + 1, nxt);
        const char* nA = has_next ? (const char*)g.A + (size_t)nxt.pm * tsA + (size_t)nxt.pn * g.a_pn_bytes : cA; const char* nB = has_next ? (const char*)g.Bt + (size_t)nxt.pn * tsB : cB;
#pragma unroll 1
        for (int t = 0; t < nt; t += 2) {
            const bool last = (t == nt - 2);
            const char* a1 = cA + (size_t)(t + 1) * kstep;
            const char* a2 = last ? nA : cA + (size_t)(t + 2) * kstep; const char* b2 = last ? nB : cB + (size_t)(t + 2) * kstep;
            const char* a3 = a2 + kstep; const char* b3 = b2 + kstep;
            PG8_RDA(At, 0, 0); PG8_STAGE(PG8_SA(1, 1), a1 + hsA, voffA);
            PG8_WAIT_V(10); PG8_BAR; PG8_PRIO(1); PG8_WAITAB(4, At, B0); PG8_SCHED; PG8_MMAK(0, 0, At, B0, 0); PG8_SCHED; PG8_WAITA(0, At, 1); PG8_SCHED; PG8_MMAK(0, 0, At, B0, 1); PG8_PRIO(0); PG8_BAR; PG8_SCHED;
            PG8_RDB(B1, 0, 1); PG8_STAGE(PG8_SB(0, 0), b2, voffB);
            PG8_WAIT_V(10); PG8_BAR; PG8_PRIO(1); PG8_WAITB(2, B1, 0); PG8_SCHED; if (!NARROW) PG8_MMAK(0, 1, At, B1, 0); PG8_SCHED; PG8_WAITB(0, B1, 1); PG8_SCHED; if (!NARROW) PG8_MMAK(0, 1, At, B1, 1); PG8_PRIO(0); PG8_BAR; PG8_SCHED;
            PG8_RDA(At, 0, 1); PG8_STAGE(PG8_SA(0, 0), a2, voffA);
            PG8_WAIT_V(10); PG8_BAR; PG8_PRIO(1); PG8_WAITA(4, At, 0); PG8_SCHED; PG8_MMAK(1, 0, At, B0, 0); PG8_SCHED; PG8_WAITA(0, At, 1); PG8_SCHED; PG8_MMAK(1, 0, At, B0, 1); PG8_PRIO(0); PG8_BAR; PG8_SCHED;
            PG8_RDB(B0, 1, 0); PG8_STAGE(PG8_SB(0, 1), b2 + hsB, voffB);
            PG8_WAIT_V(10); PG8_BAR; if (!NARROW) PG8_MMA(1, 1, At, B1); PG8_BAR; PG8_SCHED;
            PG8_RDA(At, 1, 0); PG8_STAGE(PG8_SA(0, 1), a2 + hsA, voffA);
            PG8_WAIT_V(10); PG8_BAR; PG8_PRIO(1); PG8_WAITAB(4, At, B0); PG8_SCHED; PG8_MMAK(0, 0, At, B0, 0); PG8_SCHED; PG8_WAITA(0, At, 1); PG8_SCHED; PG8_MMAK(0, 0, At, B0, 1); PG8_PRIO(0); PG8_BAR; PG8_SCHED;
            PG8_RDB(B1, 1, 1); PG8_STAGE(PG8_SB(1, 0), b3, voffB);
            PG8_WAIT_V(10); PG8_BAR; PG8_PRIO(1); PG8_WAITB(2, B1, 0); PG8_SCHED; if (!NARROW) PG8_MMAK(0, 1, At, B1, 0); PG8_SCHED; PG8_WAITB(0, B1, 1); PG8_SCHED; if (!NARROW) PG8_MMAK(0, 1, At, B1, 1); PG8_PRIO(0); PG8_BAR; PG8_SCHED;
            PG8_RDA(At, 1, 1); PG8_STAGE(PG8_SA(1, 0), a3, voffA);
            PG8_WAIT_V(10); PG8_BAR; PG8_PRIO(1); PG8_WAITA(4, At, 0); PG8_SCHED; PG8_MMAK(1, 0, At, B0, 0); PG8_SCHED; PG8_WAITA(0, At, 1); PG8_SCHED; PG8_MMAK(1, 0, At, B0, 1); PG8_PRIO(0); PG8_BAR; PG8_SCHED;
            if (!last) PG8_RDB(B0, 0, 0);
            PG8_STAGE(PG8_SB(1, 1), b3 + hsB, voffB);
            PG8_WAIT_V(10); PG8_BAR; if (!NARROW) PG8_MMA(1, 1, At, B1); PG8_BAR; PG8_SCHED;
        }
        E(acc, cur, wr, wc, fr, fq);
        if (!has_next) break;
#pragma unroll
        for (int a = 0; a < 2; ++a)
#pragma unroll
            for (int b = 0; b < 2; ++b)
#pragma unroll
                for (int m = 0; m < 4; ++m)
#pragma unroll
                    for (int n = 0; n < 2; ++n) acc[a][b][m][n] = (f32x4){0.f, 0.f, 0.f, 0.f};
        cur = nxt; cA = nA; cB = nB; ++ui;
        PG8_RDB(B0, 0, 0);
    }
    PG8_WAIT_V(0);
    if (wr == 0) PG8_BAR;
    PG8_BAR;
#undef PG8_SA
#undef PG8_SB
#undef PG8_STAGE
#undef PG8_LDA
#undef PG8_LDB
#undef PG8_MMA
#undef PG8_MMAK
#undef PG8_RDA
#undef PG8_RDB
#undef PG8_WAITA
#undef PG8_WAITB
#undef PG8_WAITAB
#undef PG8_PRIO
#undef PG8_WAIT_V
#undef PG8_WAIT_L
#undef PG8_BAR
#undef PG8_SCHED
}

typedef const f32x4 (&AccRef)[2][2][4][2];

struct EpiG1 {
    static constexpr bool PERM = true;
    bf16_t* zs; bf16_t* xbc; float* dtb; const float* dt_bias; int pn_off;
    __device__ __forceinline__ void operator()(AccRef acc, const Unit& u, int wr, int wc, int fr, int fq) const {
        const int row0 = u.pm * BM + wr * 64 + fr, pn = u.pn + pn_off;
        if (pn < 24) {
            const bool act = pn < 8;
            bf16_t* base = act ? zs : xbc; const int ld = act ? 2048 : 4096; const int colt = act ? pn * 256 : (pn - 8) * 256;
            const int col0 = colt + wc * 32 + 8 * fq;
#pragma unroll
            for (int ai = 0; ai < 2; ++ai)
#pragma unroll
                for (int m = 0; m < 4; ++m) { bf16_t* rowp = base + (size_t)(row0 + ai * HALF + m * 16) * ld + col0;
#pragma unroll
                    for (int bj = 0; bj < 2; ++bj) { f32x4 v0 = acc[ai][bj][m][0], v1 = acc[ai][bj][m][1];
                        if (act) {
#pragma unroll
                            for (int j = 0; j < 4; ++j) { v0[j] = siluf_(v0[j]); v1[j] = siluf_(v1[j]); } }
                        *(u32x4*)(rowp + bj * HALF) = pack8(v0, v1); } }
        } else if (wc == 0) {
            const int c0 = 8 * fq; const f32x4 b0 = *(const f32x4*)(dt_bias + c0), b1 = *(const f32x4*)(dt_bias + c0 + 4);
#pragma unroll
            for (int ai = 0; ai < 2; ++ai)
#pragma unroll
                for (int m = 0; m < 4; ++m) { float* rowp = dtb + (size_t)(row0 + ai * HALF + m * 16) * 32 + c0;
                    f32x4 v0 = acc[ai][0][m][0] + b0, v1 = acc[ai][0][m][1] + b1;
#pragma unroll
                    for (int j = 0; j < 4; ++j) { v0[j] = softplusf_(v0[j]); v1[j] = softplusf_(v1[j]); }
                    *(f32x4*)rowp = v0; *(f32x4*)(rowp + 4) = v1; }
        }
    }
};
struct EpiG2 {
    static constexpr bool PERM = true;
    bf16_t* upool; bf16_t* gates; const float* b_gates;
    __device__ __forceinline__ void operator()(AccRef acc, const Unit& u, int wr, int wc, int fr, int fq) const {
        const int row0 = u.pm * BM + wr * 64 + fr, pn = u.pn;
        const bool act = pn >= 4;
        bf16_t* base = act ? gates : upool; const int ld = act ? 2048 : 1024; const int colt = act ? (pn - 4) * 256 : pn * 256;
        const int col0 = colt + wc * 32 + 8 * fq;
        f32x4 bv[2][2];
#pragma unroll
        for (int bj = 0; bj < 2; ++bj)
#pragma unroll
            for (int n = 0; n < 2; ++n) bv[bj][n] = act ? *(const f32x4*)(b_gates + col0 + bj * HALF + 4 * n) : (f32x4){0.f, 0.f, 0.f, 0.f};
#pragma unroll
        for (int ai = 0; ai < 2; ++ai)
#pragma unroll
            for (int m = 0; m < 4; ++m) { bf16_t* rowp = base + (size_t)(row0 + ai * HALF + m * 16) * ld + col0;
#pragma unroll
                for (int bj = 0; bj < 2; ++bj) { f32x4 v0 = acc[ai][bj][m][0] + bv[bj][0], v1 = acc[ai][bj][m][1] + bv[bj][1];
                    if (act) {
#pragma unroll
                        for (int j = 0; j < 4; ++j) { v0[j] = sigmoidf_(v0[j]); v1[j] = sigmoidf_(v1[j]); } }
                    *(u32x4*)(rowp + bj * HALF) = pack8(v0, v1); } }
    }
};
template <bool FIRST> struct EpiPool {
    static constexpr bool PERM = true;
    bf16_t* merged; const bf16_t* gates;
    __device__ __forceinline__ void operator()(AccRef acc, const Unit& u, int wr, int wc, int fr, int fq) const {
        const int row0 = u.pm * BM + wr * 64 + fr; const int col0 = u.pn * 256 + wc * 32 + 8 * fq;
#pragma unroll
        for (int ai = 0; ai < 2; ++ai) {
            u32x4 gw[4][2], pw[4][2];
#pragma unroll
            for (int m = 0; m < 4; ++m)
#pragma unroll
                for (int bj = 0; bj < 2; ++bj) { const size_t row = (size_t)(row0 + ai * HALF + m * 16);
                    gw[m][bj] = *(const u32x4*)(gates + row * 2048 + col0 + bj * HALF); if (!FIRST) pw[m][bj] = *(const u32x4*)(merged + row * 1024 + col0 + bj * HALF); }
#pragma unroll
            for (int m = 0; m < 4; ++m) { const size_t row = (size_t)(row0 + ai * HALF + m * 16);
#pragma unroll
                for (int bj = 0; bj < 2; ++bj) { f32x4 g0, g1, p0 = {0.f, 0.f, 0.f, 0.f}, p1 = {0.f, 0.f, 0.f, 0.f}; unpack8(gw[m][bj], g0, g1); if (!FIRST) unpack8(pw[m][bj], p0, p1);
                    const f32x4 v0 = p0 + acc[ai][bj][m][0] * g0, v1 = p1 + acc[ai][bj][m][1] * g1;
                    *(u32x4*)(merged + row * 1024 + col0 + bj * HALF) = pack8(v0, v1); } }
            asm volatile("" ::: "memory");
        }
    }
};
template <bool FIRST> struct EpiSsd {
    static constexpr bool PERM = true;
    bf16_t* merged; const bf16_t* gates;
    __device__ __forceinline__ void operator()(AccRef acc, const Unit& u, int wr, int wc, int fr, int fq) const {
        const int row0 = u.pm * BM + wr * 64 + fr; const int col0 = u.pn * 256 + wc * 32 + 8 * fq;
#pragma unroll
        for (int ai = 0; ai < 2; ++ai) {
            u32x4 gw[4][2], pw[4][2];
#pragma unroll
            for (int m = 0; m < 4; ++m)
#pragma unroll
                for (int bj = 0; bj < 2; ++bj) { const size_t row = (size_t)(row0 + ai * HALF + m * 16);
                    gw[m][bj] = *(const u32x4*)(gates + row * 2048 + 1024 + col0 + bj * HALF); if (!FIRST) pw[m][bj] = *(const u32x4*)(merged + row * 1024 + col0 + bj * HALF); }
#pragma unroll
            for (int m = 0; m < 4; ++m) { const size_t row = (size_t)(row0 + ai * HALF + m * 16);
#pragma unroll
                for (int bj = 0; bj < 2; ++bj) { f32x4 g0, g1, p0 = {0.f, 0.f, 0.f, 0.f}, p1 = {0.f, 0.f, 0.f, 0.f}; unpack8(gw[m][bj], g0, g1); if (!FIRST) unpack8(pw[m][bj], p0, p1);
                    const f32x4 v0 = p0 + acc[ai][bj][m][0] * g0, v1 = p1 + acc[ai][bj][m][1] * g1;
                    *(u32x4*)(merged + row * 1024 + col0 + bj * HALF) = pack8(v0, v1); } }
            asm volatile("" ::: "memory");
        }
    }
};
struct EpiUp {
    static constexpr bool PERM = true;
    bf16_t* upb;
    __device__ __forceinline__ void operator()(AccRef acc, const Unit& u, int wr, int wc, int fr, int fq) const {
        const int row0 = u.pm * BM + wr * 64 + fr; const int col0 = u.pn * 256 + wc * 32 + 8 * fq;
#pragma unroll
        for (int ai = 0; ai < 2; ++ai)
#pragma unroll
            for (int m = 0; m < 4; ++m) { bf16_t* rowp = upb + (size_t)(row0 + ai * HALF + m * 16) * DFF + col0;
#pragma unroll
                for (int bj = 0; bj < 2; ++bj) { f32x4 v0 = acc[ai][bj][m][0], v1 = acc[ai][bj][m][1];
#pragma unroll
                    for (int j = 0; j < 4; ++j) { const float a = fmaxf(v0[j], 0.f), b = fmaxf(v1[j], 0.f); v0[j] = a * a; v1[j] = b * b; }
                    *(u32x4*)(rowp + bj * HALF) = pack8(v0, v1); } }
    }
};
struct EpiOut {
    static constexpr bool PERM = true;
    const float* x; bf16_t* v;
    __device__ __forceinline__ void operator()(AccRef acc, const Unit& u, int wr, int wc, int fr, int fq) const {
        const int row0 = u.pm * BM + wr * 64 + fr, col0 = u.pn * BM + wc * 32 + 8 * fq;
#pragma unroll
        for (int ai = 0; ai < 2; ++ai) {
            f32x4 xv[4][2][2];
#pragma unroll
            for (int m = 0; m < 4; ++m)
#pragma unroll
                for (int bj = 0; bj < 2; ++bj)
#pragma unroll
                    for (int n = 0; n < 2; ++n) xv[m][bj][n] = *(const f32x4*)(x + (size_t)(row0 + ai * HALF + m * 16) * DM + col0 + bj * HALF + n * 4);
#pragma unroll
            for (int m = 0; m < 4; ++m) { const size_t off = (size_t)(row0 + ai * HALF + m * 16) * DM + col0;
#pragma unroll
                for (int bj = 0; bj < 2; ++bj) *(u32x4*)(v + off + bj * HALF) = pack8(xv[m][bj][0] * ALPHA + acc[ai][bj][m][0], xv[m][bj][1] * ALPHA + acc[ai][bj][m][1]); }
            asm volatile("" ::: "memory");
        }
    }
};
struct EpiDown {
    static constexpr bool PERM = true;
    const bf16_t* h1b; bf16_t* y;
    __device__ __forceinline__ void operator()(AccRef acc, const Unit& u, int wr, int wc, int fr, int fq) const {
        const int row0 = u.pm * BM + wr * 64 + fr, col0 = u.pn * BM + wc * 32 + 8 * fq;
        u32x4 hw[2][4][2];
#pragma unroll
        for (int ai = 0; ai < 2; ++ai)
#pragma unroll
            for (int m = 0; m < 4; ++m)
#pragma unroll
                for (int bj = 0; bj < 2; ++bj) hw[ai][m][bj] = *(const u32x4*)(h1b + (size_t)(row0 + ai * HALF + m * 16) * DM + col0 + bj * HALF);
#pragma unroll
        for (int ai = 0; ai < 2; ++ai)
#pragma unroll
            for (int m = 0; m < 4; ++m) { const size_t off = (size_t)(row0 + ai * HALF + m * 16) * DM + col0;
#pragma unroll
                for (int bj = 0; bj < 2; ++bj) { f32x4 h0, h1; unpack8(hw[ai][m][bj], h0, h1);
                    *(u32x4*)(y + off + bj * HALF) = pack8(h0 * ALPHA + acc[ai][bj][m][0], h1 * ALPHA + acc[ai][bj][m][1]); } }
    }
};
}

struct TrJob { const float* src; int ld_src, col0, K, ncols, nvalid; bf16_t* dst; int ld_dst; const float* cscale; };
__device__ __forceinline__ int tr_tiles(int K, int ncols) { return (K / 64) * (ncols / 256); }
__device__ __forceinline__ bool tr_pick(const Params& p, int gt, TrJob& J, int& lt) {
    unsigned char* ws = p.ws; const float* w_in = p.in[1];
    bf16_t* win1 = (bf16_t*)(ws + WS_WIN1); bf16_t* win2 = (bf16_t*)(ws + WS_WIN2);
    int base = 0, n;
#define TRJ(SRC, LDS_, COL0, K_, NC, NV, DST, LDD, CS) do { n = tr_tiles((K_), (NC)); if (gt < base + n) { J.src = (SRC); J.ld_src = (LDS_); J.col0 = (COL0); J.K = (K_); J.ncols = (NC); J.nvalid = (NV); J.dst = (DST); J.ld_dst = (LDD); J.cscale = (CS); lt = gt - base; return true; } base += n; } while (0)
    TRJ(w_in, 9248, 3072, 1024, 4096, 4096, win1 + (size_t)2048 * 1024, 1024, nullptr);
    TRJ(p.in[15], 4096, 0, 1024, 4096, 4096, (bf16_t*)(ws + WS_WUP), 1024, nullptr);
    TRJ(p.in[16], 1024, 0, 4096, 1024, 1024, (bf16_t*)(ws + WS_WDN), 4096, nullptr);
    TRJ(w_in, 9248, 1024, 1024, 2048, 2048, win1, 1024, nullptr);
    TRJ(w_in, 9248, 7200, 1024, 2048, 2048, win2 + (size_t)1024 * 1024, 1024, nullptr);
    TRJ(p.in[9], 1024, 0, 2048, 1024, 1024, (bf16_t*)(ws + WS_WSSD), 2048, nullptr);
    TRJ(w_in, 9248, 0, 1024, 1024, 1024, win2, 1024, nullptr);
    TRJ(p.in[12], 1024, 0, 1024, 1024, 1024, (bf16_t*)(ws + WS_WOUT), 1024, nullptr);
    TRJ(w_in, 9248, 7168, 1024, 256, 32, win1 + (size_t)6144 * 1024, 1024, nullptr);
    TRJ(p.in[10], 256, 0, 256, 256, 256, (bf16_t*)(ws + WS_WP), 256, p.in[11]);
    TRJ(p.in[10] + 65536, 256, 0, 256, 256, 256, (bf16_t*)(ws + WS_WP) + 65536, 256, p.in[11] + 256);
    TRJ(p.in[10] + 2 * 65536, 256, 0, 256, 256, 256, (bf16_t*)(ws + WS_WP) + 2 * 65536, 256, p.in[11] + 512);
    TRJ(p.in[10] + 3 * 65536, 256, 0, 256, 256, 256, (bf16_t*)(ws + WS_WP) + 3 * 65536, 256, p.in[11] + 768);
#undef TRJ
    return false;
}
__device__ void phase0(const Params& p, unsigned char* smem) {
    unsigned char* ws = p.ws;
    { const float* __restrict__ x = p.in[0]; bf16_t* __restrict__ xb = (bf16_t*)(ws + WS_RC);
      const size_t nvec = (size_t)T_TOK * DM / 8, stride = (size_t)gridDim.x * blockDim.x;
      for (size_t i = (size_t)blockIdx.x * blockDim.x + threadIdx.x; i < nvec; i += 4 * stride) {
          f32x4 a[4], b[4];
#pragma unroll
          for (int k = 0; k < 4; ++k) { a[k] = *(const f32x4*)(x + (i + k * stride) * 8); b[k] = *(const f32x4*)(x + (i + k * stride) * 8 + 4); }
#pragma unroll
          for (int k = 0; k < 4; ++k) *(u32x4*)(xb + (i + k * stride) * 8) = pack8(a[k], b[k]); } }
    float* t = (float*)smem;
    const int tid = threadIdx.x;
    for (int gt = blockIdx.x; ; gt += gridDim.x) {
        TrJob J; int lt;
        if (!tr_pick(p, gt, J, lt)) break;
        const int tn = J.ncols / 256; const int k0 = (lt / tn) * 64, n0 = (lt % tn) * 256;
        __syncthreads();
        float v[4][8];
#pragma unroll
        for (int sb = 0; sb < 4; ++sb)
#pragma unroll
            for (int i = 0; i < 8; ++i) { const int k = (tid >> 6) + 8 * i, n = n0 + sb * 64 + (tid & 63); const int nc = n < J.nvalid ? n : 0;
                const float ld = J.src[(size_t)(k0 + k) * J.ld_src + J.col0 + nc]; v[sb][i] = n < J.nvalid ? ld : 0.f; }
#pragma unroll
        for (int sb = 0; sb < 4; ++sb) { const float sc = J.cscale ? J.cscale[n0 + sb * 64 + (tid & 63)] : 1.0f;
#pragma unroll
            for (int i = 0; i < 8; ++i) t[(sb * 64 + (tid >> 6) + 8 * i) * 65 + (tid & 63)] = v[sb][i] * sc; }
        __syncthreads();
        const int n = tid >> 3, kk = (tid & 7) * 8;
#pragma unroll
        for (int sb = 0; sb < 4; ++sb) { float e[8];
#pragma unroll
            for (int j = 0; j < 8; ++j) e[j] = t[(sb * 64 + kk + j) * 65 + n];
            u32x4 w; w.x = cvt_pk_bf16(e[0], e[1]); w.y = cvt_pk_bf16(e[2], e[3]); w.z = cvt_pk_bf16(e[4], e[5]); w.w = cvt_pk_bf16(e[6], e[7]);
            *(u32x4*)(J.dst + (size_t)(n0 + sb * 64 + n) * J.ld_dst + k0 + kk) = w; }
    }
}

__device__ void phase_ssd_simple(const Params& p, unsigned char* smem) {
    unsigned char* ws = p.ws;
    const bf16_t* xbc = (const bf16_t*)(ws + WS_RA); bf16_t* zy = (bf16_t*)(ws + WS_RB); const float* dtb = (const float*)(ws + WS_DT);
    const float* conv_w = p.in[3]; const float* conv_b = p.in[4]; const float* a_log = p.in[6]; const float* d_skip = p.in[7]; const float* norm_w = p.in[8];
    float* sX = (float*)smem;
    float* sY = sX + 16 * 512;
    float* sdt = sY + 16 * 256;
    const int tid = threadIdx.x;
    for (int item = blockIdx.x; item < 256; item += gridDim.x) {
        const int b = item >> 3, g = item & 7;
        const int ch = tid; int gcol;
        if (ch < 256) gcol = g * 256 + ch; else if (ch < 384) gcol = 2048 + g * 128 + (ch - 256); else gcol = 3072 + g * 128 + (ch - 384);
        const float cw0 = conv_w[gcol], cw1 = conv_w[4096 + gcol], cw2 = conv_w[8192 + gcol], cw3 = conv_w[12288 + gcol], cb = conv_b[gcol];
        float u1 = 0.f, u2 = 0.f, u3 = 0.f;
        const int r = tid >> 7, pp = (tid & 127) >> 1, nh = tid & 1;
        const float a_r = -__expf(a_log[g * 4 + r]), d_r = d_skip[g * 4 + r];
        float hst[64];
#pragma unroll
        for (int i = 0; i < 64; ++i) hst[i] = 0.f;
        for (int blk = 0; blk < SEQ / 16; ++blk) {
            const size_t t0 = (size_t)b * SEQ + (size_t)blk * 16;
#pragma unroll 4
            for (int tt = 0; tt < 16; ++tt) { const float raw = bf2f(xbc[(t0 + tt) * 4096 + gcol]);
                const float y = cb + cw0 * u1 + cw1 * u2 + cw2 * u3 + cw3 * raw; u1 = u2; u2 = u3; u3 = raw;
                sX[tt * 512 + ch] = siluf_(y); }
            if (tid < 64) sdt[tid] = dtb[(t0 + (tid >> 2)) * 32 + g * 4 + (tid & 3)];
            __syncthreads();
            for (int tt = 0; tt < 16; ++tt) {
                const float dt = sdt[tt * 4 + r], dec = __expf(dt * a_r), xv = sX[tt * 512 + r * 64 + pp], xdt = xv * dt;
                const float* Bp = sX + tt * 512 + 256 + nh * 64; const float* Cp = sX + tt * 512 + 384 + nh * 64;
                float y = 0.f;
#pragma unroll
                for (int i = 0; i < 64; ++i) { hst[i] = hst[i] * dec + xdt * Bp[i]; y += hst[i] * Cp[i]; }
                y += __shfl_xor(y, 1);
                if (nh == 0) { const float zv = bf2f(zy[(t0 + tt) * 2048 + g * 256 + r * 64 + pp]); sY[tt * 256 + r * 64 + pp] = (y + d_r * xv) * zv; }
            }
            __syncthreads();
            { const int tt = tid >> 5, c0 = (tid & 31) * 8; float e[8]; float ss = 0.f;
#pragma unroll
              for (int j = 0; j < 8; ++j) { e[j] = sY[tt * 256 + c0 + j]; ss += e[j] * e[j]; }
              ss += __shfl_xor(ss, 16); ss += __shfl_xor(ss, 8); ss += __shfl_xor(ss, 4); ss += __shfl_xor(ss, 2); ss += __shfl_xor(ss, 1);
              const float rstd = rsqrtf(ss * (1.0f / 256.0f) + RMS_EPS);
              const f32x4 w0 = *(const f32x4*)(norm_w + g * 256 + c0), w1 = *(const f32x4*)(norm_w + g * 256 + c0 + 4);
              u32x4 o; o.x = cvt_pk_bf16(e[0] * rstd * w0[0], e[1] * rstd * w0[1]); o.y = cvt_pk_bf16(e[2] * rstd * w0[2], e[3] * rstd * w0[3]);
              o.z = cvt_pk_bf16(e[4] * rstd * w1[0], e[5] * rstd * w1[1]); o.w = cvt_pk_bf16(e[6] * rstd * w1[2], e[7] * rstd * w1[3]);
              *(u32x4*)(zy + (t0 + tt) * 2048 + g * 256 + c0) = o; }
            __syncthreads();
        }
    }
}


constexpr int SX_STR = 144, SN_STR = 272, SZ_STR = 528;
constexpr int O_XT = 0;
constexpr int O_BT = O_XT + 256 * SX_STR;
constexpr int O_BN = O_BT + 128 * SX_STR;
constexpr int O_CN = O_BN + 64 * SN_STR;
constexpr int O_CB = O_CN + 64 * SN_STR;
constexpr int O_ZT = O_CB + 64 * SN_STR;
constexpr int O_ACS = O_ZT + 64 * SZ_STR;
constexpr int O_DT = O_ACS + 1024;
constexpr int O_WG = O_DT + 1024;
constexpr int O_EA = O_WG + 1024;
constexpr int O_SSQ = O_EA + 1024;
constexpr int O_RSTD = O_SSQ + 2048;
constexpr int O_CW = O_RSTD + 256;
constexpr int O_RSW = O_CW + 5 * 512 * 4;
constexpr int SSD_LDS = O_RSW + 2048;
static_assert(SSD_LDS <= LDS_BYTES, "LDS");
#define MFMA16(a, b, c) __builtin_amdgcn_mfma_f32_16x16x32_bf16((a), (b), (c), 0, 0, 0)

template <int CTRL> __device__ __forceinline__ float dpp_add(float v) { return v + __builtin_bit_cast(float, __builtin_amdgcn_update_dpp(0, __builtin_bit_cast(int, v), CTRL, 0xf, 0xf, false)); }
__device__ __forceinline__ float row16_sum(float v) { v = dpp_add<0xB1>(v); v = dpp_add<0x4E>(v); v = dpp_add<0x124>(v); v = dpp_add<0x128>(v); return v; }
__device__ __forceinline__ f32x4 unpack4(u32x2 w) { return (f32x4){bf_lo(w.x), bf_hi(w.x), bf_lo(w.y), bf_hi(w.y)}; }

__device__ void phase_ssd(const Params& p, LAS unsigned char* sm) {
    unsigned char* ws = p.ws;
    const bf16_t* xbc = (const bf16_t*)(ws + WS_RA); bf16_t* zy = (bf16_t*)(ws + WS_RB); const float* dtb = (const float*)(ws + WS_DT);
    const float* conv_w = p.in[3]; const float* conv_b = p.in[4]; const float* a_log = p.in[6]; const float* d_skip = p.in[7]; const float* norm_w = p.in[8];
    const int tid = threadIdx.x, lane = tid & 63, w = __builtin_amdgcn_readfirstlane(tid >> 6), c = lane & 15, q = lane >> 4;
    const int r = w >> 1, ph = w & 1;
    const int tq = tid >> 7, ch0 = (tid & 127) * 4;
    LAS float* ACS = (LAS float*)(sm + O_ACS); LAS float* DTV = (LAS float*)(sm + O_DT); LAS float* WG = (LAS float*)(sm + O_WG); LAS float* EA = (LAS float*)(sm + O_EA);
    LAS float* SSQ = (LAS float*)(sm + O_SSQ); LAS float* RSTD = (LAS float*)(sm + O_RSTD);
    for (int item = blockIdx.x; item < 256; item += gridDim.x) {
        const int b = item >> 3, g = item & 7;
#define SSD_GCOL(CH) ((CH) < 256 ? g * 256 + (CH) : ((CH) < 384 ? 1792 + g * 128 + (CH) : 2688 + g * 128 + (CH)))
        { const int gcol = SSD_GCOL(ch0);
        __syncthreads();
        if (tq == 0) {
#pragma unroll
            for (int k = 0; k < 4; ++k) *(LAS f32x4*)(sm + O_CW + (k * 512 + ch0) * 4) = *(const f32x4*)(conv_w + k * 4096 + gcol);
            *(LAS f32x4*)(sm + O_CW + (4 * 512 + ch0) * 4) = *(const f32x4*)(conv_b + gcol); }
        __syncthreads(); }
        const float d_r = d_skip[g * 4 + r];
        const float a_w = -__expf(a_log[g * 4 + (w & 3)]);
        const int prow0 = r * 64 + ph * 32 + c;
        const float nw0 = norm_w[g * 256 + prow0], nw1 = norm_w[g * 256 + prow0 + 16];
        f32x4 accH[8][2];
#pragma unroll
        for (int nt = 0; nt < 8; ++nt)
#pragma unroll
            for (int pt = 0; pt < 2; ++pt) accH[nt][pt] = (f32x4){0.f, 0.f, 0.f, 0.f};
        u32x2 raw[19]; u32x4 zr[4]; float dtn = 0.f;
#define SSD_ISSUE(SUBN) do { int sn_ = (SUBN); asm volatile("" : "+s"(sn_)); int tid_ = tid; asm volatile("" : "+v"(tid_)); const int ch_ = (tid_ & 127) * 4; const int gc_ = SSD_GCOL(ch_); \
            const int sl0_ = sn_ * 64 + (tid_ >> 7) * 16 - 3; const bf16_t* rp_ = xbc + ((size_t)b * SEQ + (sl0_ < 0 ? 0 : sl0_)) * 4096 + gc_; \
            _Pragma("unroll") for (int i = 0; i < 19; ++i) { const int sl = sl0_ + i; \
                const u32x2 v = *(const u32x2*)(rp_ + (sl0_ < 0 ? (i < 3 ? 0 : i - 3) : i) * 4096); raw[i].x = sl < 0 ? 0u : v.x; raw[i].y = sl < 0 ? 0u : v.y; } \
            const bf16_t* zp_ = zy + ((size_t)b * SEQ + (size_t)sn_ * 64 + (tid_ >> 5)) * 2048 + g * 256 + (tid_ & 31) * 8; \
            _Pragma("unroll") for (int k = 0; k < 4; ++k) zr[k] = *(const u32x4*)(zp_ + (size_t)k * 16 * 2048); \
            if (w < 4) dtn = dtb[((size_t)b * SEQ + (size_t)sn_ * 64 + lane) * 32 + g * 4 + w]; } while (0)
        SSD_ISSUE(0);
#pragma unroll 1
        for (int sub = 0; sub < SEQ / 64; ++sub) {
            const size_t t0 = (size_t)b * SEQ + (size_t)sub * 64;
            {
                const f32x4 cw0 = *(const LAS f32x4*)(sm + O_CW + ch0 * 4), cw1 = *(const LAS f32x4*)(sm + O_CW + (512 + ch0) * 4), cw2 = *(const LAS f32x4*)(sm + O_CW + (1024 + ch0) * 4),
                            cw3 = *(const LAS f32x4*)(sm + O_CW + (1536 + ch0) * 4), cbv = *(const LAS f32x4*)(sm + O_CW + (2048 + ch0) * 4);
                f32x4 u0 = unpack4(raw[0]), u1 = unpack4(raw[1]), u2 = unpack4(raw[2]);
                unsigned tr[4][8]; f32x4 pv = {0.f, 0.f, 0.f, 0.f};
                LAS unsigned char* nb = ch0 < 384 ? sm + O_BN + (ch0 - 256) * 2 : sm + O_CN + (ch0 - 384) * 2;
#pragma unroll
                for (int i = 0; i < 16; ++i) {
                    const f32x4 u3 = unpack4(raw[i + 3]);
                    f32x4 y = cbv + cw0 * u0 + cw1 * u1 + cw2 * u2 + cw3 * u3;
#pragma unroll
                    for (int j = 0; j < 4; ++j) y[j] = siluf_(y[j]);
                    if (ch0 >= 256) *(LAS u32x2*)(nb + (tq * 16 + i) * SN_STR) = (u32x2){cvt_pk_bf16(y[0], y[1]), cvt_pk_bf16(y[2], y[3])};
                    if (i & 1) {
#pragma unroll
                        for (int j = 0; j < 4; ++j) tr[j][i >> 1] = cvt_pk_bf16(pv[j], y[j]); }
                    else pv = y;
                    u0 = u1; u1 = u2; u2 = u3;
                }
                if (ch0 < 384) {
                    LAS unsigned char* tb = ch0 < 256 ? sm + O_XT + ch0 * SX_STR : sm + O_BT + (ch0 - 256) * SX_STR;
#pragma unroll
                    for (int j = 0; j < 4; ++j) { *(LAS u32x4*)(tb + j * SX_STR + tq * 32) = (u32x4){tr[j][0], tr[j][1], tr[j][2], tr[j][3]};
                        *(LAS u32x4*)(tb + j * SX_STR + tq * 32 + 16) = (u32x4){tr[j][4], tr[j][5], tr[j][6], tr[j][7]}; }
                }
            }
            if (w < 4) {
                const float dt = dtn; float x = dt * a_w;
#pragma unroll
                for (int o = 1; o < 64; o <<= 1) { const float v = __shfl_up(x, o); if (lane >= o) x += v; }
                const float last = __shfl(x, 63);
                ACS[w * 64 + lane] = x; DTV[w * 64 + lane] = dt; WG[w * 64 + lane] = dt * __expf(last - x); EA[w * 64 + lane] = __expf(x);
            }
            __syncthreads();
            {
#pragma unroll
                for (int k = 0; k < 4; ++k) { const int v = tid + 512 * k, l = v >> 5, c8 = (v & 31) * 8; *(LAS u32x4*)(sm + O_ZT + l * SZ_STR + c8 * 2) = zr[k]; }
                const int lt = w >> 1;
#pragma unroll
                for (int sti = 0; sti < 2; ++sti) { const int st = 2 * (w & 1) + sti; f32x4 acc = {0.f, 0.f, 0.f, 0.f};
#pragma unroll
                    for (int ks = 0; ks < 4; ++ks) { const bf16x8 a = *(const LAS bf16x8*)(sm + O_CN + (16 * lt + c) * SN_STR + (32 * ks + 8 * q) * 2);
                        const bf16x8 bb = *(const LAS bf16x8*)(sm + O_BN + (16 * st + c) * SN_STR + (32 * ks + 8 * q) * 2); acc = MFMA16(a, bb, acc); }
#pragma unroll
                    for (int rg = 0; rg < 4; ++rg) *(LAS float*)(sm + O_CB + (16 * lt + 4 * q + rg) * SN_STR + (16 * st + c) * 4) = acc[rg]; }
            }
            __syncthreads();
            f32x4 accY[4][2];
#pragma unroll
            for (int lt = 0; lt < 4; ++lt)
#pragma unroll
                for (int pt = 0; pt < 2; ++pt) accY[lt][pt] = (f32x4){0.f, 0.f, 0.f, 0.f};
#pragma unroll
            for (int ks = 0; ks < 4; ++ks) {
                bf16x8 hb[2];
#pragma unroll
                for (int pt = 0; pt < 2; ++pt) hb[pt] = __builtin_bit_cast(bf16x8, pack8(accH[2 * ks][pt], accH[2 * ks + 1][pt]));
#pragma unroll
                for (int lt = 0; lt < 4; ++lt) { const LAS unsigned char* cp = sm + O_CN + (16 * lt + c) * SN_STR + (32 * ks + 4 * q) * 2;
                    const u32x2 lo = *(const LAS u32x2*)cp, hi = *(const LAS u32x2*)(cp + 32);
                    const bf16x8 a = __builtin_bit_cast(bf16x8, (u32x4){lo.x, lo.y, hi.x, hi.y});
#pragma unroll
                    for (int pt = 0; pt < 2; ++pt) accY[lt][pt] = MFMA16(a, hb[pt], accY[lt][pt]); }
            }
#pragma unroll
            for (int lt = 0; lt < 4; ++lt) { const f32x4 e = *(const LAS f32x4*)(EA + r * 64 + 16 * lt + 4 * q);
#pragma unroll
                for (int pt = 0; pt < 2; ++pt) accY[lt][pt] *= e; }
            bf16x8 xf[2][2];
#pragma unroll
            for (int ks = 0; ks < 2; ++ks)
#pragma unroll
                for (int pt = 0; pt < 2; ++pt) xf[ks][pt] = *(const LAS bf16x8*)(sm + O_XT + (prow0 + 16 * pt) * SX_STR + (32 * ks + 8 * q) * 2);
#pragma unroll
            for (int lt = 0; lt < 4; ++lt)
#pragma unroll
                for (int ks = 0; ks < 2; ++ks) {
                    if (ks == 1 && lt < 2) continue;
                    const int l = 16 * lt + c; const float acl = ACS[r * 64 + l];
                    const LAS float* cbp = (const LAS float*)(sm + O_CB + l * SN_STR) + 32 * ks + 8 * q;
                    const f32x4 cb0 = *(const LAS f32x4*)cbp, cb1 = *(const LAS f32x4*)(cbp + 4);
                    const f32x4 as0 = *(const LAS f32x4*)(ACS + r * 64 + 32 * ks + 8 * q), as1 = *(const LAS f32x4*)(ACS + r * 64 + 32 * ks + 8 * q + 4);
                    const f32x4 d0 = *(const LAS f32x4*)(DTV + r * 64 + 32 * ks + 8 * q), d1 = *(const LAS f32x4*)(DTV + r * 64 + 32 * ks + 8 * q + 4);
                    f32x4 m0, m1;
#pragma unroll
                    for (int j = 0; j < 4; ++j) { const int s0 = 32 * ks + 8 * q + j, s1 = s0 + 4;
                        m0[j] = (s0 <= l) ? cb0[j] * __expf(acl - as0[j]) * d0[j] : 0.f;
                        m1[j] = (s1 <= l) ? cb1[j] * __expf(acl - as1[j]) * d1[j] : 0.f; }
                    const bf16x8 mf = __builtin_bit_cast(bf16x8, pack8(m0, m1));
#pragma unroll
                    for (int pt = 0; pt < 2; ++pt) accY[lt][pt] = MFMA16(mf, xf[ks][pt], accY[lt][pt]);
                }
#pragma unroll
            for (int lt = 0; lt < 4; ++lt) {
#pragma unroll
                for (int pt = 0; pt < 2; ++pt) { const int prow = prow0 + 16 * pt;
                    const f32x4 xv = unpack4(*(const LAS u32x2*)(sm + O_XT + prow * SX_STR + (16 * lt + 4 * q) * 2));
#pragma unroll
                    for (int rg = 0; rg < 4; ++rg) { const int l = 16 * lt + 4 * q + rg; const float zv = bf2f(*(const LAS bf16_t*)(sm + O_ZT + l * SZ_STR + prow * 2));
                        accY[lt][pt][rg] = (accY[lt][pt][rg] + d_r * xv[rg]) * zv; } }
                f32x4 sv;
#pragma unroll
                for (int rg = 0; rg < 4; ++rg) sv[rg] = row16_sum(accY[lt][0][rg] * accY[lt][0][rg] + accY[lt][1][rg] * accY[lt][1][rg]);
                if (c == 0) *(LAS f32x4*)(SSQ + w * 64 + 16 * lt + 4 * q) = sv;
            }
            {
                const float dec = __expf(ACS[r * 64 + 63]);
#pragma unroll
                for (int nt = 0; nt < 8; ++nt)
#pragma unroll
                    for (int pt = 0; pt < 2; ++pt) accH[nt][pt] *= dec;
                bf16x8 xw[2][2];
#pragma unroll
                for (int ks = 0; ks < 2; ++ks) { const f32x4 w0 = *(const LAS f32x4*)(WG + r * 64 + 32 * ks + 8 * q), w1 = *(const LAS f32x4*)(WG + r * 64 + 32 * ks + 8 * q + 4);
#pragma unroll
                    for (int pt = 0; pt < 2; ++pt) { f32x4 a, bq; unpack8(__builtin_bit_cast(u32x4, xf[ks][pt]), a, bq); xw[ks][pt] = __builtin_bit_cast(bf16x8, pack8(a * w0, bq * w1)); } }
#pragma unroll
                for (int nt = 0; nt < 8; ++nt)
#pragma unroll
                    for (int ks = 0; ks < 2; ++ks) { const bf16x8 bfr = *(const LAS bf16x8*)(sm + O_BT + (16 * nt + c) * SX_STR + (32 * ks + 8 * q) * 2);
#pragma unroll
                        for (int pt = 0; pt < 2; ++pt) accH[nt][pt] = MFMA16(bfr, xw[ks][pt], accH[nt][pt]); }
            }
            SSD_ISSUE(sub + 1 < SEQ / 64 ? sub + 1 : sub);
            __syncthreads();
            { float s = 0.f;
#pragma unroll
              for (int k = 0; k < 8; ++k) s += SSQ[k * 64 + lane];
              LAS float* RSW = (LAS float*)(sm + O_RSW) + w * 64;
              RSW[lane] = rsqrtf(s * (1.0f / 256.0f) + RMS_EPS);
#pragma unroll
              for (int lt = 0; lt < 4; ++lt) { const f32x4 rs = *(const LAS f32x4*)(RSW + 16 * lt + 4 * q);
#pragma unroll
                for (int pt = 0; pt < 2; ++pt) { const float nw = pt ? nw1 : nw0;
#pragma unroll
                    for (int rg = 0; rg < 4; ++rg) { const int l = 16 * lt + 4 * q + rg;
                        *(LAS bf16_t*)(sm + O_ZT + l * SZ_STR + (prow0 + 16 * pt) * 2) = (bf16_t)(cvt_pk_bf16(accY[lt][pt][rg] * rs[rg] * nw, 0.f) & 0xffffu); } } }
#pragma unroll
              for (int k = 0; k < 4; ++k) { const int row = (lane >> 2) + 16 * k, pc = lane & 3;
                *(u32x4*)(zy + (t0 + row) * 2048 + g * 256 + r * 64 + ph * 32 + pc * 8) = *(const LAS u32x4*)(sm + O_ZT + row * SZ_STR + (r * 64 + ph * 32 + pc * 8) * 2); }
            }
        }
    }
}

template <int W, int RUN = 16>
__device__ __forceinline__ void pool_task(const bf16_t* __restrict__ colp, bf16_t* __restrict__ outp, int t0, int s0) {
    constexpr int H = W - 1;
    u32x4 rw[RUN + H];
#pragma unroll
    for (int j = 0; j < RUN + H; ++j) { int tt = t0 - H + j; tt = tt < 0 ? 0 : tt; rw[j] = *(const u32x4*)(colp + (size_t)tt * 1024); }
    f32x4 S0 = {0.f, 0.f, 0.f, 0.f}, S1 = {0.f, 0.f, 0.f, 0.f};
#pragma unroll
    for (int j = 1; j <= H; ++j) { f32x4 a, b; unpack8(rw[H - j], a, b); const bool ok = (s0 - j >= 0); S0 += ok ? a : (f32x4){0.f, 0.f, 0.f, 0.f}; S1 += ok ? b : (f32x4){0.f, 0.f, 0.f, 0.f}; }
#pragma unroll
    for (int tt = 0; tt < RUN; ++tt) { const int s = s0 + tt;
        f32x4 a, b; unpack8(rw[H + tt], a, b); S0 += a; S1 += b;
        const float inv = 1.0f / (float)(s + 1 < W ? s + 1 : W);
        *(u32x4*)(outp + (size_t)(t0 + tt) * 1024) = pack8(S0 * inv - a, S1 * inv - b);
        f32x4 c, d; unpack8(rw[tt], c, d);
        if (s - W + 1 >= 0) { S0 -= c; S1 -= d; } }
}
__device__ __forceinline__ void pool_tile(const Params& p, int pm, int g) {
    const bf16_t* up = (const bf16_t*)(p.ws + WS_RA); bf16_t* pooled = (bf16_t*)(p.ws + WS_RA + 384 * MiB);
    int tl = threadIdx.x; asm volatile("" : "+v"(tl));
    const int vec = g * 32 + (tl & 31), run = tl >> 5;
    const int t0 = pm * 256 + run * 16, s0 = t0 & (SEQ - 1);
    const bf16_t* colp = up + vec * 8; bf16_t* outp = pooled + vec * 8;
    if (g == 0) pool_task<2>(colp, outp, t0, s0); else if (g == 1) pool_task<4>(colp, outp, t0, s0);
    else if (g == 2) pool_task<8>(colp, outp, t0, s0); else { pool_task<16, 8>(colp, outp, t0, s0); pool_task<16, 8>(colp, outp, t0 + 8, s0 + 8); }
}

template <bool OUT_BF16>
__device__ void phase_ln(const bf16_t* __restrict__ src, void* __restrict__ dst, const float* __restrict__ gam, const float* __restrict__ bet) {
    const int lane = threadIdx.x & 63, wv = threadIdx.x >> 6;
    f32x4 gv[4], bv[4];
#pragma unroll
    for (int i = 0; i < 2; ++i) { gv[2 * i] = *(const f32x4*)(gam + lane * 8 + 512 * i); gv[2 * i + 1] = *(const f32x4*)(gam + lane * 8 + 512 * i + 4);
        bv[2 * i] = *(const f32x4*)(bet + lane * 8 + 512 * i); bv[2 * i + 1] = *(const f32x4*)(bet + lane * 8 + 512 * i + 4); }
    for (int row0 = (blockIdx.x * 8 + wv) * 4; row0 < T_TOK; row0 += gridDim.x * 8 * 4) {
        u32x4 rw[4][2];
#pragma unroll
        for (int rr = 0; rr < 4; ++rr)
#pragma unroll
            for (int i = 0; i < 2; ++i) rw[rr][i] = *(const u32x4*)(src + (size_t)(row0 + rr) * DM + lane * 8 + 512 * i);
#pragma unroll
        for (int rr = 0; rr < 4; ++rr) {
            f32x4 v[4]; unpack8(rw[rr][0], v[0], v[1]); unpack8(rw[rr][1], v[2], v[3]);
            float s = 0.f;
#pragma unroll
            for (int i = 0; i < 4; ++i) s += (v[i][0] + v[i][1]) + (v[i][2] + v[i][3]);
#pragma unroll
            for (int o = 32; o >= 1; o >>= 1) s += __shfl_xor(s, o);
            const float mu = s * (1.0f / 1024.0f); float q = 0.f;
#pragma unroll
            for (int i = 0; i < 4; ++i) { v[i] -= mu; q += (v[i][0] * v[i][0] + v[i][1] * v[i][1]) + (v[i][2] * v[i][2] + v[i][3] * v[i][3]); }
#pragma unroll
            for (int o = 32; o >= 1; o >>= 1) q += __shfl_xor(q, o);
            const float rstd = rsqrtf(q * (1.0f / 1024.0f) + LN_EPS);
#pragma unroll
            for (int i = 0; i < 2; ++i) { const f32x4 o0 = v[2 * i] * rstd * gv[2 * i] + bv[2 * i], o1 = v[2 * i + 1] * rstd * gv[2 * i + 1] + bv[2 * i + 1];
                if (OUT_BF16) *(u32x4*)((bf16_t*)dst + (size_t)(row0 + rr) * DM + lane * 8 + 512 * i) = pack8(o0, o1);
                else { float* op = (float*)dst + (size_t)(row0 + rr) * DM + lane * 8 + 512 * i; *(f32x4*)op = o0; *(f32x4*)(op + 4) = o1; } }
        }
    }
}

__device__ __forceinline__ void ln_panel_bf16(const bf16_t* __restrict__ src, bf16_t* __restrict__ dst, const float* __restrict__ gam, const float* __restrict__ bet, int r0) {
    int tl = threadIdx.x; asm volatile("" : "+v"(tl));
    const int lane = tl & 63, wv = tl >> 6;
    f32x4 gv[4], bv[4];
#pragma unroll
    for (int i = 0; i < 2; ++i) { gv[2 * i] = *(const f32x4*)(gam + lane * 8 + 512 * i); gv[2 * i + 1] = *(const f32x4*)(gam + lane * 8 + 512 * i + 4);
        bv[2 * i] = *(const f32x4*)(bet + lane * 8 + 512 * i); bv[2 * i + 1] = *(const f32x4*)(bet + lane * 8 + 512 * i + 4); }
#pragma unroll 1
    for (int k = 0; k < 8; ++k) { const int row0 = r0 + wv * 32 + k * 4;
        u32x4 rw[4][2];
#pragma unroll
        for (int rr = 0; rr < 4; ++rr)
#pragma unroll
            for (int i = 0; i < 2; ++i) rw[rr][i] = *(const u32x4*)(src + (size_t)(row0 + rr) * DM + lane * 8 + 512 * i);
#pragma unroll
        for (int rr = 0; rr < 4; ++rr) {
            f32x4 v[4]; unpack8(rw[rr][0], v[0], v[1]); unpack8(rw[rr][1], v[2], v[3]);
            float sm = 0.f;
#pragma unroll
            for (int i = 0; i < 4; ++i) sm += (v[i][0] + v[i][1]) + (v[i][2] + v[i][3]);
#pragma unroll
            for (int o = 32; o >= 1; o >>= 1) sm += __shfl_xor(sm, o);
            const float mu = sm * (1.0f / 1024.0f); float q = 0.f;
#pragma unroll
            for (int i = 0; i < 4; ++i) { v[i] -= mu; q += (v[i][0] * v[i][0] + v[i][1] * v[i][1]) + (v[i][2] * v[i][2] + v[i][3] * v[i][3]); }
#pragma unroll
            for (int o = 32; o >= 1; o >>= 1) q += __shfl_xor(q, o);
            const float rstd = rsqrtf(q * (1.0f / 1024.0f) + LN_EPS);
#pragma unroll
            for (int i = 0; i < 2; ++i) *(u32x4*)(dst + (size_t)(row0 + rr) * DM + lane * 8 + 512 * i) = pack8(v[2 * i] * rstd * gv[2 * i] + bv[2 * i], v[2 * i + 1] * rstd * gv[2 * i + 1] + bv[2 * i + 1]);
        }
    }
}

#define XB_TMO      128
#define XB_XCNT(j)  (256  + 64 * (j))
#define XB_XSUB(j)  (1280 + 64 * (j))
#define XB_XGEN(j)  (2304 + 64 * (j))
#define XB_TOP      3328
#define XB_TOPGEN   3392
#define XCD_BAR_WORDS 3456
#define XB_SPIN_CAP (1u << 18)
__device__ __forceinline__ unsigned xb_ld(unsigned* p)              { return __hip_atomic_load(p, __ATOMIC_RELAXED, __HIP_MEMORY_SCOPE_AGENT); }
__device__ __forceinline__ unsigned xb_add(unsigned* p, unsigned v) { return __hip_atomic_fetch_add(p, v, __ATOMIC_RELAXED, __HIP_MEMORY_SCOPE_AGENT); }
__device__ __forceinline__ unsigned xb_xcc_id() { return (unsigned)__builtin_amdgcn_s_getreg((3 << 11) | 20) & 0xFu; }
#define XB_SPIN(cond, bar) do { unsigned _sp = 0; while (cond) { __builtin_amdgcn_s_sleep(1); \
    if ((++_sp & 255u) == 0u) { if (xb_ld(&(bar)[XB_TMO])) break; if (_sp > XB_SPIN_CAP) { atomicAdd(&(bar)[XB_TMO], 1u); break; } } } } while (0)
struct XcdBarrier { unsigned* bar; unsigned x; volatile LAS unsigned* st; };
__device__ __forceinline__ XcdBarrier xcd_barrier_post(unsigned* bar, volatile LAS unsigned* st) {
    XcdBarrier b; b.bar = bar; b.x = xb_xcc_id(); b.st = st;
    if (threadIdx.x == 0) (void)xb_add(&bar[XB_XCNT(b.x)], 1u);
    return b;
}
__device__ __forceinline__ void xcd_barrier_complete(unsigned* bar, unsigned x, unsigned& nloc, unsigned& nx) {
    const unsigned G = gridDim.x * gridDim.y * gridDim.z;
    unsigned sum, cnt, mine, sp = 0u;
    for (;;) {
        sum = 0u; cnt = 0u; mine = 0u;
#pragma unroll
        for (unsigned j = 0; j < 16; ++j) { const unsigned c = xb_ld(&bar[XB_XCNT(j)]); sum += c; cnt += (c > 0u) ? 1u : 0u; mine = (j == x) ? c : mine; }
        if (sum == G) break;
        __builtin_amdgcn_s_sleep(1);
        if ((++sp & 255u) == 0u) { if (xb_ld(&bar[XB_TMO])) break; if (sp > XB_SPIN_CAP) { atomicAdd(&bar[XB_TMO], 1u); break; } }
    }
    nloc = mine > 0u ? mine : 1u; nx = cnt > 0u ? cnt : 1u;
}
__device__ __forceinline__ void xcd_barrier(const XcdBarrier& b) {
    asm volatile("s_waitcnt vmcnt(0)" ::: "memory");
    __syncthreads();
    if (threadIdx.x == 0) {
        unsigned* bar = b.bar;
        __builtin_amdgcn_s_waitcnt(0);
        unsigned nloc = b.st[0], nx = b.st[1];
        if (nloc == 0u) { xcd_barrier_complete(bar, b.x, nloc, nx); b.st[0] = nloc; b.st[1] = nx; }
        const unsigned old = xb_add(&bar[XB_XSUB(b.x)], 1u);
        const unsigned gen = old / nloc;
        if (old + 1u == (gen + 1u) * nloc) {
            __builtin_amdgcn_fence(__ATOMIC_RELEASE, "agent");
            asm volatile("s_waitcnt vmcnt(0)" ::: "memory");
            const unsigned og = xb_add(&bar[XB_TOP], 1u);
            const unsigned tg = og / nx;
            if (og + 1u == (tg + 1u) * nx) xb_add(&bar[XB_TOPGEN], 1u);
            else XB_SPIN(xb_ld(&bar[XB_TOPGEN]) == tg, bar);
            __builtin_amdgcn_fence(__ATOMIC_ACQUIRE, "agent");
            xb_add(&bar[XB_XGEN(b.x)], 1u);
            asm volatile("s_waitcnt vmcnt(0)" ::: "memory");
        } else {
            XB_SPIN(xb_ld(&bar[XB_XGEN(b.x)]) == gen, bar);
            __builtin_amdgcn_fence(__ATOMIC_ACQUIRE, "agent");
            asm volatile("s_waitcnt vmcnt(0)" ::: "memory");
        }
    }
    __syncthreads();
}

__global__ void __launch_bounds__(512, 2) mega(Params p) {
    extern __shared__ __attribute__((aligned(16))) unsigned char lds_raw[];
    LAS unsigned char* lds = (LAS unsigned char*)lds_raw;
    cg::grid_group grid = cg::this_grid();
    unsigned char* ws = p.ws;
    const int G = gridDim.x, c = blockIdx.x;
    volatile LAS unsigned* xb_st = (volatile LAS unsigned*)(lds + LDS_XB);
    unsigned* xb_words = (unsigned*)(ws + WS_BAR);
    if (threadIdx.x == 0) { xb_st[0] = 0u; xb_st[1] = 0u; }
    __syncthreads();
    XcdBarrier xb; xb.bar = xb_words; xb.x = 0u; xb.st = xb_st;
#ifndef PHMASK
#define PHMASK 0x7ff
#endif
#define IN(k) (((PHMASK >> (k)) & 1) && p.ph_lo <= (k) && (k) < p.ph_hi)
#define SEAM(k) do { if (IN(k) && IN((k) + 1)) { if ((k) == 0) { grid.sync(); xb = xcd_barrier_post(xb_words, xb_st); } else xcd_barrier(xb); } } while (0)
    if (IN(0)) { if (c == 0) for (int i = threadIdx.x; i < XCD_BAR_WORDS; i += blockDim.x) xb_words[i] = 0u;
        phase0(p, lds_raw); }
    SEAM(0);
    if (IN(1)) {
        { pg8::Gemm g{(const bf16_t*)(ws + WS_RC), (const bf16_t*)(ws + WS_WIN1), T_TOK, N1 - 256, 1024, 1024, 1024, 0};
          pg8::StaticOrder S; S.init(T_TOK, N1 - 256, G, c);
          pg8::EpiG1 E{(bf16_t*)(ws + WS_RB), (bf16_t*)(ws + WS_RA), (float*)(ws + WS_DT), p.in[5], 0};
          pg8::gemm_phase<pg8::EpiG1>(lds, g, S, E); }
        { pg8::Gemm g{(const bf16_t*)(ws + WS_RC), (const bf16_t*)(ws + WS_WIN1) + (size_t)(N1 - 256) * 1024, T_TOK, 256, 1024, 1024, 1024, 0};
          pg8::StaticOrder S; S.init(T_TOK, 256, G, c);
          pg8::EpiG1 E{(bf16_t*)(ws + WS_RB), (bf16_t*)(ws + WS_RA), (float*)(ws + WS_DT), p.in[5], 24};
          pg8::gemm_phase<pg8::EpiG1, true>(lds, g, S, E); }
    }
    SEAM(1);
    #ifdef SSD_SIMPLE
    if (IN(2)) phase_ssd_simple(p, lds_raw);
#else
    if (IN(2)) phase_ssd(p, lds);
#endif
    SEAM(2);
    if (IN(3)) {
        pg8::Gemm g{(const bf16_t*)(ws + WS_RC), (const bf16_t*)(ws + WS_WIN2), T_TOK, N2, 1024, 1024, 1024, 0};
        pg8::StaticOrder S; S.init(T_TOK, N2, G, c);
        pg8::EpiG2 E{(bf16_t*)(ws + WS_RA), (bf16_t*)(ws + WS_RA + 128 * MiB), p.in[2]};
        pg8::gemm_phase<pg8::EpiG2>(lds, g, S, E);
    }
    SEAM(3);
    if (IN(5)) {
        bf16_t* merged = (bf16_t*)(ws + WS_RC); const bf16_t* gates = (const bf16_t*)(ws + WS_RA + 128 * MiB);
        pg8::StaticOrder S; S.init(T_TOK, 1024, G, c);
        const pg8::Gemm gp{(const bf16_t*)(ws + WS_RA + 384 * MiB), (const bf16_t*)(ws + WS_WP), T_TOK, 1024, 256, 1024, 256, 512};
        const pg8::Gemm gs{(const bf16_t*)(ws + WS_RB), (const bf16_t*)(ws + WS_WSSD), T_TOK, 1024, 2048, 2048, 2048, 0};
        if ((c & 1) == 0) {
            { pg8::Unit u; for (int i = 0; S.next(i, u); ++i) pool_tile(p, u.pm, u.pn); }
            __syncthreads();
            { pg8::EpiPool<true> E{merged, gates}; pg8::gemm_phase<pg8::EpiPool<true>>(lds, gp, S, E); }
            { pg8::EpiSsd<false> E{merged, gates}; pg8::gemm_phase<pg8::EpiSsd<false>>(lds, gs, S, E); }
        } else {
            { pg8::EpiSsd<true> E{merged, gates}; pg8::gemm_phase<pg8::EpiSsd<true>>(lds, gs, S, E); }
            { pg8::Unit u; for (int i = 0; S.next(i, u); ++i) pool_tile(p, u.pm, u.pn); }
            __syncthreads();
            { pg8::EpiPool<false> E{merged, gates}; pg8::gemm_phase<pg8::EpiPool<false>>(lds, gp, S, E); }
        }
    }
    SEAM(5);
    if (IN(6)) {
        pg8::Gemm g{(const bf16_t*)(ws + WS_RC), (const bf16_t*)(ws + WS_WOUT), T_TOK, 1024, 1024, 1024, 1024, 0};
        pg8::StaticOrder S; S.init(T_TOK, 1024, G, c, 1);
        pg8::EpiOut E{p.in[0], (bf16_t*)(ws + WS_RB)};
        pg8::gemm_phase<pg8::EpiOut>(lds, g, S, E);
        __syncthreads();
        for (int pm = c; pm < T_TOK / 256; pm += G) ln_panel_bf16((const bf16_t*)(ws + WS_RB), (bf16_t*)(ws + WS_RC), p.in[13], p.in[14], pm * 256);
    }
    SEAM(6);
    if (IN(8)) {
        pg8::Gemm g{(const bf16_t*)(ws + WS_RC), (const bf16_t*)(ws + WS_WUP), T_TOK, DFF, 1024, 1024, 1024, 0};
        pg8::StaticOrder S; S.init(T_TOK, DFF, G, c);
        pg8::EpiUp E{(bf16_t*)(ws + WS_RA)};
        pg8::gemm_phase<pg8::EpiUp>(lds, g, S, E);
    }
    SEAM(8);
    if (IN(9)) {
        pg8::Gemm g{(const bf16_t*)(ws + WS_RA), (const bf16_t*)(ws + WS_WDN), T_TOK, 1024, DFF, DFF, DFF, 0};
        pg8::StaticOrder S; S.init(T_TOK, 1024, G, c);
        pg8::EpiDown E{(const bf16_t*)(ws + WS_RC), (bf16_t*)(ws + WS_RB)};
        pg8::gemm_phase<pg8::EpiDown>(lds, g, S, E);
    }
    SEAM(9);
    if (IN(10)) phase_ln<false>((const bf16_t*)(ws + WS_RB), (void*)p.out, p.in[17], p.in[18]);
#undef IN
#undef SEAM
}

#ifndef DUPMASK
#define DUPMASK 0
#endif
#ifndef ONE_LAUNCH
#define ONE_LAUNCH 1
#endif
extern "C" void kernel_launch(void* const* d_in, const int* in_sizes, int n_in, void* d_out, int out_size, void* d_ws, size_t ws_size, hipStream_t stream) {
    static int grid = 0;
    if (grid == 0) {
        if (n_in != 19 || ws_size < WS_END + 16384) { fprintf(stderr, "kernel_launch: need 19 inputs and >= %zu bytes of workspace; got %d, %zu\n", (size_t)WS_END, n_in, ws_size); grid = -1; return; }
        int dev = 0, cus = 0, per_cu = 0;
        hipGetDevice(&dev); hipDeviceGetAttribute(&cus, hipDeviceAttributeMultiprocessorCount, dev);
        if (hipFuncSetAttribute((const void*)mega, hipFuncAttributeMaxDynamicSharedMemorySize, LDS_BYTES) != hipSuccess) { fprintf(stderr, "kernel_launch: hipFuncSetAttribute failed\n"); grid = -1; return; }
        if (hipOccupancyMaxActiveBlocksPerMultiprocessor(&per_cu, (const void*)mega, 512, LDS_BYTES) != hipSuccess || per_cu < 1) { fprintf(stderr, "kernel_launch: occupancy query says %d\n", per_cu); per_cu = 1; }
        (void)hipGetLastError();
        grid = cus;
    }
    if (grid < 0) return;
    Params p{};
    for (int i = 0; i < 19; ++i) p.in[i] = (const float*)d_in[i];
    p.out = (float*)d_out; p.ws = (unsigned char*)d_ws;
#if ONE_LAUNCH
    p.ph_lo = 0; p.ph_hi = NPHASE;
    void* args[] = {&p};
    hipError_t e = hipLaunchCooperativeKernel((const void*)mega, dim3(grid), dim3(512), args, LDS_BYTES, stream);
    if (e != hipSuccess) fprintf(stderr, "cooperative launch failed: %s (grid %d)\n", hipGetErrorString(e), grid);
#else
    for (int ph = 0; ph < NPHASE; ++ph) { p.ph_lo = ph; p.ph_hi = ph + 1;
        for (int rep = 0; rep < (((DUPMASK >> ph) & 1) ? 2 : 1); ++rep) hipLaunchKernelGGL(mega, dim3(grid), dim3(512), LDS_BYTES, stream, p); }
#endif
}
```

```cpp
#include <hip/hip_runtime.h>
#include <hip/hip_cooperative_groups.h>
#include <cstdio>
namespace cg = cooperative_groups;

#define LAS __attribute__((address_space(3)))
typedef unsigned short bf16_t;
typedef short bf16x8 __attribute__((ext_vector_type(8)));
typedef float f32x4 __attribute__((ext_vector_type(4)));
typedef float f32x2 __attribute__((ext_vector_type(2)));
typedef unsigned u32x4 __attribute__((ext_vector_type(4)));
typedef unsigned u32x2 __attribute__((ext_vector_type(2)));

constexpr int T_TOK = 65536, SEQ = 2048, DM = 1024, DFF = 4096;
constexpr int N1 = 6400;
constexpr int N2 = 3072;
constexpr float ALPHA = 1.189207115002721f;
constexpr float LN_EPS = 1e-5f, RMS_EPS = 1e-5f;
constexpr size_t MiB = 1024ull * 1024ull;
constexpr size_t WS_RA = 0;
constexpr size_t WS_RB = 512 * MiB;
constexpr size_t WS_RC = 768 * MiB;
constexpr size_t WS_DT = 896 * MiB;
constexpr size_t WS_W  = 904 * MiB;
constexpr size_t WS_WIN1 = WS_W;
constexpr size_t WS_WIN2 = WS_WIN1 + (size_t)N1 * 1024 * 2;
constexpr size_t WS_WP   = WS_WIN2 + (size_t)N2 * 1024 * 2;
constexpr size_t WS_WSSD = WS_WP + (size_t)1024 * 256 * 2;
constexpr size_t WS_WOUT = WS_WSSD + (size_t)1024 * 2048 * 2;
constexpr size_t WS_WUP  = WS_WOUT + (size_t)1024 * 1024 * 2;
constexpr size_t WS_WDN  = WS_WUP + (size_t)4096 * 1024 * 2;
constexpr size_t WS_END  = WS_WDN + (size_t)4096 * 1024 * 2;
constexpr size_t WS_BAR = WS_END;
constexpr int LDS_BYTES = 160016;
constexpr int LDS_XB = 160000;
constexpr int NPHASE = 11;

struct Params { const float* in[19]; float* out; unsigned char* ws; int ph_lo, ph_hi; };

__device__ __forceinline__ unsigned cvt_pk_bf16(float lo, float hi) { unsigned r; asm volatile("v_cvt_pk_bf16_f32 %0, %1, %2" : "=v"(r) : "v"(lo), "v"(hi)); return r; }
__device__ __forceinline__ float bf_lo(unsigned u) { return __uint_as_float(u << 16); }
__device__ __forceinline__ float bf_hi(unsigned u) { return __uint_as_float(u & 0xffff0000u); }
__device__ __forceinline__ float bf2f(bf16_t b) { return __uint_as_float(((unsigned)b) << 16); }
__device__ __forceinline__ float sigmoidf_(float v) { return __builtin_amdgcn_rcpf(1.0f + __expf(-v)); }
__device__ __forceinline__ float siluf_(float v) { return v * __builtin_amdgcn_rcpf(1.0f + __expf(-v)); }
__device__ __forceinline__ float softplusf_(float v) { return fmaxf(v, 0.f) + log1pf(__expf(-fabsf(v))); }
__device__ __forceinline__ u32x4 pack8(f32x4 a, f32x4 b) { u32x4 w; w.x = cvt_pk_bf16(a[0], a[1]); w.y = cvt_pk_bf16(a[2], a[3]); w.z = cvt_pk_bf16(b[0], b[1]); w.w = cvt_pk_bf16(b[2], b[3]); return w; }
__device__ __forceinline__ void unpack8(u32x4 w, f32x4& a, f32x4& b) { a = (f32x4){bf_lo(w.x), bf_hi(w.x), bf_lo(w.y), bf_hi(w.y)}; b = (f32x4){bf_lo(w.z), bf_hi(w.z), bf_lo(w.w), bf_hi(w.w)}; }

namespace pg8 {
constexpr int BM = 256, BK = 64, HALF = 128, HTB = HALF * BK * 2, STAGE_BYTES = 8 * HTB, NXCD = 8, WGM = 8;
__device__ __forceinline__ int lds_byte(int r, int c) { const int st = (r >> 4) * 2 + (c >> 5), rr = r & 15, cc = c & 31, ob = rr * 64 + cc * 2; return st * 1024 + (ob ^ (((ob >> 9) & 1) << 5)); }
__device__ __forceinline__ void stage_rc(int b, int& R, int& C) { const int st = b / 1024, sb = b % 1024, swz = sb ^ (((sb >> 9) & 1) << 5); R = (st >> 1) * 16 + swz / 64; C = (st & 1) * 32 + (swz % 64) / 2; }
__device__ __forceinline__ int perm32(int rho) { const int n = rho >> 4, i = rho & 15; return 8 * (i >> 2) + 4 * n + (i & 3); }
struct Unit { int pm, pn; };
struct Gemm { const bf16_t* A; const bf16_t* Bt; int M, N, K, lda, ldb, a_pn_bytes; };
struct StaticOrder {
    int nM, nN, nwg, G, c, owner;
    __device__ void init(int M, int N, int G_, int c_, int owner_ = 0) { nM = M / BM; nN = N / BM; nwg = nM * nN; G = G_; c = c_; owner = owner_; }
    __device__ bool next(int i, Unit& u) const {
        if (owner) { const int pm = c + (i / nN) * G; if (pm >= nM) return false; u.pm = pm; u.pn = i % nN; return true; }
        const long L = (long)i * G + c; if (L >= nwg) return false;
        int wgid = (int)L; { const int q = nwg / NXCD, r = nwg % NXCD, xcd = wgid % NXCD, off = wgid / NXCD; wgid = (xcd < r ? xcd * (q + 1) : r * (q + 1) + (xcd - r) * q) + off; }
        const int nig = WGM * nN, gid = wgid / nig, fm = gid * WGM, gsz = (nM - fm) < WGM ? (nM - fm) : WGM;
        u.pm = fm + ((wgid % nig) % gsz); u.pn = (wgid % nig) / gsz; return true;
    }
};

template <int OFF> __device__ __forceinline__ void ds_rd128(bf16x8& dst, unsigned addr) { asm volatile("ds_read_b128 %0, %1 offset:%2" : "=v"(dst) : "v"(addr), "n"(OFF)); }
template <class Epi, bool NARROW = false>
__device__ __forceinline__ void gemm_phase(LAS unsigned char* lds, const Gemm g, const StaticOrder& S, const Epi& E) {
    int tid_l = threadIdx.x; asm volatile("" : "+v"(tid_l));
    const int tid = tid_l, wid = __builtin_amdgcn_readfirstlane(tid >> 6), lane = tid & 63, wr = wid >> 2, wc = wid & 3, fr = lane & 15, fq = lane >> 4;
    const int K = g.K, nt = K / BK;
    unsigned voffA[2], voffB[2];
#pragma unroll
    for (int i = 0; i < 2; ++i) { int R, C; stage_rc(tid * 16 + i * 8192, R, C); const int Rb = Epi::PERM ? ((R & ~31) + perm32(R & 31)) : R;
        voffA[i] = (unsigned)(R * g.lda + C) * 2u; voffB[i] = (unsigned)(Rb * g.ldb + C) * 2u; }
    const size_t kstep = (size_t)(BK * 2);
    const size_t hsA = (size_t)HALF * g.lda * 2, hsB = (size_t)HALF * g.ldb * 2;
    const size_t tsA = 2 * hsA, tsB = 2 * hsB;
    const unsigned ldsw = (unsigned)wid * 1024u;
    const int aoff = lds_byte(wr * 64 + fr, fq * 8), boff = lds_byte(wc * 32 + fr, fq * 8);
    const unsigned aaddr = (unsigned)(unsigned long long)(lds + aoff), baddr = (unsigned)(unsigned long long)(lds + 4 * HTB + boff);
#define PG8_SA(b, h) (((b) * 2 + (h)) * HTB)
#define PG8_SB(b, h) ((4 + (b) * 2 + (h)) * HTB)
#define PG8_STAGE(bufoff, gbase, voff) do { _Pragma("unroll") for (int _i = 0; _i < 2; ++_i) \
        __builtin_amdgcn_global_load_lds((const unsigned*)((const char*)(gbase) + (voff)[_i]), (LAS unsigned*)(lds + (bufoff) + ldsw + _i * 8192), 16, 0, 0); } while (0)
#define PG8_LDA(dst, b, h) do { _Pragma("unroll") for (int m = 0; m < 4; ++m) _Pragma("unroll") for (int k = 0; k < 2; ++k) dst[m][k] = *(const LAS bf16x8*)(lds + PG8_SA(b, h) + aoff + m * 2048 + k * 1024); } while (0)
#define PG8_LDB(dst, b, h) do { _Pragma("unroll") for (int n = 0; n < 2; ++n) _Pragma("unroll") for (int k = 0; k < 2; ++k) dst[n][k] = *(const LAS bf16x8*)(lds + PG8_SB(b, h) + boff + n * 2048 + k * 1024); } while (0)
#define PG8_MMA(ai, bj, At, Bt) do { __builtin_amdgcn_s_setprio(1); _Pragma("unroll") for (int m = 0; m < 4; ++m) _Pragma("unroll") for (int n = 0; n < 2; ++n) _Pragma("unroll") for (int k = 0; k < 2; ++k) \
        acc[ai][bj][m][n] = __builtin_amdgcn_mfma_f32_16x16x32_bf16(Bt[n][k], At[m][k], acc[ai][bj][m][n], 0, 0, 0); __builtin_amdgcn_s_setprio(0); } while (0)
#define PG8_RDA(dst, b, h) do { ds_rd128<PG8_SA(b, h) + 0 * 2048>(dst[0][0], aaddr); ds_rd128<PG8_SA(b, h) + 1 * 2048>(dst[1][0], aaddr); ds_rd128<PG8_SA(b, h) + 2 * 2048>(dst[2][0], aaddr); ds_rd128<PG8_SA(b, h) + 3 * 2048>(dst[3][0], aaddr); \
        ds_rd128<PG8_SA(b, h) + 0 * 2048 + 1024>(dst[0][1], aaddr); ds_rd128<PG8_SA(b, h) + 1 * 2048 + 1024>(dst[1][1], aaddr); ds_rd128<PG8_SA(b, h) + 2 * 2048 + 1024>(dst[2][1], aaddr); ds_rd128<PG8_SA(b, h) + 3 * 2048 + 1024>(dst[3][1], aaddr); } while (0)
#define PG8_RDB(dst, b, h) do { ds_rd128<PG8_SA(b, h)>(dst[0][0], baddr); ds_rd128<PG8_SA(b, h) + 2048>(dst[1][0], baddr); ds_rd128<PG8_SA(b, h) + 1024>(dst[0][1], baddr); ds_rd128<PG8_SA(b, h) + 2048 + 1024>(dst[1][1], baddr); } while (0)
#define PG8_WAITA(n, F, k) asm volatile("s_waitcnt lgkmcnt(" #n ")" : "+v"(F[0][k]), "+v"(F[1][k]), "+v"(F[2][k]), "+v"(F[3][k]) :: "memory")
#define PG8_WAITB(n, F, k) asm volatile("s_waitcnt lgkmcnt(" #n ")" : "+v"(F[0][k]), "+v"(F[1][k]) :: "memory")
#define PG8_WAITAB(n, FA, FB) asm volatile("s_waitcnt lgkmcnt(" #n ")" : "+v"(FA[0][0]), "+v"(FA[1][0]), "+v"(FA[2][0]), "+v"(FA[3][0]), "+v"(FB[0][0]), "+v"(FB[1][0]), "+v"(FB[0][1]), "+v"(FB[1][1]) :: "memory")
#define PG8_MMAK(ai, bj, At, Bt, k) do { _Pragma("unroll") for (int m = 0; m < 4; ++m) _Pragma("unroll") for (int n = 0; n < 2; ++n) \
        acc[ai][bj][m][n] = __builtin_amdgcn_mfma_f32_16x16x32_bf16(Bt[n][k], At[m][k], acc[ai][bj][m][n], 0, 0, 0); } while (0)
#define PG8_PRIO(x) __builtin_amdgcn_s_setprio(x)
#define PG8_WAIT_V(n) asm volatile("s_waitcnt vmcnt(" #n ")" ::: "memory")
#define PG8_WAIT_L(n) asm volatile("s_waitcnt lgkmcnt(" #n ")" ::: "memory")
#define PG8_BAR __builtin_amdgcn_s_barrier()
#define PG8_SCHED __builtin_amdgcn_sched_barrier(0)
    Unit cur, nxt; int ui = 0;
    if (!S.next(0, cur)) return;
    f32x4 acc[2][2][4][2];
#pragma unroll
    for (int a = 0; a < 2; ++a)
#pragma unroll
        for (int b = 0; b < 2; ++b)
#pragma unroll
            for (int m = 0; m < 4; ++m)
#pragma unroll
                for (int n = 0; n < 2; ++n) acc[a][b][m][n] = (f32x4){0.f, 0.f, 0.f, 0.f};
    bf16x8 At[4][2], B0[2][2], B1[2][2];
    const char* cA = (const char*)g.A + (size_t)cur.pm * tsA + (size_t)cur.pn * g.a_pn_bytes; const char* cB = (const char*)g.Bt + (size_t)cur.pn * tsB;
    PG8_STAGE(PG8_SB(0, 0), cB, voffB); PG8_STAGE(PG8_SA(0, 0), cA, voffA); PG8_STAGE(PG8_SB(0, 1), cB + hsB, voffB); PG8_STAGE(PG8_SA(0, 1), cA + hsA, voffA);
    if (wr == 1) PG8_BAR;
    PG8_WAIT_V(4); PG8_BAR;
    PG8_STAGE(PG8_SB(1, 0), cB + kstep, voffB); PG8_STAGE(PG8_SA(1, 0), cA + kstep, voffA); PG8_STAGE(PG8_SB(1, 1), cB + hsB + kstep, voffB);
    PG8_WAIT_V(6); PG8_BAR;
    PG8_RDB(B0, 0, 0);
    for (;;) {
        const bool has_next = S.next(ui + 1, nxt);
        const char* nA = has_next ? (const char*)g.A + (size_t)nxt.pm * tsA + (size_t)nxt.pn * g.a_pn_bytes : cA; const char* nB = has_next ? (const char*)g.Bt + (size_t)nxt.pn * tsB : cB;
#pragma unroll 1
        for (int t = 0; t < nt; t += 2) {
            const bool last = (t == nt - 2);
            const char* a1 = cA + (size_t)(t + 1) * kstep;
            const char* a2 = last ? nA : cA + (size_t)(t + 2) * kstep; const char* b2 = last ? nB : cB + (size_t)(t + 2) * kstep;
            const char* a3 = a2 + kstep; const char* b3 = b2 + kstep;
            PG8_RDA(At, 0, 0); PG8_STAGE(PG8_SA(1, 1), a1 + hsA, voffA);
            PG8_WAIT_V(10); PG8_BAR; PG8_PRIO(1); PG8_WAITAB(4, At, B0); PG8_SCHED; PG8_MMAK(0, 0, At, B0, 0); PG8_SCHED; PG8_WAITA(0, At, 1); PG8_SCHED; PG8_MMAK(0, 0, At, B0, 1); PG8_PRIO(0); PG8_BAR; PG8_SCHED;
            PG8_RDB(B1, 0, 1); PG8_STAGE(PG8_SB(0, 0), b2, voffB);
            PG8_WAIT_V(10); PG8_BAR; PG8_PRIO(1); PG8_WAITB(2, B1, 0); PG8_SCHED; if (!NARROW) PG8_MMAK(0, 1, At, B1, 0); PG8_SCHED; PG8_WAITB(0, B1, 1); PG8_SCHED; if (!NARROW) PG8_MMAK(0, 1, At, B1, 1); PG8_PRIO(0); PG8_BAR; PG8_SCHED;
            PG8_RDA(At, 0, 1); PG8_STAGE(PG8_SA(0, 0), a2, voffA);
            PG8_WAIT_V(10); PG8_BAR; PG8_PRIO(1); PG8_WAITA(4, At, 0); PG8_SCHED; PG8_MMAK(1, 0, At, B0, 0); PG8_SCHED; PG8_WAITA(0, At, 1); PG8_SCHED; PG8_MMAK(1, 0, At, B0, 1); PG8_PRIO(0); PG8_BAR; PG8_SCHED;
            PG8_RDB(B0, 1, 0); PG8_STAGE(PG8_SB(0, 1), b2 + hsB, voffB);
            PG8_WAIT_V(10); PG8_BAR; if (!NARROW) PG8_MMA(1, 1, At, B1); PG8_BAR; PG8_SCHED;
            PG8_RDA(At, 1, 0); PG8_STAGE(PG8_SA(0, 1), a2 + hsA, voffA);
            PG8_WAIT_V(10); PG8_BAR; PG8_PRIO(1); PG8_WAITAB(4, At, B0); PG8_SCHED; PG8_MMAK(0, 0, At, B0, 0); PG8_SCHED; PG8_WAITA(0, At, 1); PG8_SCHED; PG8_MMAK(0, 0, At, B0, 1); PG8_PRIO(0); PG8_BAR; PG8_SCHED;
            PG8_RDB(B1, 1, 1); PG8_STAGE(PG8_SB(1, 0), b3, voffB);
            PG8_WAIT_V(10); PG8_BAR; PG8_PRIO(1); PG8_WAITB(2, B1, 0); PG8_SCHED; if (!NARROW) PG8_MMAK(0, 1, At, B1, 0); PG8_SCHED; PG8_WAITB(0, B1, 1); PG8_SCHED; if (!NARROW) PG8_MMAK(0, 1, At, B1, 1); PG8_PRIO(0); PG8_BAR; PG8_SCHED;
            PG8_RDA(At, 1, 1); PG8_STAGE(PG8_SA(1, 0), a3, voffA);
            PG8_WAIT_V(10); PG8_BAR; PG8_PRIO(1); PG8_WAITA(4, At, 0); PG8_SCHED; PG8_MMAK(1, 0, At, B0, 0); PG8_SCHED; PG8_WAITA(0, At, 1); PG8_SCHED; PG8_MMAK(1, 0, At, B0, 1); PG8_PRIO(0); PG8_BAR; PG8_SCHED;
            if (!last) PG8_RDB(B0, 0, 0);
            PG8_STAGE(PG8_SB(1, 1), b3 + hsB, voffB);
            PG8_WAIT_V(10); PG8_BAR; if (!NARROW) PG8_MMA(1, 1, At, B1); PG8_BAR; PG8_SCHED;
        }
        E(acc, cur, wr, wc, fr, fq);
        if (!has_next) break;
#pragma unroll
        for (int a = 0; a < 2; ++a)
#pragma unroll
            for (int b = 0; b < 2; ++b)
#pragma unroll
                for (int m = 0; m < 4; ++m)
#pragma unroll
                    for (int n = 0; n < 2; ++n) acc[a][b][m][n] = (f32x4){0.f, 0.f, 0.f, 0.f};
        cur = nxt; cA = nA; cB = nB; ++ui;
        PG8_RDB(B0, 0, 0);
    }
    PG8_WAIT_V(0);
    if (wr == 0) PG8_BAR;
    PG8_BAR;
#undef PG8_SA
#undef PG8_SB
#undef PG8_STAGE
#undef PG8_LDA
#undef PG8_LDB
#undef PG8_MMA
#undef PG8_MMAK
#undef PG8_RDA
#undef PG8_RDB
#undef PG8_WAITA
#undef PG8_WAITB
#undef PG8_WAITAB
#undef PG8_PRIO
#undef PG8_WAIT_V
#undef PG8_WAIT_L
#undef PG8_BAR
#undef PG8_SCHED
}

typedef const f32x4 (&AccRef)[2][2][4][2];

struct EpiG1 {
    static constexpr bool PERM = true;
    bf16_t* zs; bf16_t* xbc; float* dtb; const float* dt_bias; int pn_off;
    __device__ __forceinline__ void operator()(AccRef acc, const Unit& u, int wr, int wc, int fr, int fq) const {
        const int row0 = u.pm * BM + wr * 64 + fr, pn = u.pn + pn_off;
        if (pn < 24) {
            const bool act = pn < 8;
            bf16_t* base = act ? zs : xbc; const int ld = act ? 2048 : 4096; const int colt = act ? pn * 256 : (pn - 8) * 256;
            const int col0 = colt + wc * 32 + 8 * fq;
#pragma unroll
            for (int ai = 0; ai < 2; ++ai)
#pragma unroll
                for (int m = 0; m < 4; ++m) { bf16_t* rowp = base + (size_t)(row0 + ai * HALF + m * 16) * ld + col0;
#pragma unroll
                    for (int bj = 0; bj < 2; ++bj) { f32x4 v0 = acc[ai][bj][m][0], v1 = acc[ai][bj][m][1];
                        if (act) {
#pragma unroll
                            for (int j = 0; j < 4; ++j) { v0[j] = siluf_(v0[j]); v1[j] = siluf_(v1[j]); } }
                        *(u32x4*)(rowp + bj * HALF) = pack8(v0, v1); } }
        } else if (wc == 0) {
            const int c0 = 8 * fq; const f32x4 b0 = *(const f32x4*)(dt_bias + c0), b1 = *(const f32x4*)(dt_bias + c0 + 4);
#pragma unroll
            for (int ai = 0; ai < 2; ++ai)
#pragma unroll
                for (int m = 0; m < 4; ++m) { float* rowp = dtb + (size_t)(row0 + ai * HALF + m * 16) * 32 + c0;
                    f32x4 v0 = acc[ai][0][m][0] + b0, v1 = acc[ai][0][m][1] + b1;
#pragma unroll
                    for (int j = 0; j < 4; ++j) { v0[j] = softplusf_(v0[j]); v1[j] = softplusf_(v1[j]); }
                    *(f32x4*)rowp = v0; *(f32x4*)(rowp + 4) = v1; }
        }
    }
};
struct EpiG2 {
    static constexpr bool PERM = true;
    bf16_t* upool; bf16_t* gates; const float* b_gates;
    __device__ __forceinline__ void operator()(AccRef acc, const Unit& u, int wr, int wc, int fr, int fq) const {
        const int row0 = u.pm * BM + wr * 64 + fr, pn = u.pn;
        const bool act = pn >= 4;
        bf16_t* base = act ? gates : upool; const int ld = act ? 2048 : 1024; const int colt = act ? (pn - 4) * 256 : pn * 256;
        const int col0 = colt + wc * 32 + 8 * fq;
        f32x4 bv[2][2];
#pragma unroll
        for (int bj = 0; bj < 2; ++bj)
#pragma unroll
            for (int n = 0; n < 2; ++n) bv[bj][n] = act ? *(const f32x4*)(b_gates + col0 + bj * HALF + 4 * n) : (f32x4){0.f, 0.f, 0.f, 0.f};
#pragma unroll
        for (int ai = 0; ai < 2; ++ai)
#pragma unroll
            for (int m = 0; m < 4; ++m) { bf16_t* rowp = base + (size_t)(row0 + ai * HALF + m * 16) * ld + col0;
#pragma unroll
                for (int bj = 0; bj < 2; ++bj) { f32x4 v0 = acc[ai][bj][m][0] + bv[bj][0], v1 = acc[ai][bj][m][1] + bv[bj][1];
                    if (act) {
#pragma unroll
                        for (int j = 0; j < 4; ++j) { v0[j] = sigmoidf_(v0[j]); v1[j] = sigmoidf_(v1[j]); } }
                    *(u32x4*)(rowp + bj * HALF) = pack8(v0, v1); } }
    }
};
template <bool FIRST> struct EpiPool {
    static constexpr bool PERM = true;
    bf16_t* merged; const bf16_t* gates;
    __device__ __forceinline__ void operator()(AccRef acc, const Unit& u, int wr, int wc, int fr, int fq) const {
        const int row0 = u.pm * BM + wr * 64 + fr; const int col0 = u.pn * 256 + wc * 32 + 8 * fq;
#pragma unroll
        for (int ai = 0; ai < 2; ++ai) {
            u32x4 gw[4][2], pw[4][2];
#pragma unroll
            for (int m = 0; m < 4; ++m)
#pragma unroll
                for (int bj = 0; bj < 2; ++bj) { const size_t row = (size_t)(row0 + ai * HALF + m * 16);
                    gw[m][bj] = *(const u32x4*)(gates + row * 2048 + col0 + bj * HALF); if (!FIRST) pw[m][bj] = *(const u32x4*)(merged + row * 1024 + col0 + bj * HALF); }
#pragma unroll
            for (int m = 0; m < 4; ++m) { const size_t row = (size_t)(row0 + ai * HALF + m * 16);
#pragma unroll
                for (int bj = 0; bj < 2; ++bj) { f32x4 g0, g1, p0 = {0.f, 0.f, 0.f, 0.f}, p1 = {0.f, 0.f, 0.f, 0.f}; unpack8(gw[m][bj], g0, g1); if (!FIRST) unpack8(pw[m][bj], p0, p1);
                    const f32x4 v0 = p0 + acc[ai][bj][m][0] * g0, v1 = p1 + acc[ai][bj][m][1] * g1;
                    *(u32x4*)(merged + row * 1024 + col0 + bj * HALF) = pack8(v0, v1); } }
            asm volatile("" ::: "memory");
        }
    }
};
template <bool FIRST> struct EpiSsd {
    static constexpr bool PERM = true;
    bf16_t* merged; const bf16_t* gates;
    __device__ __forceinline__ void operator()(AccRef acc, const Unit& u, int wr, int wc, int fr, int fq) const {
        const int row0 = u.pm * BM + wr * 64 + fr; const int col0 = u.pn * 256 + wc * 32 + 8 * fq;
#pragma unroll
        for (int ai = 0; ai < 2; ++ai) {
            u32x4 gw[4][2], pw[4][2];
#pragma unroll
            for (int m = 0; m < 4; ++m)
#pragma unroll
                for (int bj = 0; bj < 2; ++bj) { const size_t row = (size_t)(row0 + ai * HALF + m * 16);
                    gw[m][bj] = *(const u32x4*)(gates + row * 2048 + 1024 + col0 + bj * HALF); if (!FIRST) pw[m][bj] = *(const u32x4*)(merged + row * 1024 + col0 + bj * HALF); }
#pragma unroll
            for (int m = 0; m < 4; ++m) { const size_t row = (size_t)(row0 + ai * HALF + m * 16);
#pragma unroll
                for (int bj = 0; bj < 2; ++bj) { f32x4 g0, g1, p0 = {0.f, 0.f, 0.f, 0.f}, p1 = {0.f, 0.f, 0.f, 0.f}; unpack8(gw[m][bj], g0, g1); if (!FIRST) unpack8(pw[m][bj], p0, p1);
                    const f32x4 v0 = p0 + acc[ai][bj][m][0] * g0, v1 = p1 + acc[ai][bj][m][1] * g1;
                    *(u32x4*)(merged + row * 1024 + col0 + bj * HALF) = pack8(v0, v1); } }
            asm volatile("" ::: "memory");
        }
    }
};
struct EpiUp {
    static constexpr bool PERM = true;
    bf16_t* upb;
    __device__ __forceinline__ void operator()(AccRef acc, const Unit& u, int wr, int wc, int fr, int fq) const {
        const int row0 = u.pm * BM + wr * 64 + fr; const int col0 = u.pn * 256 + wc * 32 + 8 * fq;
#pragma unroll
        for (int ai = 0; ai < 2; ++ai)
#pragma unroll
            for (int m = 0; m < 4; ++m) { bf16_t* rowp = upb + (size_t)(row0 + ai * HALF + m * 16) * DFF + col0;
#pragma unroll
                for (int bj = 0; bj < 2; ++bj) { f32x4 v0 = acc[ai][bj][m][0], v1 = acc[ai][bj][m][1];
#pragma unroll
                    for (int j = 0; j < 4; ++j) { const float a = fmaxf(v0[j], 0.f), b = fmaxf(v1[j], 0.f); v0[j] = a * a; v1[j] = b * b; }
                    *(u32x4*)(rowp + bj * HALF) = pack8(v0, v1); } }
    }
};
struct EpiOut {
    static constexpr bool PERM = true;
    const float* x; bf16_t* v;
    __device__ __forceinline__ void operator()(AccRef acc, const Unit& u, int wr, int wc, int fr, int fq) const {
        const int row0 = u.pm * BM + wr * 64 + fr, col0 = u.pn * BM + wc * 32 + 8 * fq;
#pragma unroll
        for (int ai = 0; ai < 2; ++ai) {
            f32x4 xv[4][2][2];
#pragma unroll
            for (int m = 0; m < 4; ++m)
#pragma unroll
                for (int bj = 0; bj < 2; ++bj)
#pragma unroll
                    for (int n = 0; n < 2; ++n) xv[m][bj][n] = *(const f32x4*)(x + (size_t)(row0 + ai * HALF + m * 16) * DM + col0 + bj * HALF + n * 4);
#pragma unroll
            for (int m = 0; m < 4; ++m) { const size_t off = (size_t)(row0 + ai * HALF + m * 16) * DM + col0;
#pragma unroll
                for (int bj = 0; bj < 2; ++bj) *(u32x4*)(v + off + bj * HALF) = pack8(xv[m][bj][0] * ALPHA + acc[ai][bj][m][0], xv[m][bj][1] * ALPHA + acc[ai][bj][m][1]); }
            asm volatile("" ::: "memory");
        }
    }
};
struct EpiDown {
    static constexpr bool PERM = true;
    const bf16_t* h1b; bf16_t* y;
    __device__ __forceinline__ void operator()(AccRef acc, const Unit& u, int wr, int wc, int fr, int fq) const {
        const int row0 = u.pm * BM + wr * 64 + fr, col0 = u.pn * BM + wc * 32 + 8 * fq;
        u32x4 hw[2][4][2];
#pragma unroll
        for (int ai = 0; ai < 2; ++ai)
#pragma unroll
            for (int m = 0; m < 4; ++m)
#pragma unroll
                for (int bj = 0; bj < 2; ++bj) hw[ai][m][bj] = *(const u32x4*)(h1b + (size_t)(row0 + ai * HALF + m * 16) * DM + col0 + bj * HALF);
#pragma unroll
        for (int ai = 0; ai < 2; ++ai)
#pragma unroll
            for (int m = 0; m < 4; ++m) { const size_t off = (size_t)(row0 + ai * HALF + m * 16) * DM + col0;
#pragma unroll
                for (int bj = 0; bj < 2; ++bj) { f32x4 h0, h1; unpack8(hw[ai][m][bj], h0, h1);
                    *(u32x4*)(y + off + bj * HALF) = pack8(h0 * ALPHA + acc[ai][bj][m][0], h1 * ALPHA + acc[ai][bj][m][1]); } }
    }
};
}

struct TrJob { const float* src; int ld_src, col0, K, ncols, nvalid; bf16_t* dst; int ld_dst; const float* cscale; };
__device__ __forceinline__ int tr_tiles(int K, int ncols) { return (K / 64) * (ncols / 256); }
__device__ __forceinline__ bool tr_pick(const Params& p, int gt, TrJob& J, int& lt) {
    unsigned char* ws = p.ws; const float* w_in = p.in[1];
    bf16_t* win1 = (bf16_t*)(ws + WS_WIN1); bf16_t* win2 = (bf16_t*)(ws + WS_WIN2);
    int base = 0, n;
#define TRJ(SRC, LDS_, COL0, K_, NC, NV, DST, LDD, CS) do { n = tr_tiles((K_), (NC)); if (gt < base + n) { J.src = (SRC); J.ld_src = (LDS_); J.col0 = (COL0); J.K = (K_); J.ncols = (NC); J.nvalid = (NV); J.dst = (DST); J.ld_dst = (LDD); J.cscale = (CS); lt = gt - base; return true; } base += n; } while (0)
    TRJ(w_in, 9248, 3072, 1024, 4096, 4096, win1 + (size_t)2048 * 1024, 1024, nullptr);
    TRJ(p.in[15], 4096, 0, 1024, 4096, 4096, (bf16_t*)(ws + WS_WUP), 1024, nullptr);
    TRJ(p.in[16], 1024, 0, 4096, 1024, 1024, (bf16_t*)(ws + WS_WDN), 4096, nullptr);
    TRJ(w_in, 9248, 1024, 1024, 2048, 2048, win1, 1024, nullptr);
    TRJ(w_in, 9248, 7200, 1024, 2048, 2048, win2 + (size_t)1024 * 1024, 1024, nullptr);
    TRJ(p.in[9], 1024, 0, 2048, 1024, 1024, (bf16_t*)(ws + WS_WSSD), 2048, nullptr);
    TRJ(w_in, 9248, 0, 1024, 1024, 1024, win2, 1024, nullptr);
    TRJ(p.in[12], 1024, 0, 1024, 1024, 1024, (bf16_t*)(ws + WS_WOUT), 1024, nullptr);
    TRJ(w_in, 9248, 7168, 1024, 256, 32, win1 + (size_t)6144 * 1024, 1024, nullptr);
    TRJ(p.in[10], 256, 0, 256, 256, 256, (bf16_t*)(ws + WS_WP), 256, p.in[11]);
    TRJ(p.in[10] + 65536, 256, 0, 256, 256, 256, (bf16_t*)(ws + WS_WP) + 65536, 256, p.in[11] + 256);
    TRJ(p.in[10] + 2 * 65536, 256, 0, 256, 256, 256, (bf16_t*)(ws + WS_WP) + 2 * 65536, 256, p.in[11] + 512);
    TRJ(p.in[10] + 3 * 65536, 256, 0, 256, 256, 256, (bf16_t*)(ws + WS_WP) + 3 * 65536, 256, p.in[11] + 768);
#undef TRJ
    return false;
}
__device__ void phase0(const Params& p, unsigned char* smem) {
    unsigned char* ws = p.ws;
    { const float* __restrict__ x = p.in[0]; bf16_t* __restrict__ xb = (bf16_t*)(ws + WS_RC);
      const size_t nvec = (size_t)T_TOK * DM / 8, stride = (size_t)gridDim.x * blockDim.x;
      for (size_t i = (size_t)blockIdx.x * blockDim.x + threadIdx.x; i < nvec; i += 4 * stride) {
          f32x4 a[4], b[4];
#pragma unroll
          for (int k = 0; k < 4; ++k) { a[k] = *(const f32x4*)(x + (i + k * stride) * 8); b[k] = *(const f32x4*)(x + (i + k * stride) * 8 + 4); }
#pragma unroll
          for (int k = 0; k < 4; ++k) *(u32x4*)(xb + (i + k * stride) * 8) = pack8(a[k], b[k]); } }
    float* t = (float*)smem;
    const int tid = threadIdx.x;
    for (int gt = blockIdx.x; ; gt += gridDim.x) {
        TrJob J; int lt;
        if (!tr_pick(p, gt, J, lt)) break;
        const int tn = J.ncols / 256; const int k0 = (lt / tn) * 64, n0 = (lt % tn) * 256;
        __syncthreads();
        float v[4][8];
#pragma unroll
        for (int sb = 0; sb < 4; ++sb)
#pragma unroll
            for (int i = 0; i < 8; ++i) { const int k = (tid >> 6) + 8 * i, n = n0 + sb * 64 + (tid & 63); const int nc = n < J.nvalid ? n : 0;
                const float ld = J.src[(size_t)(k0 + k) * J.ld_src + J.col0 + nc]; v[sb][i] = n < J.nvalid ? ld : 0.f; }
#pragma unroll
        for (int sb = 0; sb < 4; ++sb) { const float sc = J.cscale ? J.cscale[n0 + sb * 64 + (tid & 63)] : 1.0f;
#pragma unroll
            for (int i = 0; i < 8; ++i) t[(sb * 64 + (tid >> 6) + 8 * i) * 65 + (tid & 63)] = v[sb][i] * sc; }
        __syncthreads();
        const int n = tid >> 3, kk = (tid & 7) * 8;
#pragma unroll
        for (int sb = 0; sb < 4; ++sb) { float e[8];
#pragma unroll
            for (int j = 0; j < 8; ++j) e[j] = t[(sb * 64 + kk + j) * 65 + n];
            u32x4 w; w.x = cvt_pk_bf16(e[0], e[1]); w.y = cvt_pk_bf16(e[2], e[3]); w.z = cvt_pk_bf16(e[4], e[5]); w.w = cvt_pk_bf16(e[6], e[7]);
            *(u32x4*)(J.dst + (size_t)(n0 + sb * 64 + n) * J.ld_dst + k0 + kk) = w; }
    }
}

__device__ void phase_ssd_simple(const Params& p, unsigned char* smem) {
    unsigned char* ws = p.ws;
    const bf16_t* xbc = (const bf16_t*)(ws + WS_RA); bf16_t* zy = (bf16_t*)(ws + WS_RB); const float* dtb = (const float*)(ws + WS_DT);
    const float* conv_w = p.in[3]; const float* conv_b = p.in[4]; const float* a_log = p.in[6]; const float* d_skip = p.in[7]; const float* norm_w = p.in[8];
    float* sX = (float*)smem;
    float* sY = sX + 16 * 512;
    float* sdt = sY + 16 * 256;
    const int tid = threadIdx.x;
    for (int item = blockIdx.x; item < 256; item += gridDim.x) {
        const int b = item >> 3, g = item & 7;
        const int ch = tid; int gcol;
        if (ch < 256) gcol = g * 256 + ch; else if (ch < 384) gcol = 2048 + g * 128 + (ch - 256); else gcol = 3072 + g * 128 + (ch - 384);
        const float cw0 = conv_w[gcol], cw1 = conv_w[4096 + gcol], cw2 = conv_w[8192 + gcol], cw3 = conv_w[12288 + gcol], cb = conv_b[gcol];
        float u1 = 0.f, u2 = 0.f, u3 = 0.f;
        const int r = tid >> 7, pp = (tid & 127) >> 1, nh = tid & 1;
        const float a_r = -__expf(a_log[g * 4 + r]), d_r = d_skip[g * 4 + r];
        float hst[64];
#pragma unroll
        for (int i = 0; i < 64; ++i) hst[i] = 0.f;
        for (int blk = 0; blk < SEQ / 16; ++blk) {
            const size_t t0 = (size_t)b * SEQ + (size_t)blk * 16;
#pragma unroll 4
            for (int tt = 0; tt < 16; ++tt) { const float raw = bf2f(xbc[(t0 + tt) * 4096 + gcol]);
                const float y = cb + cw0 * u1 + cw1 * u2 + cw2 * u3 + cw3 * raw; u1 = u2; u2 = u3; u3 = raw;
                sX[tt * 512 + ch] = siluf_(y); }
            if (tid < 64) sdt[tid] = dtb[(t0 + (tid >> 2)) * 32 + g * 4 + (tid & 3)];
            __syncthreads();
            for (int tt = 0; tt < 16; ++tt) {
                const float dt = sdt[tt * 4 + r], dec = __expf(dt * a_r), xv = sX[tt * 512 + r * 64 + pp], xdt = xv * dt;
                const float* Bp = sX + tt * 512 + 256 + nh * 64; const float* Cp = sX + tt * 512 + 384 + nh * 64;
                float y = 0.f;
#pragma unroll
                for (int i = 0; i < 64; ++i) { hst[i] = hst[i] * dec + xdt * Bp[i]; y += hst[i] * Cp[i]; }
                y += __shfl_xor(y, 1);
                if (nh == 0) { const float zv = bf2f(zy[(t0 + tt) * 2048 + g * 256 + r * 64 + pp]); sY[tt * 256 + r * 64 + pp] = (y + d_r * xv) * zv; }
            }
            __syncthreads();
            { const int tt = tid >> 5, c0 = (tid & 31) * 8; float e[8]; float ss = 0.f;
#pragma unroll
              for (int j = 0; j < 8; ++j) { e[j] = sY[tt * 256 + c0 + j]; ss += e[j] * e[j]; }
              ss += __shfl_xor(ss, 16); ss += __shfl_xor(ss, 8); ss += __shfl_xor(ss, 4); ss += __shfl_xor(ss, 2); ss += __shfl_xor(ss, 1);
              const float rstd = rsqrtf(ss * (1.0f / 256.0f) + RMS_EPS);
              const f32x4 w0 = *(const f32x4*)(norm_w + g * 256 + c0), w1 = *(const f32x4*)(norm_w + g * 256 + c0 + 4);
              u32x4 o; o.x = cvt_pk_bf16(e[0] * rstd * w0[0], e[1] * rstd * w0[1]); o.y = cvt_pk_bf16(e[2] * rstd * w0[2], e[3] * rstd * w0[3]);
              o.z = cvt_pk_bf16(e[4] * rstd * w1[0], e[5] * rstd * w1[1]); o.w = cvt_pk_bf16(e[6] * rstd * w1[2], e[7] * rstd * w1[3]);
              *(u32x4*)(zy + (t0 + tt) * 2048 + g * 256 + c0) = o; }
            __syncthreads();
        }
    }
}


constexpr int SX_STR = 144, SN_STR = 272, SZ_STR = 528;
constexpr int O_XT = 0;
constexpr int O_BT = O_XT + 256 * SX_STR;
constexpr int O_BN = O_BT + 128 * SX_STR;
constexpr int O_CN = O_BN + 64 * SN_STR;
constexpr int O_CB = O_CN + 64 * SN_STR;
constexpr int O_ZT = O_CB + 64 * SN_STR;
constexpr int O_ACS = O_ZT + 64 * SZ_STR;
constexpr int O_DT = O_ACS + 1024;
constexpr int O_WG = O_DT + 1024;
constexpr int O_EA = O_WG + 1024;
constexpr int O_SSQ = O_EA + 1024;
constexpr int O_RSTD = O_SSQ + 2048;
constexpr int O_CW = O_RSTD + 256;
constexpr int O_RSW = O_CW + 5 * 512 * 4;
constexpr int SSD_LDS = O_RSW + 2048;
static_assert(SSD_LDS <= LDS_BYTES, "LDS");
#define MFMA16(a, b, c) __builtin_amdgcn_mfma_f32_16x16x32_bf16((a), (b), (c), 0, 0, 0)

template <int CTRL> __device__ __forceinline__ float dpp_add(float v) { return v + __builtin_bit_cast(float, __builtin_amdgcn_update_dpp(0, __builtin_bit_cast(int, v), CTRL, 0xf, 0xf, false)); }
__device__ __forceinline__ float row16_sum(float v) { v = dpp_add<0xB1>(v); v = dpp_add<0x4E>(v); v = dpp_add<0x124>(v); v = dpp_add<0x128>(v); return v; }
__device__ __forceinline__ f32x4 unpack4(u32x2 w) { return (f32x4){bf_lo(w.x), bf_hi(w.x), bf_lo(w.y), bf_hi(w.y)}; }

__device__ void phase_ssd(const Params& p, LAS unsigned char* sm) {
    unsigned char* ws = p.ws;
    const bf16_t* xbc = (const bf16_t*)(ws + WS_RA); bf16_t* zy = (bf16_t*)(ws + WS_RB); const float* dtb = (const float*)(ws + WS_DT);
    const float* conv_w = p.in[3]; const float* conv_b = p.in[4]; const float* a_log = p.in[6]; const float* d_skip = p.in[7]; const float* norm_w = p.in[8];
    const int tid = threadIdx.x, lane = tid & 63, w = __builtin_amdgcn_readfirstlane(tid >> 6), c = lane & 15, q = lane >> 4;
    const int r = w >> 1, ph = w & 1;
    const int tq = tid >> 7, ch0 = (tid & 127) * 4;
    LAS float* ACS = (LAS float*)(sm + O_ACS); LAS float* DTV = (LAS float*)(sm + O_DT); LAS float* WG = (LAS float*)(sm + O_WG); LAS float* EA = (LAS float*)(sm + O_EA);
    LAS float* SSQ = (LAS float*)(sm + O_SSQ); LAS float* RSTD = (LAS float*)(sm + O_RSTD);
    for (int item = blockIdx.x; item < 256; item += gridDim.x) {
        const int b = item >> 3, g = item & 7;
#define SSD_GCOL(CH) ((CH) < 256 ? g * 256 + (CH) : ((CH) < 384 ? 1792 + g * 128 + (CH) : 2688 + g * 128 + (CH)))
        { const int gcol = SSD_GCOL(ch0);
        __syncthreads();
        if (tq == 0) {
#pragma unroll
            for (int k = 0; k < 4; ++k) *(LAS f32x4*)(sm + O_CW + (k * 512 + ch0) * 4) = *(const f32x4*)(conv_w + k * 4096 + gcol);
            *(LAS f32x4*)(sm + O_CW + (4 * 512 + ch0) * 4) = *(const f32x4*)(conv_b + gcol); }
        __syncthreads(); }
        const float d_r = d_skip[g * 4 + r];
        const float a_w = -__expf(a_log[g * 4 + (w & 3)]);
        const int prow0 = r * 64 + ph * 32 + c;
        const float nw0 = norm_w[g * 256 + prow0], nw1 = norm_w[g * 256 + prow0 + 16];
        f32x4 accH[8][2];
#pragma unroll
        for (int nt = 0; nt < 8; ++nt)
#pragma unroll
            for (int pt = 0; pt < 2; ++pt) accH[nt][pt] = (f32x4){0.f, 0.f, 0.f, 0.f};
        u32x2 raw[19]; u32x4 zr[4]; float dtn = 0.f;
#define SSD_ISSUE(SUBN) do { int sn_ = (SUBN); asm volatile("" : "+s"(sn_)); int tid_ = tid; asm volatile("" : "+v"(tid_)); const int ch_ = (tid_ & 127) * 4; const int gc_ = SSD_GCOL(ch_); \
            const int sl0_ = sn_ * 64 + (tid_ >> 7) * 16 - 3; const bf16_t* rp_ = xbc + ((size_t)b * SEQ + (sl0_ < 0 ? 0 : sl0_)) * 4096 + gc_; \
            _Pragma("unroll") for (int i = 0; i < 19; ++i) { const int sl = sl0_ + i; \
                const u32x2 v = *(const u32x2*)(rp_ + (sl0_ < 0 ? (i < 3 ? 0 : i - 3) : i) * 4096); raw[i].x = sl < 0 ? 0u : v.x; raw[i].y = sl < 0 ? 0u : v.y; } \
            const bf16_t* zp_ = zy + ((size_t)b * SEQ + (size_t)sn_ * 64 + (tid_ >> 5)) * 2048 + g * 256 + (tid_ & 31) * 8; \
            _Pragma("unroll") for (int k = 0; k < 4; ++k) zr[k] = *(const u32x4*)(zp_ + (size_t)k * 16 * 2048); \
            if (w < 4) dtn = dtb[((size_t)b * SEQ + (size_t)sn_ * 64 + lane) * 32 + g * 4 + w]; } while (0)
        SSD_ISSUE(0);
#pragma unroll 1
        for (int sub = 0; sub < SEQ / 64; ++sub) {
            const size_t t0 = (size_t)b * SEQ + (size_t)sub * 64;
            {
                const f32x4 cw0 = *(const LAS f32x4*)(sm + O_CW + ch0 * 4), cw1 = *(const LAS f32x4*)(sm + O_CW + (512 + ch0) * 4), cw2 = *(const LAS f32x4*)(sm + O_CW + (1024 + ch0) * 4),
                            cw3 = *(const LAS f32x4*)(sm + O_CW + (1536 + ch0) * 4), cbv = *(const LAS f32x4*)(sm + O_CW + (2048 + ch0) * 4);
                f32x4 u0 = unpack4(raw[0]), u1 = unpack4(raw[1]), u2 = unpack4(raw[2]);
                unsigned tr[4][8]; f32x4 pv = {0.f, 0.f, 0.f, 0.f};
                LAS unsigned char* nb = ch0 < 384 ? sm + O_BN + (ch0 - 256) * 2 : sm + O_CN + (ch0 - 384) * 2;
#pragma unroll
                for (int i = 0; i < 16; ++i) {
                    const f32x4 u3 = unpack4(raw[i + 3]);
                    f32x4 y = cbv + cw0 * u0 + cw1 * u1 + cw2 * u2 + cw3 * u3;
#pragma unroll
                    for (int j = 0; j < 4; ++j) y[j] = siluf_(y[j]);
                    if (ch0 >= 256) *(LAS u32x2*)(nb + (tq * 16 + i) * SN_STR) = (u32x2){cvt_pk_bf16(y[0], y[1]), cvt_pk_bf16(y[2], y[3])};
                    if (i & 1) {
#pragma unroll
                        for (int j = 0; j < 4; ++j) tr[j][i >> 1] = cvt_pk_bf16(pv[j], y[j]); }
                    else pv = y;
                    u0 = u1; u1 = u2; u2 = u3;
                }
                if (ch0 < 384) {
                    LAS unsigned char* tb = ch0 < 256 ? sm + O_XT + ch0 * SX_STR : sm + O_BT + (ch0 - 256) * SX_STR;
#pragma unroll
                    for (int j = 0; j < 4; ++j) { *(LAS u32x4*)(tb + j * SX_STR + tq * 32) = (u32x4){tr[j][0], tr[j][1], tr[j][2], tr[j][3]};
                        *(LAS u32x4*)(tb + j * SX_STR + tq * 32 + 16) = (u32x4){tr[j][4], tr[j][5], tr[j][6], tr[j][7]}; }
                }
            }
            if (w < 4) {
                const float dt = dtn; float x = dt * a_w;
#pragma unroll
                for (int o = 1; o < 64; o <<= 1) { const float v = __shfl_up(x, o); if (lane >= o) x += v; }
                const float last = __shfl(x, 63);
                ACS[w * 64 + lane] = x; DTV[w * 64 + lane] = dt; WG[w * 64 + lane] = dt * __expf(last - x); EA[w * 64 + lane] = __expf(x);
            }
            __syncthreads();
            {
#pragma unroll
                for (int k = 0; k < 4; ++k) { const int v = tid + 512 * k, l = v >> 5, c8 = (v & 31) * 8; *(LAS u32x4*)(sm + O_ZT + l * SZ_STR + c8 * 2) = zr[k]; }
                const int lt = w >> 1;
#pragma unroll
                for (int sti = 0; sti < 2; ++sti) { const int st = 2 * (w & 1) + sti; f32x4 acc = {0.f, 0.f, 0.f, 0.f};
#pragma unroll
                    for (int ks = 0; ks < 4; ++ks) { const bf16x8 a = *(const LAS bf16x8*)(sm + O_CN + (16 * lt + c) * SN_STR + (32 * ks + 8 * q) * 2);
                        const bf16x8 bb = *(const LAS bf16x8*)(sm + O_BN + (16 * st + c) * SN_STR + (32 * ks + 8 * q) * 2); acc = MFMA16(a, bb, acc); }
#pragma unroll
                    for (int rg = 0; rg < 4; ++rg) *(LAS float*)(sm + O_CB + (16 * lt + 4 * q + rg) * SN_STR + (16 * st + c) * 4) = acc[rg]; }
            }
            __syncthreads();
            f32x4 accY[4][2];
#pragma unroll
            for (int lt = 0; lt < 4; ++lt)
#pragma unroll
                for (int pt = 0; pt < 2; ++pt) accY[lt][pt] = (f32x4){0.f, 0.f, 0.f, 0.f};
#pragma unroll
            for (int ks = 0; ks < 4; ++ks) {
                bf16x8 hb[2];
#pragma unroll
                for (int pt = 0; pt < 2; ++pt) hb[pt] = __builtin_bit_cast(bf16x8, pack8(accH[2 * ks][pt], accH[2 * ks + 1][pt]));
#pragma unroll
                for (int lt = 0; lt < 4; ++lt) { const LAS unsigned char* cp = sm + O_CN + (16 * lt + c) * SN_STR + (32 * ks + 4 * q) * 2;
                    const u32x2 lo = *(const LAS u32x2*)cp, hi = *(const LAS u32x2*)(cp + 32);
                    const bf16x8 a = __builtin_bit_cast(bf16x8, (u32x4){lo.x, lo.y, hi.x, hi.y});
#pragma unroll
                    for (int pt = 0; pt < 2; ++pt) accY[lt][pt] = MFMA16(a, hb[pt], accY[lt][pt]); }
            }
#pragma unroll
            for (int lt = 0; lt < 4; ++lt) { const f32x4 e = *(const LAS f32x4*)(EA + r * 64 + 16 * lt + 4 * q);
#pragma unroll
                for (int pt = 0; pt < 2; ++pt) accY[lt][pt] *= e; }
            bf16x8 xf[2][2];
#pragma unroll
            for (int ks = 0; ks < 2; ++ks)
#pragma unroll
                for (int pt = 0; pt < 2; ++pt) xf[ks][pt] = *(const LAS bf16x8*)(sm + O_XT + (prow0 + 16 * pt) * SX_STR + (32 * ks + 8 * q) * 2);
#pragma unroll
            for (int lt = 0; lt < 4; ++lt)
#pragma unroll
                for (int ks = 0; ks < 2; ++ks) {
                    if (ks == 1 && lt < 2) continue;
                    const int l = 16 * lt + c; const float acl = ACS[r * 64 + l];
                    const LAS float* cbp = (const LAS float*)(sm + O_CB + l * SN_STR) + 32 * ks + 8 * q;
                    const f32x4 cb0 = *(const LAS f32x4*)cbp, cb1 = *(const LAS f32x4*)(cbp + 4);
                    const f32x4 as0 = *(const LAS f32x4*)(ACS + r * 64 + 32 * ks + 8 * q), as1 = *(const LAS f32x4*)(ACS + r * 64 + 32 * ks + 8 * q + 4);
                    const f32x4 d0 = *(const LAS f32x4*)(DTV + r * 64 + 32 * ks + 8 * q), d1 = *(const LAS f32x4*)(DTV + r * 64 + 32 * ks + 8 * q + 4);
                    f32x4 m0, m1;
#pragma unroll
                    for (int j = 0; j < 4; ++j) { const int s0 = 32 * ks + 8 * q + j, s1 = s0 + 4;
                        m0[j] = (s0 <= l) ? cb0[j] * __expf(acl - as0[j]) * d0[j] : 0.f;
                        m1[j] = (s1 <= l) ? cb1[j] * __expf(acl - as1[j]) * d1[j] : 0.f; }
                    const bf16x8 mf = __builtin_bit_cast(bf16x8, pack8(m0, m1));
#pragma unroll
                    for (int pt = 0; pt < 2; ++pt) accY[lt][pt] = MFMA16(mf, xf[ks][pt], accY[lt][pt]);
                }
#pragma unroll
            for (int lt = 0; lt < 4; ++lt) {
#pragma unroll
                for (int pt = 0; pt < 2; ++pt) { const int prow = prow0 + 16 * pt;
                    const f32x4 xv = unpack4(*(const LAS u32x2*)(sm + O_XT + prow * SX_STR + (16 * lt + 4 * q) * 2));
#pragma unroll
                    for (int rg = 0; rg < 4; ++rg) { const int l = 16 * lt + 4 * q + rg; const float zv = bf2f(*(const LAS bf16_t*)(sm + O_ZT + l * SZ_STR + prow * 2));
                        accY[lt][pt][rg] = (accY[lt][pt][rg] + d_r * xv[rg]) * zv; } }
                f32x4 sv;
#pragma unroll
                for (int rg = 0; rg < 4; ++rg) sv[rg] = row16_sum(accY[lt][0][rg] * accY[lt][0][rg] + accY[lt][1][rg] * accY[lt][1][rg]);
                if (c == 0) *(LAS f32x4*)(SSQ + w * 64 + 16 * lt + 4 * q) = sv;
            }
            {
                const float dec = __expf(ACS[r * 64 + 63]);
#pragma unroll
                for (int nt = 0; nt < 8; ++nt)
#pragma unroll
                    for (int pt = 0; pt < 2; ++pt) accH[nt][pt] *= dec;
                bf16x8 xw[2][2];
#pragma unroll
                for (int ks = 0; ks < 2; ++ks) { const f32x4 w0 = *(const LAS f32x4*)(WG + r * 64 + 32 * ks + 8 * q), w1 = *(const LAS f32x4*)(WG + r * 64 + 32 * ks + 8 * q + 4);
#pragma unroll
                    for (int pt = 0; pt < 2; ++pt) { f32x4 a, bq; unpack8(__builtin_bit_cast(u32x4, xf[ks][pt]), a, bq); xw[ks][pt] = __builtin_bit_cast(bf16x8, pack8(a * w0, bq * w1)); } }
#pragma unroll
                for (int nt = 0; nt < 8; ++nt)
#pragma unroll
                    for (int ks = 0; ks < 2; ++ks) { const bf16x8 bfr = *(const LAS bf16x8*)(sm + O_BT + (16 * nt + c) * SX_STR + (32 * ks + 8 * q) * 2);
#pragma unroll
                        for (int pt = 0; pt < 2; ++pt) accH[nt][pt] = MFMA16(bfr, xw[ks][pt], accH[nt][pt]); }
            }
            SSD_ISSUE(sub + 1 < SEQ / 64 ? sub + 1 : sub);
            __syncthreads();
            { float s = 0.f;
#pragma unroll
              for (int k = 0; k < 8; ++k) s += SSQ[k * 64 + lane];
              LAS float* RSW = (LAS float*)(sm + O_RSW) + w * 64;
              RSW[lane] = rsqrtf(s * (1.0f / 256.0f) + RMS_EPS);
#pragma unroll
              for (int lt = 0; lt < 4; ++lt) { const f32x4 rs = *(const LAS f32x4*)(RSW + 16 * lt + 4 * q);
#pragma unroll
                for (int pt = 0; pt < 2; ++pt) { const float nw = pt ? nw1 : nw0;
#pragma unroll
                    for (int rg = 0; rg < 4; ++rg) { const int l = 16 * lt + 4 * q + rg;
                        *(LAS bf16_t*)(sm + O_ZT + l * SZ_STR + (prow0 + 16 * pt) * 2) = (bf16_t)(cvt_pk_bf16(accY[lt][pt][rg] * rs[rg] * nw, 0.f) & 0xffffu); } } }
#pragma unroll
              for (int k = 0; k < 4; ++k) { const int row = (lane >> 2) + 16 * k, pc = lane & 3;
                *(u32x4*)(zy + (t0 + row) * 2048 + g * 256 + r * 64 + ph * 32 + pc * 8) = *(const LAS u32x4*)(sm + O_ZT + row * SZ_STR + (r * 64 + ph * 32 + pc * 8) * 2); }
            }
        }
    }
}

template <int W, int RUN = 16>
__device__ __forceinline__ void pool_task(const bf16_t* __restrict__ colp, bf16_t* __restrict__ outp, int t0, int s0) {
    constexpr int H = W - 1;
    u32x4 rw[RUN + H];
#pragma unroll
    for (int j = 0; j < RUN + H; ++j) { int tt = t0 - H + j; tt = tt < 0 ? 0 : tt; rw[j] = *(const u32x4*)(colp + (size_t)tt * 1024); }
    f32x4 S0 = {0.f, 0.f, 0.f, 0.f}, S1 = {0.f, 0.f, 0.f, 0.f};
#pragma unroll
    for (int j = 1; j <= H; ++j) { f32x4 a, b; unpack8(rw[H - j], a, b); const bool ok = (s0 - j >= 0); S0 += ok ? a : (f32x4){0.f, 0.f, 0.f, 0.f}; S1 += ok ? b : (f32x4){0.f, 0.f, 0.f, 0.f}; }
#pragma unroll
    for (int tt = 0; tt < RUN; ++tt) { const int s = s0 + tt;
        f32x4 a, b; unpack8(rw[H + tt], a, b); S0 += a; S1 += b;
        const float inv = 1.0f / (float)(s + 1 < W ? s + 1 : W);
        *(u32x4*)(outp + (size_t)(t0 + tt) * 1024) = pack8(S0 * inv - a, S1 * inv - b);
        f32x4 c, d; unpack8(rw[tt], c, d);
        if (s - W + 1 >= 0) { S0 -= c; S1 -= d; } }
}
__device__ __forceinline__ void pool_tile(const Params& p, int pm, int g) {
    const bf16_t* up = (const bf16_t*)(p.ws + WS_RA); bf16_t* pooled = (bf16_t*)(p.ws + WS_RA + 384 * MiB);
    int tl = threadIdx.x; asm volatile("" : "+v"(tl));
    const int vec = g * 32 + (tl & 31), run = tl >> 5;
    const int t0 = pm * 256 + run * 16, s0 = t0 & (SEQ - 1);
    const bf16_t* colp = up + vec * 8; bf16_t* outp = pooled + vec * 8;
    if (g == 0) pool_task<2>(colp, outp, t0, s0); else if (g == 1) pool_task<4>(colp, outp, t0, s0);
    else if (g == 2) pool_task<8>(colp, outp, t0, s0); else { pool_task<16, 8>(colp, outp, t0, s0); pool_task<16, 8>(colp, outp, t0 + 8, s0 + 8); }
}

template <bool OUT_BF16>
__device__ void phase_ln(const bf16_t* __restrict__ src, void* __restrict__ dst, const float* __restrict__ gam, const float* __restrict__ bet) {
    const int lane = threadIdx.x & 63, wv = threadIdx.x >> 6;
    f32x4 gv[4], bv[4];
#pragma unroll
    for (int i = 0; i < 2; ++i) { gv[2 * i] = *(const f32x4*)(gam + lane * 8 + 512 * i); gv[2 * i + 1] = *(const f32x4*)(gam + lane * 8 + 512 * i + 4);
        bv[2 * i] = *(const f32x4*)(bet + lane * 8 + 512 * i); bv[2 * i + 1] = *(const f32x4*)(bet + lane * 8 + 512 * i + 4); }
    for (int row0 = (blockIdx.x * 8 + wv) * 4; row0 < T_TOK; row0 += gridDim.x * 8 * 4) {
        u32x4 rw[4][2];
#pragma unroll
        for (int rr = 0; rr < 4; ++rr)
#pragma unroll
            for (int i = 0; i < 2; ++i) rw[rr][i] = *(const u32x4*)(src + (size_t)(row0 + rr) * DM + lane * 8 + 512 * i);
#pragma unroll
        for (int rr = 0; rr < 4; ++rr) {
            f32x4 v[4]; unpack8(rw[rr][0], v[0], v[1]); unpack8(rw[rr][1], v[2], v[3]);
            float s = 0.f;
#pragma unroll
            for (int i = 0; i < 4; ++i) s += (v[i][0] + v[i][1]) + (v[i][2] + v[i][3]);
#pragma unroll
            for (int o = 32; o >= 1; o >>= 1) s += __shfl_xor(s, o);
            const float mu = s * (1.0f / 1024.0f); float q = 0.f;
#pragma unroll
            for (int i = 0; i < 4; ++i) { v[i] -= mu; q += (v[i][0] * v[i][0] + v[i][1] * v[i][1]) + (v[i][2] * v[i][2] + v[i][3] * v[i][3]); }
#pragma unroll
            for (int o = 32; o >= 1; o >>= 1) q += __shfl_xor(q, o);
            const float rstd = rsqrtf(q * (1.0f / 1024.0f) + LN_EPS);
#pragma unroll
            for (int i = 0; i < 2; ++i) { const f32x4 o0 = v[2 * i] * rstd * gv[2 * i] + bv[2 * i], o1 = v[2 * i + 1] * rstd * gv[2 * i + 1] + bv[2 * i + 1];
                if (OUT_BF16) *(u32x4*)((bf16_t*)dst + (size_t)(row0 + rr) * DM + lane * 8 + 512 * i) = pack8(o0, o1);
                else { float* op = (float*)dst + (size_t)(row0 + rr) * DM + lane * 8 + 512 * i; *(f32x4*)op = o0; *(f32x4*)(op + 4) = o1; } }
        }
    }
}

__device__ __forceinline__ void ln_panel_bf16(const bf16_t* __restrict__ src, bf16_t* __restrict__ dst, const float* __restrict__ gam, const float* __restrict__ bet, int r0) {
    int tl = threadIdx.x; asm volatile("" : "+v"(tl));
    const int lane = tl & 63, wv = tl >> 6;
    f32x4 gv[4], bv[4];
#pragma unroll
    for (int i = 0; i < 2; ++i) { gv[2 * i] = *(const f32x4*)(gam + lane * 8 + 512 * i); gv[2 * i + 1] = *(const f32x4*)(gam + lane * 8 + 512 * i + 4);
        bv[2 * i] = *(const f32x4*)(bet + lane * 8 + 512 * i); bv[2 * i + 1] = *(const f32x4*)(bet + lane * 8 + 512 * i + 4); }
#pragma unroll 1
    for (int k = 0; k < 8; ++k) { const int row0 = r0 + wv * 32 + k * 4;
        u32x4 rw[4][2];
#pragma unroll
        for (int rr = 0; rr < 4; ++rr)
#pragma unroll
            for (int i = 0; i < 2; ++i) rw[rr][i] = *(const u32x4*)(src + (size_t)(row0 + rr) * DM + lane * 8 + 512 * i);
#pragma unroll
        for (int rr = 0; rr < 4; ++rr) {
            f32x4 v[4]; unpack8(rw[rr][0], v[0], v[1]); unpack8(rw[rr][1], v[2], v[3]);
            float sm = 0.f;
#pragma unroll
            for (int i = 0; i < 4; ++i) sm += (v[i][0] + v[i][1]) + (v[i][2] + v[i][3]);
#pragma unroll
            for (int o = 32; o >= 1; o >>= 1) sm += __shfl_xor(sm, o);
            const float mu = sm * (1.0f / 1024.0f); float q = 0.f;
#pragma unroll
            for (int i = 0; i < 4; ++i) { v[i] -= mu; q += (v[i][0] * v[i][0] + v[i][1] * v[i][1]) + (v[i][2] * v[i][2] + v[i][3] * v[i][3]); }
#pragma unroll
            for (int o = 32; o >= 1; o >>= 1) q += __shfl_xor(q, o);
            const float rstd = rsqrtf(q * (1.0f / 1024.0f) + LN_EPS);
#pragma unroll
            for (int i = 0; i < 2; ++i) *(u32x4*)(dst + (size_t)(row0 + rr) * DM + lane * 8 + 512 * i) = pack8(v[2 * i] * rstd * gv[2 * i] + bv[2 * i], v[2 * i + 1] * rstd * gv[2 * i + 1] + bv[2 * i + 1]);
        }
    }
}

#define XB_TMO      128
#define XB_XCNT(j)  (256  + 64 * (j))
#define XB_XSUB(j)  (1280 + 64 * (j))
#define XB_XGEN(j)  (2304 + 64 * (j))
#define XB_TOP      3328
#define XB_TOPGEN   3392
#define XCD_BAR_WORDS 3456
#define XB_SPIN_CAP (1u << 18)
__device__ __forceinline__ unsigned xb_ld(unsigned* p)              { return __hip_atomic_load(p, __ATOMIC_RELAXED, __HIP_MEMORY_SCOPE_AGENT); }
__device__ __forceinline__ unsigned xb_add(unsigned* p, unsigned v) { return __hip_atomic_fetch_add(p, v, __ATOMIC_RELAXED, __HIP_MEMORY_SCOPE_AGENT); }
__device__ __forceinline__ unsigned xb_xcc_id() { return (unsigned)__builtin_amdgcn_s_getreg((3 << 11) | 20) & 0xFu; }
#define XB_SPIN(cond, bar) do { unsigned _sp = 0; while (cond) { __builtin_amdgcn_s_sleep(1); \
    if ((++_sp & 255u) == 0u) { if (xb_ld(&(bar)[XB_TMO])) break; if (_sp > XB_SPIN_CAP) { atomicAdd(&(bar)[XB_TMO], 1u); break; } } } } while (0)
struct XcdBarrier { unsigned* bar; unsigned x; volatile LAS unsigned* st; };
__device__ __forceinline__ XcdBarrier xcd_barrier_post(unsigned* bar, volatile LAS unsigned* st) {
    XcdBarrier b; b.bar = bar; b.x = xb_xcc_id(); b.st = st;
    if (threadIdx.x == 0) (void)xb_add(&bar[XB_XCNT(b.x)], 1u);
    return b;
}
__device__ __forceinline__ void xcd_barrier_complete(unsigned* bar, unsigned x, unsigned& nloc, unsigned& nx) {
    const unsigned G = gridDim.x * gridDim.y * gridDim.z;
    unsigned sum, cnt, mine, sp = 0u;
    for (;;) {
        sum = 0u; cnt = 0u; mine = 0u;
#pragma unroll
        for (unsigned j = 0; j < 16; ++j) { const unsigned c = xb_ld(&bar[XB_XCNT(j)]); sum += c; cnt += (c > 0u) ? 1u : 0u; mine = (j == x) ? c : mine; }
        if (sum == G) break;
        __builtin_amdgcn_s_sleep(1);
        if ((++sp & 255u) == 0u) { if (xb_ld(&bar[XB_TMO])) break; if (sp > XB_SPIN_CAP) { atomicAdd(&bar[XB_TMO], 1u); break; } }
    }
    nloc = mine > 0u ? mine : 1u; nx = cnt > 0u ? cnt : 1u;
}
__device__ __forceinline__ void xcd_barrier(const XcdBarrier& b) {
    asm volatile("s_waitcnt vmcnt(0)" ::: "memory");
    __syncthreads();
    if (threadIdx.x == 0) {
        unsigned* bar = b.bar;
        __builtin_amdgcn_s_waitcnt(0);
        unsigned nloc = b.st[0], nx = b.st[1];
        if (nloc == 0u) { xcd_barrier_complete(bar, b.x, nloc, nx); b.st[0] = nloc; b.st[1] = nx; }
        const unsigned old = xb_add(&bar[XB_XSUB(b.x)], 1u);
        const unsigned gen = old / nloc;
        if (old + 1u == (gen + 1u) * nloc) {
            __builtin_amdgcn_fence(__ATOMIC_RELEASE, "agent");
            asm volatile("s_waitcnt vmcnt(0)" ::: "memory");
            const unsigned og = xb_add(&bar[XB_TOP], 1u);
            const unsigned tg = og / nx;
            if (og + 1u == (tg + 1u) * nx) xb_add(&bar[XB_TOPGEN], 1u);
            else XB_SPIN(xb_ld(&bar[XB_TOPGEN]) == tg, bar);
            __builtin_amdgcn_fence(__ATOMIC_ACQUIRE, "agent");
            xb_add(&bar[XB_XGEN(b.x)], 1u);
            asm volatile("s_waitcnt vmcnt(0)" ::: "memory");
        } else {
            XB_SPIN(xb_ld(&bar[XB_XGEN(b.x)]) == gen, bar);
            __builtin_amdgcn_fence(__ATOMIC_ACQUIRE, "agent");
            asm volatile("s_waitcnt vmcnt(0)" ::: "memory");
        }
    }
    __syncthreads();
}

__global__ void __launch_bounds__(512, 2) mega(Params p) {
    extern __shared__ __attribute__((aligned(16))) unsigned char lds_raw[];
    LAS unsigned char* lds = (LAS unsigned char*)lds_raw;
    cg::grid_group grid = cg::this_grid();
    unsigned char* ws = p.ws;
    const int G = gridDim.x, c = blockIdx.x;
    volatile LAS unsigned* xb_st = (volatile LAS unsigned*)(lds + LDS_XB);
    unsigned* xb_words = (unsigned*)(ws + WS_BAR);
    if (threadIdx.x == 0) { xb_st[0] = 0u; xb_st[1] = 0u; }
    __syncthreads();
    XcdBarrier xb; xb.bar = xb_words; xb.x = 0u; xb.st = xb_st;
#ifndef PHMASK
#define PHMASK 0x7ff
#endif
#define IN(k) (((PHMASK >> (k)) & 1) && p.ph_lo <= (k) && (k) < p.ph_hi)
#define SEAM(k) do { if (IN(k) && IN((k) + 1)) xcd_barrier(xb); } while (0)
    if (p.ph_hi == 0x7fffffff) grid.sync();
    if (p.ph_hi - p.ph_lo > 1) xb = xcd_barrier_post(xb_words, xb_st);
    if (IN(0)) phase0(p, lds_raw);
    SEAM(0);
    if (IN(1)) {
        { pg8::Gemm g{(const bf16_t*)(ws + WS_RC), (const bf16_t*)(ws + WS_WIN1), T_TOK, N1 - 256, 1024, 1024, 1024, 0};
          pg8::StaticOrder S; S.init(T_TOK, N1 - 256, G, c);
          pg8::EpiG1 E{(bf16_t*)(ws + WS_RB), (bf16_t*)(ws + WS_RA), (float*)(ws + WS_DT), p.in[5], 0};
          pg8::gemm_phase<pg8::EpiG1>(lds, g, S, E); }
        { pg8::Gemm g{(const bf16_t*)(ws + WS_RC), (const bf16_t*)(ws + WS_WIN1) + (size_t)(N1 - 256) * 1024, T_TOK, 256, 1024, 1024, 1024, 0};
          pg8::StaticOrder S; S.init(T_TOK, 256, G, c);
          pg8::EpiG1 E{(bf16_t*)(ws + WS_RB), (bf16_t*)(ws + WS_RA), (float*)(ws + WS_DT), p.in[5], 24};
          pg8::gemm_phase<pg8::EpiG1, true>(lds, g, S, E); }
    }
    SEAM(1);
    #ifdef SSD_SIMPLE
    if (IN(2)) phase_ssd_simple(p, lds_raw);
#else
    if (IN(2)) phase_ssd(p, lds);
#endif
    SEAM(2);
    if (IN(3)) {
        pg8::Gemm g{(const bf16_t*)(ws + WS_RC), (const bf16_t*)(ws + WS_WIN2), T_TOK, N2, 1024, 1024, 1024, 0};
        pg8::StaticOrder S; S.init(T_TOK, N2, G, c);
        pg8::EpiG2 E{(bf16_t*)(ws + WS_RA), (bf16_t*)(ws + WS_RA + 128 * MiB), p.in[2]};
        pg8::gemm_phase<pg8::EpiG2>(lds, g, S, E);
    }
    SEAM(3);
    if (IN(5)) {
        bf16_t* merged = (bf16_t*)(ws + WS_RC); const bf16_t* gates = (const bf16_t*)(ws + WS_RA + 128 * MiB);
        pg8::StaticOrder S; S.init(T_TOK, 1024, G, c);
        const pg8::Gemm gp{(const bf16_t*)(ws + WS_RA + 384 * MiB), (const bf16_t*)(ws + WS_WP), T_TOK, 1024, 256, 1024, 256, 512};
        const pg8::Gemm gs{(const bf16_t*)(ws + WS_RB), (const bf16_t*)(ws + WS_WSSD), T_TOK, 1024, 2048, 2048, 2048, 0};
        if ((c & 1) == 0) {
            { pg8::Unit u; for (int i = 0; S.next(i, u); ++i) pool_tile(p, u.pm, u.pn); }
            __syncthreads();
            { pg8::EpiPool<true> E{merged, gates}; pg8::gemm_phase<pg8::EpiPool<true>>(lds, gp, S, E); }
            { pg8::EpiSsd<false> E{merged, gates}; pg8::gemm_phase<pg8::EpiSsd<false>>(lds, gs, S, E); }
        } else {
            { pg8::EpiSsd<true> E{merged, gates}; pg8::gemm_phase<pg8::EpiSsd<true>>(lds, gs, S, E); }
            { pg8::Unit u; for (int i = 0; S.next(i, u); ++i) pool_tile(p, u.pm, u.pn); }
            __syncthreads();
            { pg8::EpiPool<false> E{merged, gates}; pg8::gemm_phase<pg8::EpiPool<false>>(lds, gp, S, E); }
        }
    }
    SEAM(5);
    if (IN(6)) {
        pg8::Gemm g{(const bf16_t*)(ws + WS_RC), (const bf16_t*)(ws + WS_WOUT), T_TOK, 1024, 1024, 1024, 1024, 0};
        pg8::StaticOrder S; S.init(T_TOK, 1024, G, c, 1);
        pg8::EpiOut E{p.in[0], (bf16_t*)(ws + WS_RB)};
        pg8::gemm_phase<pg8::EpiOut>(lds, g, S, E);
        __syncthreads();
        for (int pm = c; pm < T_TOK / 256; pm += G) ln_panel_bf16((const bf16_t*)(ws + WS_RB), (bf16_t*)(ws + WS_RC), p.in[13], p.in[14], pm * 256);
    }
    SEAM(6);
    if (IN(8)) {
        pg8::Gemm g{(const bf16_t*)(ws + WS_RC), (const bf16_t*)(ws + WS_WUP), T_TOK, DFF, 1024, 1024, 1024, 0};
        pg8::StaticOrder S; S.init(T_TOK, DFF, G, c);
        pg8::EpiUp E{(bf16_t*)(ws + WS_RA)};
        pg8::gemm_phase<pg8::EpiUp>(lds, g, S, E);
    }
    SEAM(8);
    if (IN(9)) {
        pg8::Gemm g{(const bf16_t*)(ws + WS_RA), (const bf16_t*)(ws + WS_WDN), T_TOK, 1024, DFF, DFF, DFF, 0};
        pg8::StaticOrder S; S.init(T_TOK, 1024, G, c);
        pg8::EpiDown E{(const bf16_t*)(ws + WS_RC), (bf16_t*)(ws + WS_RB)};
        pg8::gemm_phase<pg8::EpiDown>(lds, g, S, E);
    }
    SEAM(9);
    if (IN(10)) phase_ln<false>((const bf16_t*)(ws + WS_RB), (void*)p.out, p.in[17], p.in[18]);
#undef IN
#undef SEAM
}

#ifndef DUPMASK
#define DUPMASK 0
#endif
#ifndef ONE_LAUNCH
#define ONE_LAUNCH 1
#endif
extern "C" void kernel_launch(void* const* d_in, const int* in_sizes, int n_in, void* d_out, int out_size, void* d_ws, size_t ws_size, hipStream_t stream) {
    static int grid = 0;
    if (grid == 0) {
        if (n_in != 19 || ws_size < WS_END + 16384) { fprintf(stderr, "kernel_launch: need 19 inputs and >= %zu bytes of workspace; got %d, %zu\n", (size_t)WS_END, n_in, ws_size); grid = -1; return; }
        int dev = 0, cus = 0, per_cu = 0;
        hipGetDevice(&dev); hipDeviceGetAttribute(&cus, hipDeviceAttributeMultiprocessorCount, dev);
        if (hipFuncSetAttribute((const void*)mega, hipFuncAttributeMaxDynamicSharedMemorySize, LDS_BYTES) != hipSuccess) { fprintf(stderr, "kernel_launch: hipFuncSetAttribute failed\n"); grid = -1; return; }
        if (hipOccupancyMaxActiveBlocksPerMultiprocessor(&per_cu, (const void*)mega, 512, LDS_BYTES) != hipSuccess || per_cu < 1) { fprintf(stderr, "kernel_launch: occupancy query says %d\n", per_cu); per_cu = 1; }
        (void)hipGetLastError();
        grid = cus;
    }
    if (grid < 0) return;
    Params p{};
    for (int i = 0; i < 19; ++i) p.in[i] = (const float*)d_in[i];
    p.out = (float*)d_out; p.ws = (unsigned char*)d_ws;
#if ONE_LAUNCH
    p.ph_lo = 0; p.ph_hi = NPHASE;
    if (hipMemsetAsync((unsigned char*)d_ws + WS_BAR, 0, XCD_BAR_WORDS * 4, stream) != hipSuccess) { fprintf(stderr, "kernel_launch: hipMemsetAsync of the barrier words failed\n"); return; }
    void* args[] = {&p};
    hipError_t e = hipLaunchCooperativeKernel((const void*)mega, dim3(grid), dim3(512), args, LDS_BYTES, stream);
    if (e != hipSuccess) fprintf(stderr, "cooperative launch failed: %s (grid %d)\n", hipGetErrorString(e), grid);
#else
    for (int ph = 0; ph < NPHASE; ++ph) { p.ph_lo = ph; p.ph_hi = ph + 1;
        for (int rep = 0; rep < (((DUPMASK >> ph) & 1) ? 2 : 1); ++rep) hipLaunchKernelGGL(mega, dim3(grid), dim3(512), LDS_BYTES, stream, p); }
#endif
}
```
